# Optimizing an MI355X kernel written in HIP

```python
import jax, jax.numpy as jnp
from jax import lax
import numpy as np

D_MODEL = 1024
BATCH = 4
SEQ = 8192
DEPTH = 1

CHUNK = 64
Q_BLOCK = 128
FOX_HEADS = 8
FOX_HEAD_DIM = 64
FOX_WIDTH = FOX_HEADS * FOX_HEAD_DIM
GLA_HEADS = 4
GLA_KEY_WIDTH = D_MODEL // 2
GLA_VALUE_WIDTH = D_MODEL
GLA_DK = GLA_KEY_WIDTH // GLA_HEADS
GLA_DV = GLA_VALUE_WIDTH // GLA_HEADS
GLA_GATE_RANK = 16
GLA_GATE_TAU = 16.0
N_EXPERTS = 32
TOP_K = 4
D_EXPERT = D_MODEL
SWIGLU_LIMIT = 7.0
SWIGLU_ALPHA = 1.702
EXPERT_BLOCK = 256
NORM_EPS = 1e-5
DEEPNORM_ALPHA = (2 * DEPTH) ** 0.25
DEEPNORM_BETA = (8 * DEPTH) ** -0.25
IN_SPLITS = (FOX_WIDTH, FOX_WIDTH, FOX_WIDTH, FOX_HEADS,
             GLA_KEY_WIDTH, GLA_KEY_WIDTH, GLA_VALUE_WIDTH, GLA_VALUE_WIDTH, GLA_GATE_RANK,
             D_MODEL, D_MODEL)
IN_WIDTH = sum(IN_SPLITS)

kernel_name = "hybrid_fox_gla_moe_deepnorm_adaln"


def _normalize(x):
    xf = x.astype(jnp.float32)
    mu = jnp.mean(xf, axis=-1, keepdims=True)
    var = jnp.mean(jnp.square(xf - mu), axis=-1, keepdims=True)
    return (xf - mu) * lax.rsqrt(var + NORM_EPS)


def _modulate(x, shift, scale):
    return (_normalize(x) * (1.0 + scale[:, None, :]) + shift[:, None, :]).astype(x.dtype)


def _post_norm(z, g, b):
    return (_normalize(z) * g + b).astype(z.dtype)


def _forgetting_attention(q, k, v, f_logit):
    B, S, H, Dh = q.shape
    n_blk = S // Q_BLOCK
    cum = jnp.cumsum(jax.nn.log_sigmoid(f_logit.astype(jnp.float32)), axis=1)
    cum = cum.transpose(0, 2, 1)
    qh = q.transpose(0, 2, 1, 3) * (Dh ** -0.5)
    kh = k.transpose(0, 2, 1, 3)
    vh = v.transpose(0, 2, 1, 3)
    q_blocks = qh.reshape(B, H, n_blk, Q_BLOCK, Dh).transpose(2, 0, 1, 3, 4)
    c_blocks = cum.reshape(B, H, n_blk, Q_BLOCK).transpose(2, 0, 1, 3)
    kpos = jnp.arange(S)

    def one_block(args):
        blk, qb, cb = args
        qpos = blk * Q_BLOCK + jnp.arange(Q_BLOCK)
        s = jnp.einsum('bhqd,bhkd->bhqk', qb, kh, preferred_element_type=jnp.float32)
        s = s + cb[..., :, None] - cum[..., None, :]
        s = jnp.where(kpos[None, :] <= qpos[:, None], s, -jnp.inf)
        p = jax.nn.softmax(s, axis=-1)
        return jnp.einsum('bhqk,bhkd->bhqd', p.astype(vh.dtype), vh)

    out = lax.map(one_block, (jnp.arange(n_blk), q_blocks, c_blocks))
    return out.transpose(1, 0, 3, 2, 4).reshape(B, S, H * Dh)


def _gla_chunked(q, k, v, log_a):
    B, S, H, dk = q.shape
    dv = v.shape[-1]
    n = S // CHUNK

    def to_chunks(t):
        return t.reshape(B, n, CHUNK, H, t.shape[-1]).transpose(1, 0, 3, 2, 4)

    qc = to_chunks(q.astype(jnp.float32) * (dk ** -0.5))
    kc = to_chunks(k.astype(jnp.float32))
    vc = to_chunks(v.astype(jnp.float32))
    ac = to_chunks(log_a.astype(jnp.float32))
    causal = jnp.tril(jnp.ones((CHUNK, CHUNK), dtype=bool))

    def step(state, inp):
        qi, ki, vi, ai = inp
        b = jnp.cumsum(ai, axis=2)
        b_last = b[:, :, -1:, :]
        o_inter = jnp.einsum('bhtk,bhkv->bhtv', qi * jnp.exp(b), state)
        rel = jnp.where(causal[:, :, None], b[:, :, :, None, :] - b[:, :, None, :, :], -jnp.inf)
        scores = jnp.einsum('bhtk,bhsk,bhtsk->bhts', qi, ki, jnp.exp(rel))
        o_intra = jnp.einsum('bhts,bhsv->bhtv', scores, vi)
        new_state = (jnp.exp(b_last)[:, :, 0, :, None] * state
                     + jnp.einsum('bhsk,bhsv->bhkv', ki * jnp.exp(b_last - b), vi))
        return new_state, o_inter + o_intra

    state0 = jnp.zeros((B, H, dk, dv), jnp.float32)
    _, out = lax.scan(step, state0, (qc, kc, vc, ac))
    return out.transpose(1, 0, 3, 2, 4).reshape(B, S, H, dv)


def _mixer(u, w_in, fox_f_bias, w_gla_gate, b_gla_gate, gla_norm_g,
           w_branch_a, w_branch_b, w_out):
    B, S, _ = u.shape
    points = np.cumsum(IN_SPLITS)[:-1].tolist()
    proj = jnp.einsum('bsd,de->bse', u, w_in)
    fq, fk, fv, ff, gq, gk, gv, gr, glr, gate_a, gate_b = jnp.split(proj, points, axis=-1)

    fshape = (B, S, FOX_HEADS, FOX_HEAD_DIM)
    y_a = _forgetting_attention(fq.reshape(fshape), fk.reshape(fshape), fv.reshape(fshape),
                                ff + fox_f_bias)

    log_a = jax.nn.log_sigmoid((glr @ w_gla_gate + b_gla_gate).astype(jnp.float32)) / GLA_GATE_TAU
    kshape = (B, S, GLA_HEADS, GLA_DK)
    y_b = _gla_chunked(gq.reshape(kshape), gk.reshape(kshape),
                       gv.reshape(B, S, GLA_HEADS, GLA_DV), log_a.reshape(kshape))
    y_b = y_b * lax.rsqrt(jnp.mean(jnp.square(y_b), axis=-1, keepdims=True) + NORM_EPS)
    y_b = (y_b.reshape(B, S, GLA_VALUE_WIDTH) * gla_norm_g * jax.nn.silu(gr.astype(jnp.float32))).astype(u.dtype)

    br_a = jnp.einsum('bse,ed->bsd', y_a, w_branch_a)
    br_b = jnp.einsum('bse,ed->bsd', y_b, w_branch_b)
    merged = jax.nn.sigmoid(gate_a) * br_a + jax.nn.sigmoid(gate_b) * br_b
    return jnp.einsum('bsd,de->bse', merged, w_out)


def _moe(u, w_router, b_router, w_up, b_up, w_down, b_down):
    B, S, D = u.shape
    T = B * S
    A = T * TOP_K
    xt = u.reshape(T, D)
    logits = (xt @ w_router).astype(jnp.float32) + b_router
    top_vals, top_idx = lax.top_k(logits, TOP_K)
    gates = jax.nn.softmax(top_vals, axis=-1)

    e_flat = top_idx.reshape(A)
    tok_flat = jnp.arange(A, dtype=jnp.int32) // TOP_K
    g_flat = gates.reshape(A)
    order = jnp.argsort(e_flat)
    e_sorted = e_flat[order]
    counts = jnp.bincount(e_flat, length=N_EXPERTS)
    starts = jnp.cumsum(counts) - counts
    padded = (counts + EXPERT_BLOCK - 1) // EXPERT_BLOCK * EXPERT_BLOCK
    padded_end = jnp.cumsum(padded)
    padded_start = padded_end - padded
    dest = padded_start[e_sorted] + (jnp.arange(A) - starts[e_sorted])
    n_blocks = -(-A // EXPERT_BLOCK) + N_EXPERTS
    rows = n_blocks * EXPERT_BLOCK
    row_tok = jnp.zeros((rows,), jnp.int32).at[dest].set(tok_flat[order])
    row_gate = jnp.zeros((rows,), jnp.float32).at[dest].set(g_flat[order])
    block_expert = jnp.minimum(
        jnp.searchsorted(padded_end, jnp.arange(n_blocks) * EXPERT_BLOCK, side='right'),
        N_EXPERTS - 1)

    def expert_block(args):
        tok, e = args
        xb = xt[tok]
        h = xb @ w_up[e] + b_up[e]
        h_glu = jnp.minimum(h[:, :D_EXPERT], SWIGLU_LIMIT)
        h_lin = jnp.clip(h[:, D_EXPERT:], -SWIGLU_LIMIT, SWIGLU_LIMIT)
        act = h_glu * jax.nn.sigmoid(SWIGLU_ALPHA * h_glu) * (h_lin + 1.0)
        return act @ w_down[e] + b_down[e]

    out = lax.map(expert_block, (row_tok.reshape(n_blocks, EXPERT_BLOCK), block_expert))
    out = out.reshape(rows, D) * row_gate[:, None]
    y = jax.ops.segment_sum(out, row_tok, num_segments=T)
    return y.reshape(B, S, D).astype(u.dtype)


def setup_inputs(seed: int = 0) -> dict:
    key = jax.random.key(seed)
    ks = jax.random.split(key, 24)
    L, D, E, F = DEPTH, D_MODEL, N_EXPERTS, D_EXPERT

    def nrm(k, shape, scale):
        return scale * jax.random.normal(k, shape, jnp.float32)

    return {
        "x": nrm(ks[0], (BATCH, SEQ, D), 1.0),
        "c": nrm(ks[1], (BATCH, D), 1.0),
        "w_ada": nrm(ks[2], (L, D, 6 * D), 0.1 * D ** -0.5),
        "b_ada": nrm(ks[3], (L, 6 * D), 0.02),
        "w_in": nrm(ks[4], (L, D, IN_WIDTH), D ** -0.5),
        "fox_f_bias": 2.0 + nrm(ks[5], (L, FOX_HEADS), 0.5),
        "w_gla_gate": nrm(ks[6], (L, GLA_GATE_RANK, GLA_KEY_WIDTH), GLA_GATE_RANK ** -0.5),
        "b_gla_gate": nrm(ks[7], (L, GLA_KEY_WIDTH), 0.1),
        "gla_norm_g": 1.0 + nrm(ks[8], (L, GLA_VALUE_WIDTH), 0.02),
        "w_branch_a": nrm(ks[9], (L, FOX_WIDTH, D), FOX_WIDTH ** -0.5),
        "w_branch_b": nrm(ks[10], (L, GLA_VALUE_WIDTH, D), GLA_VALUE_WIDTH ** -0.5),
        "w_out": nrm(ks[11], (L, D, D), DEEPNORM_BETA * D ** -0.5),
        "ln1_g": 1.0 + nrm(ks[12], (L, D), 0.02),
        "ln1_b": nrm(ks[13], (L, D), 0.02),
        "w_router": nrm(ks[14], (L, D, E), D ** -0.5),
        "b_router": nrm(ks[15], (L, E), 0.01),
        "w_up": nrm(ks[16], (L, E, D, 2 * F), D ** -0.5),
        "b_up": nrm(ks[17], (L, E, 2 * F), 0.01),
        "w_down": nrm(ks[18], (L, E, F, D), DEEPNORM_BETA * F ** -0.5),
        "b_down": nrm(ks[19], (L, E, D), 0.01),
        "ln2_g": 1.0 + nrm(ks[20], (L, D), 0.02),
        "ln2_b": nrm(ks[21], (L, D), 0.02),
    }


def reference(x, c, w_ada, b_ada, w_in, fox_f_bias, w_gla_gate, b_gla_gate, gla_norm_g,
              w_branch_a, w_branch_b, w_out, ln1_g, ln1_b, w_router, b_router,
              w_up, b_up, w_down, b_down, ln2_g, ln2_b):
    c_act = jax.nn.silu(c)
    for l in range(DEPTH):
        mod = c_act @ w_ada[l] + b_ada[l]
        sh1, sc1, g1, sh2, sc2, g2 = jnp.split(mod, 6, axis=-1)
        u = _modulate(x, sh1, sc1)
        mix = _mixer(u, w_in[l], fox_f_bias[l], w_gla_gate[l], b_gla_gate[l], gla_norm_g[l],
                     w_branch_a[l], w_branch_b[l], w_out[l])
        x = _post_norm(DEEPNORM_ALPHA * x + (1.0 + g1[:, None, :]) * mix, ln1_g[l], ln1_b[l])
        u = _modulate(x, sh2, sc2)
        ffn = _moe(u, w_router[l], b_router[l], w_up[l], b_up[l], w_down[l], b_down[l])
        x = _post_norm(DEEPNORM_ALPHA * x + (1.0 + g2[:, None, :]) * ffn, ln2_g[l], ln2_b[l])
    return x
```

```cpp
#include <hip/hip_runtime.h>
#include <hip/hip_bf16.h>
#include <hip/hip_cooperative_groups.h>
#include <cstdio>
#include <cstdint>
#include <cmath>
namespace cg = cooperative_groups;

#ifndef MK_N_LAUNCHES
#define MK_N_LAUNCHES 1
#endif

namespace pg8 {
#define PG8_LAS __attribute__((address_space(3)))
#define PG8_GAS __attribute__((address_space(1)))
typedef unsigned short bf16_t;
typedef short bf16x8 __attribute__((ext_vector_type(8)));
typedef float f32x4 __attribute__((ext_vector_type(4)));
typedef float f32x2 __attribute__((ext_vector_type(2)));
typedef unsigned u32x4 __attribute__((ext_vector_type(4)));
constexpr int BM = 256, BK = 64, HALF = 128, HTB = HALF * BK * 2, STAGE_BYTES = 8 * HTB, NXCD = 8, WGM = 8;

__host__ __device__ __forceinline__ int lds_byte(int r, int c) { const int st = (r >> 4) * 2 + (c >> 5), rr = r & 15, cc = c & 31, ob = rr * 64 + cc * 2; return st * 1024 + (ob ^ (((ob >> 9) & 1) << 5)); }
__host__ __device__ __forceinline__ void stage_rc(int b, int& R, int& C) { const int st = b / 1024, sb = b % 1024, swz = sb ^ (((sb >> 9) & 1) << 5); R = (st >> 1) * 16 + swz / 64; C = (st & 1) * 32 + (swz % 64) / 2; }
__host__ __device__ __forceinline__ int perm32(int rho) { const int n = rho >> 4, i = rho & 15; return 8 * (i >> 2) + 4 * n + (i & 3); }

struct Unit { int pm, pn, e, rl; };
struct Gemm { const bf16_t* A; const bf16_t* Bt; int K; const int* rows; };

__device__ __forceinline__ bool tile_of(long L, int nM, int nN, int& pm, int& pn) {
    const int nwg = nM * nN; if (L >= nwg) return false;
    int wgid = (int)L; { const int q = nwg / NXCD, r = nwg % NXCD, xcd = wgid % NXCD, off = wgid / NXCD; wgid = (xcd < r ? xcd * (q + 1) : r * (q + 1) + (xcd - r) * q) + off; }
    const int nig = WGM * nN, gid = wgid / nig, fm = gid * WGM, gsz = (nM - fm) < WGM ? (nM - fm) : WGM;
    pm = fm + ((wgid % nig) % gsz); pn = (wgid % nig) / gsz; return true;
}
struct DenseOrder {
    int nM, nN, G, c;
    __device__ __forceinline__ bool next(int i, Unit& u) const { u.e = 0; u.rl = 0; return tile_of((long)i * G + c, nM, nN, u.pm, u.pn); }
};
struct MoeOrder {
    int nM, nN, G, c; const PG8_LAS int* tstart;
    __device__ __forceinline__ bool next(int i, Unit& u) const {
        int rt, pnl; if (!tile_of((long)i * G + c, nM, nN, rt, pnl)) return false;
        int e = 0;
#pragma unroll 1
        for (int j = 1; j < 32; ++j) if (tstart[j] <= rt) e = j;
        u.pm = rt; u.e = e; u.pn = e * nN + pnl; u.rl = e * 32768 + (rt - tstart[e]) * 256; return true;
    }
};

__device__ __forceinline__ unsigned cvt_pk_bf16(float lo, float hi) { unsigned r; asm volatile("v_cvt_pk_bf16_f32 %0, %1, %2" : "=v"(r) : "v"(lo), "v"(hi)); return r; }
__device__ __forceinline__ float bf_lo(unsigned w) { return __uint_as_float(w << 16); }
__device__ __forceinline__ float bf_hi(unsigned w) { return __uint_as_float(w & 0xffff0000u); }
__device__ __forceinline__ float sigm(float x) { return 1.0f / (1.0f + __expf(-x)); }


struct EpiInProj {
    static constexpr bool PERM = true;
    bf16_t *fq, *fk, *fv, *gq, *gk, *gv, *gr, *ga, *gb; float qscale, gqscale;
    __device__ __forceinline__ void operator()(const f32x4 (&acc)[2][2][4][2], const Unit& u, int wr, int wc, int fr, int fq_) const {
        const int pn = u.pn; bf16_t* base; int ldc, ct; float sc = 1.f; bool sg = false;
        if (pn < 2) { base = fq; ldc = 512; ct = pn; sc = qscale; } else if (pn < 4) { base = fk; ldc = 512; ct = pn - 2; } else if (pn < 6) { base = fv; ldc = 512; ct = pn - 4; }
        else if (pn < 8) { base = gq; ldc = 512; ct = pn - 6; sc = gqscale; } else if (pn < 10) { base = gk; ldc = 512; ct = pn - 8; }
        else if (pn < 14) { base = gv; ldc = 1024; ct = pn - 10; } else if (pn < 18) { base = gr; ldc = 1024; ct = pn - 14; }
        else if (pn < 22) { base = ga; ldc = 1024; ct = pn - 18; sg = true; } else { base = gb; ldc = 1024; ct = pn - 22; sg = true; }
        const int row0 = u.pm * BM + wr * 64 + fr, col0 = ct * BM + wc * 32 + 8 * fq_;
#pragma unroll
        for (int ai = 0; ai < 2; ++ai)
#pragma unroll
            for (int m = 0; m < 4; ++m) { bf16_t* rowp = base + (size_t)(row0 + ai * HALF + m * 16) * ldc + col0;
#pragma unroll
                for (int bj = 0; bj < 2; ++bj) { f32x4 v0 = acc[ai][bj][m][0], v1 = acc[ai][bj][m][1];
                    if (sg) {
#pragma unroll
                        for (int i = 0; i < 4; ++i) { v0[i] = sigm(v0[i]); v1[i] = sigm(v1[i]); } }
                    else { v0 = v0 * sc; v1 = v1 * sc; }
                    u32x4 w; w.x = cvt_pk_bf16(v0[0], v0[1]); w.y = cvt_pk_bf16(v0[2], v0[3]); w.z = cvt_pk_bf16(v1[0], v1[1]); w.w = cvt_pk_bf16(v1[2], v1[3]);
                    *(u32x4*)(rowp + bj * HALF) = w; } }
    }
};
template <bool ADD> struct EpiGate {
    static constexpr bool PERM = true;
    bf16_t* O; const bf16_t* gate;
    __device__ __forceinline__ void operator()(const f32x4 (&acc)[2][2][4][2], const Unit& u, int wr, int wc, int fr, int fq_) const {
        const int row0 = u.pm * BM + wr * 64 + fr, col0 = u.pn * BM + wc * 32 + 8 * fq_;
#pragma unroll
        for (int ai = 0; ai < 2; ++ai)
#pragma unroll
            for (int m = 0; m < 4; ++m) { const size_t off = (size_t)(row0 + ai * HALF + m * 16) * 1024 + col0;
#pragma unroll
                for (int bj = 0; bj < 2; ++bj) { const f32x4 a0 = acc[ai][bj][m][0], a1 = acc[ai][bj][m][1];
                    const u32x4 g = *(const u32x4*)(gate + off + bj * HALF);
                    float r[8] = { a0[0] * bf_lo(g.x), a0[1] * bf_hi(g.x), a0[2] * bf_lo(g.y), a0[3] * bf_hi(g.y), a1[0] * bf_lo(g.z), a1[1] * bf_hi(g.z), a1[2] * bf_lo(g.w), a1[3] * bf_hi(g.w) };
                    if (ADD) { const u32x4 o = *(const u32x4*)(O + off + bj * HALF);
                        r[0] += bf_lo(o.x); r[1] += bf_hi(o.x); r[2] += bf_lo(o.y); r[3] += bf_hi(o.y); r[4] += bf_lo(o.z); r[5] += bf_hi(o.z); r[6] += bf_lo(o.w); r[7] += bf_hi(o.w); }
                    u32x4 w; w.x = cvt_pk_bf16(r[0], r[1]); w.y = cvt_pk_bf16(r[2], r[3]); w.z = cvt_pk_bf16(r[4], r[5]); w.w = cvt_pk_bf16(r[6], r[7]);
                    *(u32x4*)(O + off + bj * HALF) = w; } }
    }
};
struct EpiResid {
    static constexpr bool PERM = false;
    const PG8_GAS float* x; float* z; const float* g1; int g1_bstride; int rows_per_batch; float alpha;
    __device__ __forceinline__ void operator()(const f32x4 (&acc)[2][2][4][2], const Unit& u, int wr, int wc, int fr, int fq_) const {
        const int row0 = u.pm * BM + wr * 64 + fr, col0 = u.pn * BM + wc * 32 + 4 * fq_;
        const float* gp = g1 + (size_t)((u.pm * BM) / rows_per_batch) * g1_bstride + col0;
        f32x4 gv[2][2];
#pragma unroll
        for (int bj = 0; bj < 2; ++bj)
#pragma unroll
            for (int n = 0; n < 2; ++n) gv[bj][n] = *(const f32x4*)(gp + bj * HALF + n * 16) + 1.0f;
#pragma unroll
        for (int ai = 0; ai < 2; ++ai)
#pragma unroll
            for (int m = 0; m < 4; ++m) { const size_t off = (size_t)(row0 + ai * HALF + m * 16) * 1024 + col0;
#pragma unroll
                for (int bj = 0; bj < 2; ++bj)
#pragma unroll
                    for (int n = 0; n < 2; ++n) { const f32x4 xv = *(const PG8_GAS f32x4*)(x + off + bj * HALF + n * 16);
                        *(f32x4*)(z + off + bj * HALF + n * 16) = xv * alpha + gv[bj][n] * acc[ai][bj][m][n]; } }
    }
};
struct EpiSwiglu {
    static constexpr bool PERM = true;
    bf16_t* act; const PG8_GAS float* b_up; int nNe;
    __device__ __forceinline__ void operator()(const f32x4 (&acc)[2][2][4][2], const Unit& u, int wr, int wc, int fr, int fq_) const {
        const int pnl = u.pn - u.e * nNe; const int row0 = u.pm * BM + wr * 64 + fr, cl = pnl * HALF + wc * 32 + 8 * fq_;
        const PG8_GAS float* bp = b_up + (size_t)u.e * 2048 + cl;
        const f32x4 bg0 = *(const PG8_GAS f32x4*)(bp), bg1 = *(const PG8_GAS f32x4*)(bp + 4), bl0 = *(const PG8_GAS f32x4*)(bp + 1024), bl1 = *(const PG8_GAS f32x4*)(bp + 1028);
#pragma unroll
        for (int ai = 0; ai < 2; ++ai)
#pragma unroll
            for (int m = 0; m < 4; ++m) {
                f32x4 g0 = acc[ai][0][m][0] + bg0, g1 = acc[ai][0][m][1] + bg1, l0 = acc[ai][1][m][0] + bl0, l1 = acc[ai][1][m][1] + bl1; float r[8];
#pragma unroll
                for (int i = 0; i < 4; ++i) { float g = fminf(g0[i], 7.0f), l = fminf(fmaxf(l0[i], -7.0f), 7.0f); r[i] = g * sigm(1.702f * g) * (l + 1.0f);
                    g = fminf(g1[i], 7.0f); l = fminf(fmaxf(l1[i], -7.0f), 7.0f); r[4 + i] = g * sigm(1.702f * g) * (l + 1.0f); }
                u32x4 w; w.x = cvt_pk_bf16(r[0], r[1]); w.y = cvt_pk_bf16(r[2], r[3]); w.z = cvt_pk_bf16(r[4], r[5]); w.w = cvt_pk_bf16(r[6], r[7]);
                *(u32x4*)(act + (size_t)(row0 + ai * HALF + m * 16) * 1024 + cl) = w; }
    }
};
struct EpiDown {
    static constexpr bool PERM = true;
    bf16_t* O; const PG8_GAS float* b_down; int nNe;
    __device__ __forceinline__ void operator()(const f32x4 (&acc)[2][2][4][2], const Unit& u, int wr, int wc, int fr, int fq_) const {
        const int pnl = u.pn - u.e * nNe; const int row0 = u.pm * BM + wr * 64 + fr, col0 = pnl * BM + wc * 32 + 8 * fq_;
        const PG8_GAS float* bp = b_down + (size_t)u.e * 1024 + col0;
        f32x4 bv[2][2];
#pragma unroll
        for (int bj = 0; bj < 2; ++bj)
#pragma unroll
            for (int n = 0; n < 2; ++n) bv[bj][n] = *(const PG8_GAS f32x4*)(bp + bj * HALF + 4 * n);
#pragma unroll
        for (int ai = 0; ai < 2; ++ai)
#pragma unroll
            for (int m = 0; m < 4; ++m) { bf16_t* rowp = O + (size_t)(row0 + ai * HALF + m * 16) * 1024 + col0;
#pragma unroll
                for (int bj = 0; bj < 2; ++bj) { const f32x4 v0 = acc[ai][bj][m][0] + bv[bj][0], v1 = acc[ai][bj][m][1] + bv[bj][1];
                    u32x4 w; w.x = cvt_pk_bf16(v0[0], v0[1]); w.y = cvt_pk_bf16(v0[2], v0[3]); w.z = cvt_pk_bf16(v1[0], v1[1]); w.w = cvt_pk_bf16(v1[2], v1[3]);
                    *(u32x4*)(rowp + bj * HALF) = w; } }
    }
};

template <class Epi, class Sched, bool GATHER, bool ALIGN_EPI>
__device__ __forceinline__ void gemm_phase(PG8_LAS unsigned char* lds, const Gemm g, const Sched& S, const Epi& E) {
    const int tid = threadIdx.x, wid = __builtin_amdgcn_readfirstlane(tid >> 6), lane = tid & 63, wr = wid >> 2, wc = wid & 3, fr = lane & 15, fq = lane >> 4;
    const int K = g.K, nt = K / BK;
    unsigned voffB[2], vA0[2], vA1[2], nA0[2], nA1[2]; int Rr[2], Cc[2];
#pragma unroll
    for (int i = 0; i < 2; ++i) { int R, C; stage_rc(tid * 16 + i * 8192, R, C); const int Rb = Epi::PERM ? ((R & ~31) + perm32(R & 31)) : R;
        voffB[i] = (unsigned)(Rb * K + C) * 2u; Rr[i] = R; Cc[i] = C; vA0[i] = vA1[i] = nA0[i] = nA1[i] = (unsigned)(R * K + C) * 2u; }
    const size_t kstep = (size_t)(BK * 2);
    const size_t hstep = (size_t)HALF * K * 2;
    const size_t tstep = 2 * hstep;
    const size_t hsA = GATHER ? 0 : hstep;
    const unsigned ldsw = (unsigned)wid * 1024u;
    const int aoff = lds_byte(wr * 64 + fr, fq * 8), boff = lds_byte(wc * 32 + fr, fq * 8);
#define PG8_SA(b, h) (((b) * 2 + (h)) * HTB)
#define PG8_SB(b, h) ((4 + (b) * 2 + (h)) * HTB)
#define PG8_STAGE(bufoff, gbase, voff) do { _Pragma("unroll") for (int _i = 0; _i < 2; ++_i) \
        __builtin_amdgcn_global_load_lds((const unsigned*)((const char*)(gbase) + (voff)[_i]), (PG8_LAS unsigned*)(lds + (bufoff) + ldsw + _i * 8192), 16, 0, 0); } while (0)
#define PG8_LDA(dst, b, h) do { _Pragma("unroll") for (int m = 0; m < 4; ++m) _Pragma("unroll") for (int k = 0; k < 2; ++k) dst[m][k] = *(const PG8_LAS bf16x8*)(lds + PG8_SA(b, h) + aoff + m * 2048 + k * 1024); } while (0)
#define PG8_LDB(dst, b, h) do { _Pragma("unroll") for (int n = 0; n < 2; ++n) _Pragma("unroll") for (int k = 0; k < 2; ++k) dst[n][k] = *(const PG8_LAS bf16x8*)(lds + PG8_SB(b, h) + boff + n * 2048 + k * 1024); } while (0)
#define PG8_MMA(ai, bj, At, Bt) do { __builtin_amdgcn_s_setprio(1); _Pragma("unroll") for (int m = 0; m < 4; ++m) _Pragma("unroll") for (int n = 0; n < 2; ++n) _Pragma("unroll") for (int k = 0; k < 2; ++k) \
        acc[ai][bj][m][n] = __builtin_amdgcn_mfma_f32_16x16x32_bf16(Bt[n][k], At[m][k], acc[ai][bj][m][n], 0, 0, 0); __builtin_amdgcn_s_setprio(0); } while (0)
#define PG8_WAIT_V(n) asm volatile("s_waitcnt vmcnt(" #n ")" ::: "memory")
#define PG8_WAIT_L(n) asm volatile("s_waitcnt lgkmcnt(" #n ")" ::: "memory")
#define PG8_BAR __builtin_amdgcn_s_barrier()
#define PG8_SCHED __builtin_amdgcn_sched_barrier(0)
#define PG8_GOFFS(u, o0, o1) do { if constexpr (GATHER) { _Pragma("unroll") for (int _i = 0; _i < 2; ++_i) { \
        const int t0_ = g.rows[(u).rl + Rr[_i]], t1_ = g.rows[(u).rl + HALF + Rr[_i]]; \
        o0[_i] = (unsigned)(t0_ * K + Cc[_i]) * 2u; o1[_i] = (unsigned)(t1_ * K + Cc[_i]) * 2u; } } } while (0)
    Unit cur, nxt; int ui = 0;
    if (!S.next(0, cur)) return;
    f32x4 acc[2][2][4][2];
#pragma unroll
    for (int a = 0; a < 2; ++a)
#pragma unroll
        for (int b = 0; b < 2; ++b)
#pragma unroll
            for (int m = 0; m < 4; ++m)
#pragma unroll
                for (int n = 0; n < 2; ++n) acc[a][b][m][n] = (f32x4){0.f, 0.f, 0.f, 0.f};
    bf16x8 At[4][2], B0[2][2], B1[2][2];
    const char* cA = (const char*)g.A + (GATHER ? (size_t)0 : (size_t)cur.pm * tstep); const char* cB = (const char*)g.Bt + (size_t)cur.pn * tstep;
    PG8_GOFFS(cur, vA0, vA1);
    PG8_STAGE(PG8_SB(0, 0), cB, voffB); PG8_STAGE(PG8_SB(0, 1), cB + hstep, voffB); PG8_STAGE(PG8_SA(0, 0), cA, vA0); PG8_STAGE(PG8_SA(0, 1), cA + hsA, vA1);
    if (wr == 1) PG8_BAR;
    PG8_WAIT_V(2); PG8_BAR;
    PG8_STAGE(PG8_SB(1, 0), cB + kstep, voffB); PG8_STAGE(PG8_SA(1, 0), cA + kstep, vA0); PG8_STAGE(PG8_SB(1, 1), cB + hstep + kstep, voffB);
    PG8_WAIT_V(6); PG8_BAR;
    for (;;) {
        const bool has_next = S.next(ui + 1, nxt);
        const char* nA = has_next ? (const char*)g.A + (GATHER ? (size_t)0 : (size_t)nxt.pm * tstep) : cA; const char* nB = has_next ? (const char*)g.Bt + (size_t)nxt.pn * tstep : cB;
        if constexpr (GATHER) { if (has_next) { PG8_GOFFS(nxt, nA0, nA1); } else {
#pragma unroll
            for (int i = 0; i < 2; ++i) { nA0[i] = vA0[i]; nA1[i] = vA1[i]; } } }
        for (int t = 0; t < nt; t += 2) {
            const bool last = (t == nt - 2);
            const char* a1 = cA + (size_t)(t + 1) * kstep;
            const char* a2 = last ? nA : cA + (size_t)(t + 2) * kstep; const char* b2 = last ? nB : cB + (size_t)(t + 2) * kstep;
            const char* a3 = a2 + kstep; const char* b3 = b2 + kstep;
            unsigned s0[2], s1[2];
#pragma unroll
            for (int i = 0; i < 2; ++i) { s0[i] = (GATHER && last) ? nA0[i] : vA0[i]; s1[i] = (GATHER && last) ? nA1[i] : vA1[i]; }
            PG8_LDB(B0, 0, 0); PG8_LDB(B1, 0, 1); PG8_SCHED; PG8_LDA(At, 0, 0); PG8_STAGE(PG8_SA(1, 1), a1 + hsA, vA1);
            PG8_WAIT_V(8); PG8_WAIT_L(0); PG8_BAR; PG8_MMA(0, 0, At, B0); PG8_MMA(0, 1, At, B1); PG8_BAR; PG8_SCHED;
            PG8_LDA(At, 0, 1); PG8_STAGE(PG8_SB(0, 0), b2, voffB); PG8_STAGE(PG8_SB(0, 1), b2 + hstep, voffB); PG8_STAGE(PG8_SA(0, 0), a2, s0);
            PG8_WAIT_V(8); PG8_WAIT_L(0); PG8_BAR; PG8_MMA(1, 0, At, B0); PG8_MMA(1, 1, At, B1); PG8_BAR; PG8_SCHED;
            PG8_LDB(B0, 1, 0); PG8_LDB(B1, 1, 1); PG8_SCHED; PG8_LDA(At, 1, 0); PG8_STAGE(PG8_SA(0, 1), a2 + hsA, s1);
            PG8_WAIT_V(8); PG8_WAIT_L(0); PG8_BAR; PG8_MMA(0, 0, At, B0); PG8_MMA(0, 1, At, B1); PG8_BAR; PG8_SCHED;
            PG8_LDA(At, 1, 1); PG8_STAGE(PG8_SB(1, 0), b3, voffB); PG8_STAGE(PG8_SB(1, 1), b3 + hstep, voffB); PG8_STAGE(PG8_SA(1, 0), a3, s0);
            PG8_WAIT_V(8); PG8_WAIT_L(0); PG8_BAR; PG8_MMA(1, 0, At, B0); PG8_MMA(1, 1, At, B1); PG8_BAR; PG8_SCHED;
        }
        if constexpr (ALIGN_EPI) { if (wr == 0) PG8_BAR; }
        E(acc, cur, wr, wc, fr, fq);
        if (!has_next) break;
#pragma unroll
        for (int a = 0; a < 2; ++a)
#pragma unroll
            for (int b = 0; b < 2; ++b)
#pragma unroll
                for (int m = 0; m < 4; ++m)
#pragma unroll
                    for (int n = 0; n < 2; ++n) acc[a][b][m][n] = (f32x4){0.f, 0.f, 0.f, 0.f};
        cur = nxt; cA = nA; cB = nB; ++ui;
        if constexpr (GATHER) {
#pragma unroll
            for (int i = 0; i < 2; ++i) { vA0[i] = nA0[i]; vA1[i] = nA1[i]; } }
        if constexpr (ALIGN_EPI) { if (wr == 1) PG8_BAR; }
    }
    PG8_WAIT_V(0);
    if constexpr (!ALIGN_EPI) { if (wr == 0) PG8_BAR; }
    PG8_BAR;
#undef PG8_SA
#undef PG8_SB
#undef PG8_STAGE
#undef PG8_LDA
#undef PG8_LDB
#undef PG8_MMA
#undef PG8_WAIT_V
#undef PG8_WAIT_L
#undef PG8_BAR
#undef PG8_SCHED
#undef PG8_GOFFS
}
}
#include <hip/hip_bf16.h>
#include <cmath>
namespace attn_body {
using bf16=__hip_bfloat16;
using bf16x8=__attribute__((ext_vector_type(8)))short;
using s16x4=__attribute__((ext_vector_type(4)))short;
using f32x16=__attribute__((ext_vector_type(16)))float;
using u32x4=__attribute__((ext_vector_type(4)))unsigned;
constexpr int BATCH=4,NHEAD=8,SEQ=8192,D=64,DM=NHEAD*D;
constexpr int NW=8,QBLK=32,QB=QBLK*NW,KVBLK=64,NQB=SEQ/QB;
constexpr int ATTN_PITCH=DM, ATTN_UNIT_ROWS=QB;
__device__ __forceinline__ int crow(int r,int hi){return (r&3)+8*(r>>2)+4*hi;}
#define SBAR() __builtin_amdgcn_sched_barrier(0)
__device__ __forceinline__ void cmask(f32x16&p0,f32x16&p1,int jb,int qrel,int hi){
  const float NEG=-INFINITY; int kb=64*jb+4*hi;
  #pragma unroll
  for(int r=0;r<16;++r){int kv=kb+(r&3)+8*(r>>2); if(kv>qrel)p0[r]=NEG; if(kv+32>qrel)p1[r]=NEG;}
}

constexpr int NSLOT=3, SLOTB=8192;
constexpr int LDS_K=0, LDS_V=NSLOT*SLOTB, LDS_WS=2*NSLOT*SLOTB, LDS_OST=LDS_WS+NW*64*4, LDS_CUM=LDS_OST+NW*4096, LDS_BYTES=LDS_CUM+SEQ*4;
constexpr float C2=0.125f*1.4426950408889634f;
__device__ __forceinline__ void glds16(const void*gsrc,unsigned lds_dst){unsigned keep;
  asm volatile("s_mov_b32 %0, m0\n\ts_mov_b32 m0, %2\n\ts_nop 0\n\tglobal_load_lds_dwordx4 %1, off\n\ts_mov_b32 m0, %0":"=&s"(keep):"v"(gsrc),"s"(lds_dst):"memory");}
__device__ __forceinline__ float max3f(float a,float b,float c){float r;asm("v_max3_f32 %0, %1, %2, %3":"=v"(r):"v"(a),"v"(b),"v"(c));return r;}
__device__ __forceinline__ float max2f(float a,float b){float r;asm("v_max_f32_e32 %0, %1, %2":"=v"(r):"v"(a),"v"(b));return r;}
__device__ __forceinline__ float fadd_s(float a,float b){float r;asm("v_add_f32_e32 %0, %1, %2":"=v"(r):"v"(a),"v"(b));return r;}
__device__ __forceinline__ float fsub_s(float a,float b){float r;asm("v_sub_f32_e32 %0, %1, %2":"=v"(r):"v"(a),"v"(b));return r;}
typedef float f32x2_t __attribute__((ext_vector_type(2))); typedef __bf16 bf16x2_t __attribute__((ext_vector_type(2)));
__device__ __forceinline__ unsigned cvtpk_s(float lo,float hi){f32x2_t v={lo,hi};bf16x2_t b=__builtin_convertvector(v,bf16x2_t);return __builtin_bit_cast(unsigned,b);}
#define WAIT_BAR(N) asm volatile("s_waitcnt vmcnt(" #N ") lgkmcnt(0)\n\ts_barrier":::"memory")

typedef __attribute__((address_space(3))) const float* lds_fptr;
typedef float f32x4a __attribute__((ext_vector_type(4)));
__device__ __forceinline__ void ckinit(f32x16&c0,f32x16&c1,lds_fptr ck,float nm,int hi){
  #pragma unroll
  for(int g=0;g<4;++g){
    const f32x4a a=*(const __attribute__((address_space(3))) f32x4a*)(ck+8*g+4*hi);
    const f32x4a b=*(const __attribute__((address_space(3))) f32x4a*)(ck+32+8*g+4*hi);
    c0[4*g+0]=nm-a[0];c0[4*g+1]=nm-a[1];c0[4*g+2]=nm-a[2];c0[4*g+3]=nm-a[3];
    c1[4*g+0]=nm-b[0];c1[4*g+1]=nm-b[1];c1[4*g+2]=nm-b[2];c1[4*g+3]=nm-b[3];}
}
__device__ __forceinline__ void qkt(f32x16&p0,f32x16&p1,const char*Kslot,const bf16x8*qr,lds_fptr ck,float nm,int r32,int hi){
  const char*kb=Kslot+hi*1024+r32*16;
  ckinit(p0,p1,ck,nm,hi);
  #pragma unroll
  for(int d0=0;d0<4;++d0){
    const bf16x8 b0=*reinterpret_cast<const bf16x8*>(kb+d0*2048);
    const bf16x8 b1=*reinterpret_cast<const bf16x8*>(kb+d0*2048+512);
    p0=__builtin_amdgcn_mfma_f32_32x32x16_bf16(b0,qr[d0],p0,0,0,0);p1=__builtin_amdgcn_mfma_f32_32x32x16_bf16(b1,qr[d0],p1,0,0,0);}
}
typedef __attribute__((address_space(3))) const char* lds_cptr;
typedef short v4i16_t __attribute__((ext_vector_type(4)));
__device__ __forceinline__ void kload8(bf16x8*kf,lds_cptr kp){
  kf[0]=*(const __attribute__((address_space(3))) bf16x8*)(kp);      kf[1]=*(const __attribute__((address_space(3))) bf16x8*)(kp+512);
  kf[2]=*(const __attribute__((address_space(3))) bf16x8*)(kp+2048); kf[3]=*(const __attribute__((address_space(3))) bf16x8*)(kp+2560);
  kf[4]=*(const __attribute__((address_space(3))) bf16x8*)(kp+4096); kf[5]=*(const __attribute__((address_space(3))) bf16x8*)(kp+4608);
  kf[6]=*(const __attribute__((address_space(3))) bf16x8*)(kp+6144); kf[7]=*(const __attribute__((address_space(3))) bf16x8*)(kp+6656);
}
__device__ __forceinline__ void kload2(bf16x8*kf,lds_cptr kp,int j){ kf[2*j]=*(const __attribute__((address_space(3))) bf16x8*)(kp+j*2048); kf[2*j+1]=*(const __attribute__((address_space(3))) bf16x8*)(kp+j*2048+512); }
__device__ __forceinline__ s16x4 vtr(lds_cptr p){ return __builtin_bit_cast(s16x4,__builtin_amdgcn_ds_read_tr16_b64_v4i16((__attribute__((address_space(3))) v4i16_t*)p)); }
__device__ __forceinline__ float rowmax(const f32x16&p0,const f32x16&p1){
  float a=max3f(p0[0],p0[1],p1[0]),b=max3f(p0[2],p0[3],p1[1]);a=max3f(a,p1[2],p1[3]);
  #pragma unroll
  for(int r=4;r<16;r+=4){a=max3f(a,p0[r],p0[r+1]);b=max3f(b,p0[r+2],p0[r+3]);a=max3f(a,p1[r],p1[r+1]);b=max3f(b,p1[r+2],p1[r+3]);}
  const float m=max2f(a,b);
  auto rr=__builtin_amdgcn_permlane32_swap(__float_as_uint(m),__float_as_uint(m),false,false);
  return max2f(__uint_as_float(rr[0]),__uint_as_float(rr[1]));
}
__device__ __forceinline__ void pv(f32x16*o,int vb,bf16x8 pa0,bf16x8 pa1,bf16x8 pa2,bf16x8 pa3){
  #pragma unroll
  for(int d0=0;d0<2;++d0){s16x4 lo[4],hi[4];
    #pragma unroll
    for(int ks=0;ks<4;++ks){
      asm volatile("ds_read_b64_tr_b16 %0,%1 offset:%c2":"=&v"(lo[ks]):"v"(vb),"i"(d0*4096+ks*1024):"memory");
      asm volatile("ds_read_b64_tr_b16 %0,%1 offset:%c2":"=&v"(hi[ks]):"v"(vb),"i"(d0*4096+ks*1024+512):"memory");}
    asm volatile("s_waitcnt lgkmcnt(0)":::"memory");SBAR();
    #define PK(k) (bf16x8){lo[k][0],lo[k][1],lo[k][2],lo[k][3],hi[k][0],hi[k][1],hi[k][2],hi[k][3]}
    o[d0]=__builtin_amdgcn_mfma_f32_32x32x16_bf16(pa0,PK(0),o[d0],0,0,0);
    o[d0]=__builtin_amdgcn_mfma_f32_32x32x16_bf16(pa1,PK(1),o[d0],0,0,0);
    o[d0]=__builtin_amdgcn_mfma_f32_32x32x16_bf16(pa2,PK(2),o[d0],0,0,0);
    o[d0]=__builtin_amdgcn_mfma_f32_32x32x16_bf16(pa3,PK(3),o[d0],0,0,0);
    #undef PK
  }
}

#ifndef ATTN_STORE16
#define ATTN_STORE16(p,v) (*(u32x4*)(p)=(v))
#endif
template<int THRL> __device__ __forceinline__ void attn_unit(int b,int h,int qb,const bf16*Q,const bf16*__restrict__ K,const bf16*__restrict__ V,bf16*O,const float*__restrict__ cum,char*shm){
  const int tid=threadIdx.x,lane=tid&63,r32=lane&31,hi=lane>>5; const int wid=__builtin_amdgcn_readfirstlane(tid>>6);
  const long rowbase=(long)b*SEQ; const int q0=qb*QB;
  const bf16*Qw=Q+(rowbase+q0+wid*QBLK)*DM+h*D;
  const bf16*Kh=K+rowbase*DM+h*D,*Vh=V+rowbase*DM+h*D;
  const unsigned lds0=(unsigned)(uintptr_t)shm;
  float*wsf=(float*)(shm+LDS_WS)+wid*64;
  const bf16*ksrc=Kh+(long)lane*DM+wid*8;
  const bf16*vsrc=Vh+(long)(16*(wid&3)+(lane>>2))*DM+(wid>>2)*32+(lane&3)*8;
  const unsigned kdst=lds0+LDS_K+wid*1024, vdst=lds0+LDS_V+wid*1024;
  #define DMA_K(t,slot) glds16(ksrc+(long)(t)*KVBLK*DM,(unsigned)__builtin_amdgcn_readfirstlane(kdst+(slot)))
  #define DMA_V(t,slot) glds16(vsrc+(long)(t)*KVBLK*DM,(unsigned)__builtin_amdgcn_readfirstlane(vdst+(slot)))
  const int vb0=(int)(lds0+LDS_V)+((lane>>4)&1)*32+(lane&3)*8+(4*hi+((lane&15)>>2))*64;
  const char*Kbase=shm+LDS_K; bf16x8 kf[8];
  const lds_cptr shm3=(lds_cptr)shm; const lds_cptr kp0=shm3+LDS_K+hi*1024+r32*16; const lds_cptr vp0=shm3+LDS_V+((lane>>4)&1)*32+(lane&3)*8+(4*hi+((lane&15)>>2))*64;
  const int NT=(q0+QB)/KVBLK;
  const lds_fptr cumS=(lds_fptr)(shm3+LDS_CUM);
  { const f32x4a* cg4=(const f32x4a*)(cum+(long)(b*NHEAD+h)*SEQ); __attribute__((address_space(3))) f32x4a* cs4=(__attribute__((address_space(3))) f32x4a*)(shm3+LDS_CUM);
    for(int i=tid;i<(q0+QB)/4;i+=NW*64)cs4[i]=cg4[i]; }
  DMA_K(0,0);DMA_V(0,0);DMA_K(1,SLOTB);
  bf16x8 qr[4];
  #pragma unroll
  for(int d0=0;d0<4;++d0)qr[d0]=*reinterpret_cast<const bf16x8*>(&Qw[(long)r32*DM+d0*16+hi*8]);
  float mhat=0.f,l_reg=0.f;f32x16 o[2];o[0]=f32x16{};o[1]=f32x16{};float cq=0.f,nm=0.f;
  const int qrel=wid*QBLK+r32;
  #define CMASK(P0,P1,t) do{int jb_=(t)-(NT-4); if(jb_>=0)cmask(P0,P1,jb_,qrel,hi);}while(0)
  bool resc=false;
  #define START(P0,P1) do{ const float rm=rowmax(P0,P1); resc=false; \
    { const float dl=rm; mhat=fadd_s(mhat,dl); \
      _Pragma("unroll") for(int r=0;r<16;++r){P0[r]=fsub_s(P0[r],dl);P1[r]=fsub_s(P1[r],dl);} \
      nm=cq-mhat; } \
    _Pragma("unroll") for(int r=0;r<16;++r)P0[r]=__builtin_amdgcn_exp2f(P0[r]); }while(0)
  #define RESC() do{ if(resc){ asm volatile("s_waitcnt lgkmcnt(0)":::"memory"); \
      _Pragma("unroll") for(int d_=0;d_<2;++d_) _Pragma("unroll") for(int r=0;r<16;++r)o[d_][r]*=wsf[crow(r,hi)]; } }while(0)
  f32x16 pA0,pA1,pB0,pB1;
  int sl_prev=0,sl_cur=0,sl_next=SLOTB;
  #define ROT() do{sl_prev=sl_cur;sl_cur=sl_next;sl_next=(sl_next==(NSLOT-1)*SLOTB)?0:sl_next+SLOTB;}while(0)
  DMA_K(2,2*SLOTB);
  WAIT_BAR(3);
  cq=cumS[q0+qrel]; nm=cq;
  qkt(pA0,pA1,Kbase,qr,cumS,nm,r32,hi);asm volatile("s_nop 15\n\ts_nop 7":"+v"(pA0),"+v"(pA1));CMASK(pA0,pA1,0);
  START(pA0,pA1);
  _Pragma("unroll") for(int r=0;r<16;++r)pA1[r]=__builtin_amdgcn_exp2f(pA1[r]);
  WAIT_BAR(0);
  DMA_K(3,0);DMA_V(1,SLOTB);
  ROT();
  kload8(kf,kp0+sl_cur);
  WAIT_BAR(2);
  s16x4 vlo[8],vhi[8]; u32x4 pw0,pw1,pw2,pw3;
  #define PKW(P,B) cvtpk_s(P[B],P[B+1])
  #define PAF(k) __builtin_bit_cast(bf16x8,pw##k)
  #define VFR(i) (bf16x8){vlo[i][0],vlo[i][1],vlo[i][2],vlo[i][3],vhi[i][0],vhi[i][1],vhi[i][2],vhi[i][3]}
  #define PIN(x) asm volatile("":"+v"(x))
  #define MX3(a,b,c) __builtin_fmaxf(__builtin_fmaxf((a),(b)),(c))
  #define GAPA(MF,A0,A1,A2,A3,W0,W1,PW) do{ MF; sacc+=A0; sacc+=A1; sacc+=A2; sacc+=A3; PIN(sacc); W0; W1; PIN(PW); SBAR(); }while(0)
  #define EX(v) __builtin_amdgcn_exp2f(v)
  #define GAPB(MF,X,B) do{ MF; X[B]=EX(X[B]); X[B+1]=EX(X[B+1]); X[B+2]=EX(X[B+2]); X[B+3]=EX(X[B+3]); PIN(X); SBAR(); }while(0)
  #define VRD(i) do{ vlo[i]=vtr(vp_+(((i)>>2)*4096+((i)&3)*1024)); vhi[i]=vtr(vp_+(((i)>>2)*4096+((i)&3)*1024+512)); }while(0)
  #define KRD(G,j) do{ if(G){ kload2(kf,kp0+sl_next,j); SBAR(); } }while(0)
  #define STEP(C0,C1,P0,P1,t,GK,GV,GL) do{ SBAR(); \
    ckinit(C0,C1,cumS+64*(t),nm,hi); SBAR(); \
    const lds_cptr vp_=vp0+sl_prev; \
    VRD(0); SBAR(); float sacc=(P0[0]+P0[1]); \
    GAPA(C0=__builtin_amdgcn_mfma_f32_32x32x16_bf16(kf[0],qr[0],C0,0,0,0), P0[2],P0[3],P0[4],P0[5],     pw0[0]=PKW(P0,0), pw0[1]=PKW(P0,2), pw0); \
    VRD(4); SBAR(); GAPA(C1=__builtin_amdgcn_mfma_f32_32x32x16_bf16(kf[1],qr[0],C1,0,0,0), P0[6],P0[7],P0[8],P0[9],     pw0[2]=PKW(P0,4), pw0[3]=PKW(P0,6), pw0); \
    VRD(1); SBAR(); GAPA(C0=__builtin_amdgcn_mfma_f32_32x32x16_bf16(kf[2],qr[1],C0,0,0,0),   P0[10],P0[11],P0[12],P0[13], pw1[0]=PKW(P0,8), pw1[1]=PKW(P0,10), pw1); \
    VRD(5); SBAR(); GAPA(C1=__builtin_amdgcn_mfma_f32_32x32x16_bf16(kf[3],qr[1],C1,0,0,0),   P0[14],P0[15],P1[0],P1[1],   pw1[2]=PKW(P0,12),pw1[3]=PKW(P0,14), pw1); \
    VRD(2); SBAR(); GAPA(C0=__builtin_amdgcn_mfma_f32_32x32x16_bf16(kf[4],qr[2],C0,0,0,0),   P1[2],P1[3],P1[4],P1[5],     pw2[0]=PKW(P1,0), pw2[1]=PKW(P1,2), pw2); \
    VRD(6); SBAR(); GAPA(C1=__builtin_amdgcn_mfma_f32_32x32x16_bf16(kf[5],qr[2],C1,0,0,0),   P1[6],P1[7],P1[8],P1[9],     pw2[2]=PKW(P1,4), pw2[3]=PKW(P1,6), pw2); \
    VRD(3); SBAR(); GAPA(C0=__builtin_amdgcn_mfma_f32_32x32x16_bf16(kf[6],qr[3],C0,0,0,0),   P1[10],P1[11],P1[12],P1[13], pw3[0]=PKW(P1,8), pw3[1]=PKW(P1,10), pw3); \
    VRD(7); SBAR(); GAPA(C1=__builtin_amdgcn_mfma_f32_32x32x16_bf16(kf[7],qr[3],C1,0,0,0),   P1[14],P1[15],0.f,0.f,       pw3[2]=PKW(P1,12),pw3[3]=PKW(P1,14), pw3); \
    l_reg+=sacc; \
    if(GK){DMA_K((t)+3,sl_cur);} if(GV){DMA_V((t)+1,sl_next);} \
    CMASK(C0,C1,t); \
    { float a=MX3(C0[0],C0[1],C1[0]),b=MX3(C0[2],C0[3],C1[1]); a=MX3(a,C1[2],C1[3]); \
      _Pragma("unroll") for(int r=4;r<16;r+=4){a=MX3(a,C0[r],C0[r+1]);b=MX3(b,C0[r+2],C0[r+3]);a=MX3(a,C1[r],C1[r+1]);b=MX3(b,C1[r+2],C1[r+3]);} \
      float rm=__builtin_fmaxf(a,b); { auto rr=__builtin_amdgcn_permlane32_swap(__float_as_uint(rm),__float_as_uint(rm),false,false); rm=__builtin_fmaxf(__uint_as_float(rr[0]),__uint_as_float(rr[1])); } \
      resc=false; \
      if(__builtin_expect(__any(rm>(float)THRL),0)){ const float dl=__builtin_fmaxf(rm,0.f); mhat+=dl; \
        _Pragma("unroll") for(int r=0;r<16;++r){C0[r]-=dl;C1[r]-=dl;} \
        nm=cq-mhat; \
        const float f=__builtin_amdgcn_exp2f(-dl); l_reg*=f; if(hi==0)wsf[r32]=f; resc=true; } } \
    SBAR(); \
    GAPB(o[0]=__builtin_amdgcn_mfma_f32_32x32x16_bf16(PAF(0),VFR(0),o[0],0,0,0), C0,0); \
    GAPB(o[1]=__builtin_amdgcn_mfma_f32_32x32x16_bf16(PAF(0),VFR(4),o[1],0,0,0), C0,4); \
    KRD(GL,0); GAPB(o[0]=__builtin_amdgcn_mfma_f32_32x32x16_bf16(PAF(1),VFR(1),o[0],0,0,0), C0,8); \
    KRD(GL,1); GAPB(o[1]=__builtin_amdgcn_mfma_f32_32x32x16_bf16(PAF(1),VFR(5),o[1],0,0,0), C0,12); \
    KRD(GL,2); GAPB(o[0]=__builtin_amdgcn_mfma_f32_32x32x16_bf16(PAF(2),VFR(2),o[0],0,0,0), C1,0); \
    KRD(GL,3); GAPB(o[1]=__builtin_amdgcn_mfma_f32_32x32x16_bf16(PAF(2),VFR(6),o[1],0,0,0), C1,4); \
    GAPB(o[0]=__builtin_amdgcn_mfma_f32_32x32x16_bf16(PAF(3),VFR(3),o[0],0,0,0), C1,8); \
    GAPB(o[1]=__builtin_amdgcn_mfma_f32_32x32x16_bf16(PAF(3),VFR(7),o[1],0,0,0), C1,12); \
    }while(0)
  int t=1;
  #undef CMASK
  #define CMASK(P0,P1,t) do{}while(0)
  for(;t+5<NT;t+=2){
    STEP(pB0,pB1,pA0,pA1,t,true,true,true);     WAIT_BAR(2); RESC(); ROT();
    STEP(pA0,pA1,pB0,pB1,t+1,true,true,true);   WAIT_BAR(2); RESC(); ROT();
  }
  #undef CMASK
  #define CMASK(P0,P1,t) do{int jb_=(t)-(NT-4); if(jb_>=0)cmask(P0,P1,jb_,qrel,hi);}while(0)
  #define ENDW(tt) do{ if((tt)+3<NT){WAIT_BAR(2);} else if((tt)+2<NT){WAIT_BAR(1);} else {WAIT_BAR(0);} }while(0)
  for(;t+1<NT;t+=2){
    STEP(pB0,pB1,pA0,pA1,t,(t+3<NT),(t+1<NT),(t+1<NT));       ENDW(t);   RESC(); ROT();
    STEP(pA0,pA1,pB0,pB1,t+1,(t+4<NT),(t+2<NT),(t+2<NT));     ENDW(t+1); RESC(); ROT();
  }
  STEP(pB0,pB1,pA0,pA1,NT-1,false,false,false); RESC();
  { float sacc=pB0[0]+pB0[1]; _Pragma("unroll") for(int r=2;r<16;++r)sacc+=pB0[r]; _Pragma("unroll") for(int r=0;r<16;++r)sacc+=pB1[r]; l_reg+=sacc;
    pw0=(u32x4){PKW(pB0,0),PKW(pB0,2),PKW(pB0,4),PKW(pB0,6)};pw1=(u32x4){PKW(pB0,8),PKW(pB0,10),PKW(pB0,12),PKW(pB0,14)};pw2=(u32x4){PKW(pB1,0),PKW(pB1,2),PKW(pB1,4),PKW(pB1,6)};pw3=(u32x4){PKW(pB1,8),PKW(pB1,10),PKW(pB1,12),PKW(pB1,14)};
    SBAR(); pv(o,vb0+sl_cur,PAF(0),PAF(1),PAF(2),PAF(3)); }
  #undef PKW
  #undef PAF
  #undef VFR
  #undef PIN
  #undef MX3
  #undef GAPA
  #undef GAPB
  #undef EX
  #undef VRD
  #undef KRD
  #undef STEP
  #undef ENDW
  {auto rr=__builtin_amdgcn_permlane32_swap(__float_as_uint(l_reg),__float_as_uint(l_reg),false,false);l_reg=__uint_as_float(rr[0])+__uint_as_float(rr[1]);}
  if(hi==0)wsf[32+r32]=l_reg;asm volatile("s_waitcnt lgkmcnt(0)":::"memory");
  float rli[16];
  #pragma unroll
  for(int r=0;r<16;++r)rli[r]=__builtin_amdgcn_rcpf(wsf[32+crow(r,hi)]);
  bf16*Ow=O+(rowbase+q0+wid*QBLK)*DM+h*D;
  { bf16*stg=(bf16*)(shm+LDS_OST)+wid*2048;
    #pragma unroll
    for(int r=0;r<16;++r){const int orow=crow(r,hi);
      #pragma unroll
      for(int d0=0;d0<2;++d0)stg[orow*64+d0*32+r32]=__float2bfloat16(o[d0][r]*rli[r]);}
    asm volatile("s_waitcnt lgkmcnt(0)":::"memory");
    #pragma unroll
    for(int i=0;i<4;++i){const int row=i*8+(lane>>3),ch=lane&7; const u32x4 v=*(const u32x4*)(stg+row*64+ch*8); ATTN_STORE16(Ow+(long)row*DM+ch*8,v);} }
  asm volatile("s_waitcnt lgkmcnt(0)\n\ts_barrier":::"memory");
  #undef DMA_K
  #undef DMA_V
  #undef CMASK
  #undef START
  #undef RESC
  #undef ROT
}
constexpr int ATTN_LDS_BYTES=LDS_BYTES;
struct AttnTensors { const bf16* Q; const bf16* K; const bf16* V; bf16* O; const float* cum; };
struct AttnUnit { int bh; int qb; };
struct StaticOrder {
  int vcu;
  __device__ __forceinline__ explicit StaticOrder(int grid,int block):vcu((block%8)*(grid/8)+block/8){}
  __device__ __forceinline__ bool next(int i,AttnUnit&u)const{ if(i>=4)return false; const int s=vcu&7; u.bh=vcu>>3; u.qb=(i==0)?s:(i==1)?15-s:(i==2)?16+s:31-s; return true; }
  __device__ __forceinline__ void a_ready(const AttnUnit&)const{}
  __device__ __forceinline__ void done(const AttnUnit&)const{}
};
template<class Sched,int THRL=8> __device__ __forceinline__ void attn_phase(char*lds,const AttnTensors&T,const Sched&S){
  AttnUnit u;
  for(int i=0;S.next(i,u);++i){ S.a_ready(u); attn_unit<THRL>(u.bh/NHEAD,u.bh%NHEAD,u.qb,T.Q,T.K,T.V,T.O,T.cum,lds); S.done(u); }
}
#undef SBAR
#undef WAIT_BAR
}

constexpr int NWAVES = 8, NTHR = 512;
constexpr int NB = 4, SEQ = 8192, DM = 1024, T = NB * SEQ;
constexpr int NEXP = 32, TOPK = 4, ECAP = 32768;
constexpr int NSLOT_ROWS = T * TOPK + NEXP * 256;
constexpr int INW = 6680, NPROJ = 6656;
constexpr float LN_EPS = 1e-5f, ALPHA = 1.18920711500272f, LOG2E = 1.4426950408889634f;
constexpr size_t MiB = 1u << 20;
constexpr size_t WS_CTL = 0;
constexpr size_t WS_MODP = 1 * MiB, WS_MODF = WS_MODP + 512 * 1024;
constexpr size_t WS_WSM = 2 * MiB, WS_WRT = WS_WSM + 256 * 1024;
constexpr size_t WS_FFL = 3 * MiB, WS_GLR = 4 * MiB, WS_CUM = 6 * MiB, WS_DLAST = 7 * MiB;
constexpr size_t WS_TSLOT = 8 * MiB, WS_TGATE = WS_TSLOT + 512 * 1024, WS_RTOK = 9 * MiB;
constexpr size_t WS_WIN = 16 * MiB, WS_WA = 29 * MiB, WS_WB = 30 * MiB, WS_WO = 32 * MiB, WS_WUP = 34 * MiB, WS_WDN = 162 * MiB;
constexpr size_t WS_U = 226 * MiB;
constexpr size_t WS_FQ = 290 * MiB, WS_FK = 322 * MiB, WS_FV = 354 * MiB, WS_GQ = 386 * MiB, WS_GK = 418 * MiB, WS_GV = 450 * MiB, WS_GR = 514 * MiB, WS_GA = 578 * MiB, WS_GB = 642 * MiB;
constexpr size_t WS_US = 706 * MiB;
constexpr size_t WS_U2 = 834 * MiB;
constexpr size_t WS_ACT = 290 * MiB, WS_MOE = 562 * MiB;
constexpr size_t WS_END = 898 * MiB;
static_assert(WS_ACT + (size_t)NSLOT_ROWS * 1024 * 2 <= WS_MOE && WS_MOE + (size_t)NSLOT_ROWS * 1024 * 2 <= WS_U2, "overlay map");

constexpr int LDS_BYTES = 160 * 1024;
constexpr int MISC_OFF = 131072;
constexpr int BARLDS_OFF = LDS_BYTES - 64;
constexpr int CW_BAR = 4096;
constexpr size_t CTL_ZERO_BYTES = 65536;

#define LAS __attribute__((address_space(3)))
typedef unsigned short bf16;
typedef unsigned v4u __attribute__((ext_vector_type(4)));
typedef unsigned v2u __attribute__((ext_vector_type(2)));
typedef float f32x4 __attribute__((ext_vector_type(4)));
typedef float f32x16 __attribute__((ext_vector_type(16)));
typedef short bf16x8 __attribute__((ext_vector_type(8)));
typedef short s16x4 __attribute__((ext_vector_type(4)));
#define LDS_WAIT() asm volatile("s_waitcnt lgkmcnt(0)" ::: "memory")
__device__ __forceinline__ unsigned f2bf(float f) { unsigned u = __builtin_bit_cast(unsigned, f); return (u + 0x7fffu + ((u >> 16) & 1u)) >> 16; }
__device__ __forceinline__ unsigned pk2(float lo, float hi) { return f2bf(lo) | (f2bf(hi) << 16); }
__device__ __forceinline__ float bfl(unsigned w) { return __uint_as_float(w << 16); }
__device__ __forceinline__ float bfh(unsigned w) { return __uint_as_float(w & 0xffff0000u); }
__device__ __forceinline__ float bf1(bf16 h) { return __uint_as_float((unsigned)h << 16); }
__device__ __forceinline__ float wave_sum(float v) {
#pragma unroll
    for (int o = 1; o < 64; o <<= 1) v += __shfl_xor(v, o);
    return v;
}
__device__ __forceinline__ float wave_max(float v) {
#pragma unroll
    for (int o = 1; o < 64; o <<= 1) v = fmaxf(v, __shfl_xor(v, o));
    return v;
}
__device__ __forceinline__ float logsigmoidf(float x) { return fminf(x, 0.f) - log1pf(__expf(-fabsf(x))); }
__device__ __forceinline__ float sigmoidf_(float x) { return 1.0f / (1.0f + __expf(-x)); }
__device__ __forceinline__ float reduce32(const float (&v)[32], int lane) {
    float a[16], b[8], c[4], d[2], e;
    { const bool up = lane & 32;
#pragma unroll
      for (int i = 0; i < 16; ++i) { const float keep = up ? v[16 + i] : v[i], send = up ? v[i] : v[16 + i]; a[i] = keep + __shfl_xor(send, 32); } }
    { const bool up = lane & 16;
#pragma unroll
      for (int i = 0; i < 8; ++i) { const float keep = up ? a[8 + i] : a[i], send = up ? a[i] : a[8 + i]; b[i] = keep + __shfl_xor(send, 16); } }
    { const bool up = lane & 8;
#pragma unroll
      for (int i = 0; i < 4; ++i) { const float keep = up ? b[4 + i] : b[i], send = up ? b[i] : b[4 + i]; c[i] = keep + __shfl_xor(send, 8); } }
    { const bool up = lane & 4;
#pragma unroll
      for (int i = 0; i < 2; ++i) { const float keep = up ? c[2 + i] : c[i], send = up ? c[i] : c[2 + i]; d[i] = keep + __shfl_xor(send, 4); } }
    { const bool up = lane & 2; const float keep = up ? d[1] : d[0], send = up ? d[0] : d[1]; e = keep + __shfl_xor(send, 2); }
    e += __shfl_xor(e, 1);
    return e;
}

__device__ __forceinline__ bf16x8 frag_row(const LAS bf16* img, int stride, int row0, int k0, int lane) {
    return *(const LAS bf16x8*)(img + (row0 + (lane & 31)) * stride + k0 + 8 * (lane >> 5));
}
__device__ __forceinline__ bf16x8 frag_tr(const LAS bf16* img, int stride, int k0, int n0, int lane) {
    const int g = lane >> 4, q = (lane >> 2) & 3, p = lane & 3, h = g >> 1;
    const LAS bf16* a = img + (k0 + 8 * h + q) * stride + n0 + 16 * (g & 1) + 4 * p;
    const s16x4 lo = __builtin_bit_cast(s16x4, __builtin_amdgcn_ds_read_tr16_b64_v4i16((LAS s16x4*)a));
    const s16x4 hi = __builtin_bit_cast(s16x4, __builtin_amdgcn_ds_read_tr16_b64_v4i16((LAS s16x4*)(a + 4 * stride)));
    return (bf16x8){lo[0], lo[1], lo[2], lo[3], hi[0], hi[1], hi[2], hi[3]};
}
__device__ __forceinline__ int crow16(int r, int h) { return (r & 3) + 8 * (r >> 2) + 4 * h; }

typedef __attribute__((address_space(1))) unsigned gu32;
#define XB_TMO      128
#define XB_XCNT(j)  (256  + 64 * (j))
#define XB_XSUB(j)  (1280 + 64 * (j))
#define XB_XGEN(j)  (2304 + 64 * (j))
#define XB_TOP      3328
#define XB_TOPGEN   3392
#define XCD_BAR_WORDS 3456
#define XB_SPIN_CAP (1u << 18)

__device__ __forceinline__ unsigned xb_ld(unsigned* p)              { return __hip_atomic_load(p, __ATOMIC_RELAXED, __HIP_MEMORY_SCOPE_AGENT); }
__device__ __forceinline__ unsigned xb_add(unsigned* p, unsigned v) { return __hip_atomic_fetch_add(p, v, __ATOMIC_RELAXED, __HIP_MEMORY_SCOPE_AGENT); }
__device__ __forceinline__ unsigned xb_xcc_id() { return (unsigned)__builtin_amdgcn_s_getreg((3 << 11) | 20) & 0xFu; }
#define XB_SPIN(cond, bar) do { unsigned _sp = 0; while (cond) { __builtin_amdgcn_s_sleep(1); \
    if ((++_sp & 255u) == 0u) { if (xb_ld(&(bar)[XB_TMO])) break; if (_sp > XB_SPIN_CAP) { atomicAdd(&(bar)[XB_TMO], 1u); break; } } } } while (0)

struct XcdBarrier {
    unsigned* bar; unsigned x;
    volatile LAS unsigned* st;
};

__device__ __forceinline__ XcdBarrier xcd_barrier_post(unsigned* bar, volatile LAS unsigned* st) {
    XcdBarrier b; b.bar = bar; b.x = xb_xcc_id(); b.st = st;
    if (threadIdx.x == 0) (void)xb_add(&bar[XB_XCNT(b.x)], 1u);
    return b;
}
__device__ __forceinline__ void xcd_barrier_complete(unsigned* bar, unsigned x, unsigned& nloc, unsigned& nx) {
    const unsigned G = gridDim.x * gridDim.y * gridDim.z;
    unsigned sum, cnt, mine, sp = 0u;
    for (;;) {
        sum = 0u; cnt = 0u; mine = 0u;
#pragma unroll
        for (unsigned j = 0; j < 16; ++j) { const unsigned c = xb_ld(&bar[XB_XCNT(j)]); sum += c; cnt += (c > 0u) ? 1u : 0u; mine = (j == x) ? c : mine; }
        if (sum == G) break;
        __builtin_amdgcn_s_sleep(1);
        if ((++sp & 255u) == 0u) { if (xb_ld(&bar[XB_TMO])) break; if (sp > XB_SPIN_CAP) { atomicAdd(&bar[XB_TMO], 1u); break; } }
    }
    nloc = mine > 0u ? mine : 1u; nx = cnt > 0u ? cnt : 1u;
}

__device__ __forceinline__ void xcd_barrier(const XcdBarrier& b) {
    asm volatile("s_waitcnt vmcnt(0)" ::: "memory");
    __syncthreads();
    if (threadIdx.x == 0) {
        unsigned* bar = b.bar;
        __builtin_amdgcn_s_waitcnt(0);
        unsigned nloc = b.st[0], nx = b.st[1];
        if (nloc == 0u) { xcd_barrier_complete(bar, b.x, nloc, nx); b.st[0] = nloc; b.st[1] = nx; }
        const unsigned old = xb_add(&bar[XB_XSUB(b.x)], 1u);
        const unsigned gen = old / nloc;
        if (old + 1u == (gen + 1u) * nloc) {
            __builtin_amdgcn_fence(__ATOMIC_RELEASE, "agent");
            asm volatile("s_waitcnt vmcnt(0)" ::: "memory");
            const unsigned og = xb_add(&bar[XB_TOP], 1u);
            const unsigned tg = og / nx;
            if (og + 1u == (tg + 1u) * nx) xb_add(&bar[XB_TOPGEN], 1u);
            else XB_SPIN(xb_ld(&bar[XB_TOPGEN]) == tg, bar);
            __builtin_amdgcn_fence(__ATOMIC_ACQUIRE, "agent");
            xb_add(&bar[XB_XGEN(b.x)], 1u);
            asm volatile("s_waitcnt vmcnt(0)" ::: "memory");
        } else {
            XB_SPIN(xb_ld(&bar[XB_XGEN(b.x)]) == gen, bar);
            __builtin_amdgcn_fence(__ATOMIC_ACQUIRE, "agent");
            asm volatile("s_waitcnt vmcnt(0)" ::: "memory");
        }
    }
    __syncthreads();
}

struct Frame {
    LAS unsigned char* lds;
    int wave, G, blk;
    float* out; unsigned char* ws;
};
#define WSP(type, off) ((type*)(F.ws + (off)))
constexpr size_t WS_PTRS = 2048;
#define GAS __attribute__((address_space(1)))
typedef const GAS float* gfptr_t;
typedef const GAS f32x4* gf4ptr_t;
#define PT(k) (((const gfptr_t*)(F.ws + WS_PTRS))[k])
struct Args { const float* in[22]; float* out; unsigned char* ws; int ph_lo, ph_hi; };

__device__ __forceinline__ void p0_transpose_item(const float* W, int ldw, int sc0, bf16* WT, int Kd, int drow0, int k0, LAS float* scr, int lane) {
#pragma unroll 8
    for (int i = 0; i < 32; ++i) { const int kk = 2 * i + (lane >> 5); scr[kk * 33 + (lane & 31)] = W[(size_t)(k0 + kk) * ldw + sc0 + (lane & 31)]; }
    LDS_WAIT(); asm volatile("" ::: "memory");
    const int c = lane & 7;
#pragma unroll
    for (int j = 0; j < 4; ++j) { const int n = (lane >> 3) + 8 * j; const LAS float* s = scr + (8 * c) * 33 + n;
        v4u o; o.x = pk2(s[0 * 33], s[1 * 33]); o.y = pk2(s[2 * 33], s[3 * 33]); o.z = pk2(s[4 * 33], s[5 * 33]); o.w = pk2(s[6 * 33], s[7 * 33]);
        *(v4u*)(WT + (size_t)(drow0 + n) * Kd + k0 + 8 * c) = o; }
    LDS_WAIT(); asm volatile("" ::: "memory");
}
__device__ __forceinline__ void phase0(Frame& F, const Args& A) {
    const int gtid = F.blk * NTHR + ((int)threadIdx.x), NT_ALL = F.G * NTHR;
    if (F.blk == 0 && ((int)threadIdx.x) < 64) WSP(unsigned, WS_CTL)[((int)threadIdx.x)] = 0u;
    if (F.blk == 0 && ((int)threadIdx.x) < 22) ((const float**)(F.ws + WS_PTRS))[((int)threadIdx.x)] = A.in[((int)threadIdx.x)];
    { v4u* p = WSP(v4u, WS_RTOK); for (int i = gtid; i < NEXP * ECAP / 4; i += NT_ALL) p[i] = (v4u){0u, 0u, 0u, 0u}; }
    for (int i = gtid; i < 24 * 1024; i += NT_ALL) { const int o = i >> 10, k = i & 1023; const int col = o < 8 ? 1536 + o : 4616 + (o - 8); WSP(float, WS_WSM)[i] = A.in[4][(size_t)k * INW + col]; }
    for (int i = gtid; i < 32 * 1024; i += NT_ALL) { const int e = i >> 10, k = i & 1023; WSP(float, WS_WRT)[i] = A.in[14][k * 32 + e]; }
    if (F.blk < 48) {
        LAS float* sc = (LAS float*)F.lds;
        for (int i = ((int)threadIdx.x); i < 4096; i += NTHR) { const float v = A.in[1][i]; sc[i] = v * sigmoidf_(v); }
        __syncthreads();
        const int ks = gtid / 6144, j = gtid % 6144; float a0 = 0.f, a1 = 0.f, a2 = 0.f, a3 = 0.f;
        const float* wp = A.in[2] + (size_t)(ks * 256) * 6144 + j; const LAS float* s = sc + ks * 256;
#pragma unroll 8
        for (int k = 0; k < 256; ++k) { const float w = wp[(size_t)k * 6144]; a0 += s[k] * w; a1 += s[1024 + k] * w; a2 += s[2048 + k] * w; a3 += s[3072 + k] * w; }
        const float bb = ks == 0 ? A.in[3][j] : 0.f; float* mp = WSP(float, WS_MODP) + (size_t)ks * 4 * 6144 + j;
        mp[0] = a0 + bb; mp[6144] = a1 + bb; mp[2 * 6144] = a2 + bb; mp[3 * 6144] = a3 + bb;
        __syncthreads();
    }
    LAS float* scr = (LAS float*)(F.lds + 16384 + F.wave * 16384);
    const int gw = F.blk * NWAVES + F.wave, NGW = F.G * NWAVES;
    constexpr int I_IN = 16 * (NPROJ / 32), I_A = 8 * 32, I_B = 16 * 32, I_O = 16 * 32, I_UP = 16 * 64, I_DN = 16 * 32;
    constexpr int NITEMS = I_IN + I_A + I_B + I_O + NEXP * (I_UP + I_DN);
    for (int it = gw; it < NITEMS; it += NGW) {
        int r = it;
        if (r < I_IN) { const int nblk = NPROJ / 32, kb = r / nblk, nb = r % nblk, n0 = 32 * nb; const int sc0 = n0 + (n0 < 1536 ? 0 : (n0 < 4608 ? 8 : 24));
            p0_transpose_item(A.in[4], INW, sc0, WSP(bf16, WS_WIN), 1024, n0, 64 * kb, scr, ((int)threadIdx.x & 63)); continue; } r -= I_IN;
        if (r < I_A) { const int kb = r / 32, nb = r % 32; p0_transpose_item(A.in[9], 1024, 32 * nb, WSP(bf16, WS_WA), 512, 32 * nb, 64 * kb, scr, ((int)threadIdx.x & 63)); continue; } r -= I_A;
        if (r < I_B) { const int kb = r / 32, nb = r % 32; p0_transpose_item(A.in[10], 1024, 32 * nb, WSP(bf16, WS_WB), 1024, 32 * nb, 64 * kb, scr, ((int)threadIdx.x & 63)); continue; } r -= I_B;
        if (r < I_O) { const int kb = r / 32, nb = r % 32; p0_transpose_item(A.in[11], 1024, 32 * nb, WSP(bf16, WS_WO), 1024, 32 * nb, 64 * kb, scr, ((int)threadIdx.x & 63)); continue; } r -= I_O;
        const int e = r / (I_UP + I_DN); r -= e * (I_UP + I_DN);
        if (r < I_UP) { const int kb = r / 64, nb = r % 64, n0 = 32 * nb, tile = n0 >> 8, w = n0 & 255; const int sc0 = w < 128 ? 128 * tile + w : 1024 + 128 * tile + (w - 128);
            p0_transpose_item(A.in[16] + (size_t)e * 1024 * 2048, 2048, sc0, WSP(bf16, WS_WUP) + (size_t)e * 2048 * 1024, 1024, n0, 64 * kb, scr, ((int)threadIdx.x & 63)); continue; } r -= I_UP;
        { const int kb = r / 32, nb = r % 32; p0_transpose_item(A.in[18] + (size_t)e * 1024 * 1024, 1024, 32 * nb, WSP(bf16, WS_WDN) + (size_t)e * 1024 * 1024, 1024, 32 * nb, 64 * kb, scr, ((int)threadIdx.x & 63)); }
    }
}

__device__ __forceinline__ void phase1(Frame& F, const Args& A) {
    LAS float* wsm = (LAS float*)F.lds;
    LAS float* mods = (LAS float*)(F.lds + 98304);
    const int b = F.blk / (F.G / NB);
    for (int i = ((int)threadIdx.x); i < 24 * 1024 / 4; i += NTHR) ((LAS f32x4*)wsm)[i] = WSP(f32x4, WS_WSM)[i];
    for (int i = ((int)threadIdx.x); i < 2048; i += NTHR) { const float* mp = WSP(float, WS_MODP) + (size_t)b * 6144 + i; mods[i] = (mp[0] + mp[4 * 6144]) + (mp[2 * 4 * 6144] + mp[3 * 4 * 6144]); }
    { const int gtid = F.blk * NTHR + ((int)threadIdx.x); if (gtid < 4 * 6144) { const float* mp = WSP(float, WS_MODP) + gtid; WSP(float, WS_MODF)[gtid] = (mp[0] + mp[4 * 6144]) + (mp[2 * 4 * 6144] + mp[3 * 4 * 6144]); } }
    __syncthreads();
    const int rows_per_blk = T / F.G, rows_per_wave = rows_per_blk / NWAVES;
    const int row0 = F.blk * rows_per_blk + F.wave * rows_per_wave; const int lane = ((int)threadIdx.x & 63);
    const int oi = lane >> 1; const float fb = oi < 8 ? A.in[5][oi] : 0.f;
    for (int rr = 0; rr < rows_per_wave; ++rr) {
        const int row = row0 + rr;
        const f32x4* xr = (const f32x4*)(A.in[0] + (size_t)row * DM) + lane;
        f32x4 v[4]; float s = 0.f;
#pragma unroll
        for (int j = 0; j < 4; ++j) { v[j] = xr[64 * j]; s += (v[j].x + v[j].y) + (v[j].z + v[j].w); }
        const float mean = wave_sum(s) * (1.f / DM); float s2 = 0.f;
#pragma unroll
        for (int j = 0; j < 4; ++j) { v[j] = v[j] - mean; s2 += (v[j].x * v[j].x + v[j].y * v[j].y) + (v[j].z * v[j].z + v[j].w * v[j].w); }
        const float rstd = 1.f / sqrtf(wave_sum(s2) * (1.f / DM) + LN_EPS);
        unsigned long long* o8 = (unsigned long long*)(WSP(bf16, WS_U) + (size_t)row * DM) + lane;
#pragma unroll
        for (int j = 0; j < 4; ++j) { const f32x4 sh = *(const LAS f32x4*)(mods + 256 * j + 4 * lane), scv = *(const LAS f32x4*)(mods + 1024 + 256 * j + 4 * lane);
            v[j] = v[j] * rstd * (scv + 1.0f) + sh;
            o8[64 * j] = (unsigned long long)pk2(v[j].x, v[j].y) | ((unsigned long long)pk2(v[j].z, v[j].w) << 32); }
        float part[32];
#pragma unroll
        for (int o = 0; o < 24; ++o) { float a = 0.f;
#pragma unroll
            for (int j = 0; j < 4; ++j) { const f32x4 w = *(const LAS f32x4*)(wsm + o * 1024 + 256 * j + 4 * lane); a += (v[j].x * w.x + v[j].y * w.y) + (v[j].z * w.z + v[j].w * w.w); }
            part[o] = a; if ((o & 3) == 3) asm volatile("" ::: "memory"); }
#pragma unroll
        for (int o = 24; o < 32; ++o) part[o] = 0.f;
        const float tot = reduce32(part, lane);
        if ((lane & 1) == 0) {
            if (oi < 8) WSP(float, WS_FFL)[(size_t)row * 8 + oi] = logsigmoidf(tot + fb) * LOG2E;
            else if (oi < 24) WSP(float, WS_GLR)[(size_t)row * 16 + (oi - 8)] = tot;
        }
    }
}

constexpr int GC = 64, GDK = 128, GDV = 256, GNCH = SEQ / GC, GITEMS = NB * 4 * GNCH;
constexpr int KST = 136, VST = 264, PST = 72;
__device__ __forceinline__ void fox_cumsum_item(Frame& F, int bh) {
    const int b = bh >> 3, h = bh & 7; LAS float* wt = (LAS float*)(F.lds + MISC_OFF);
    const float* src = WSP(float, WS_FFL) + (size_t)b * SEQ * 8 + h; float v[16]; float run = 0.f;
#pragma unroll
    for (int i = 0; i < 16; ++i) { run += src[(size_t)(((int)threadIdx.x) * 16 + i) * 8]; v[i] = run; }
    float incl = run;
#pragma unroll
    for (int o = 1; o < 64; o <<= 1) { const float n = __shfl_up(incl, o); if (((int)threadIdx.x & 63) >= o) incl += n; }
    if (((int)threadIdx.x & 63) == 63) wt[F.wave] = incl;
    __syncthreads();
    float base = incl - run;
    for (int w = 0; w < F.wave; ++w) base += wt[w];
    float* dst = WSP(float, WS_CUM) + (size_t)bh * SEQ + ((int)threadIdx.x) * 16;
#pragma unroll
    for (int i = 0; i < 16; i += 4) *(f32x4*)(dst + i) = (f32x4){v[i] + base, v[i + 1] + base, v[i + 2] + base, v[i + 3] + base};
    __syncthreads();
}
__device__ __forceinline__ float gla_decay(Frame& F, int h, const LAS float* glrS, LAS float* totS, float (&p)[16]) {
    const int c = ((int)threadIdx.x) & 127, tg = ((int)threadIdx.x) >> 7; float wg[16];
#pragma unroll
    for (int r = 0; r < 16; ++r) wg[r] = PT(6)[r * 512 + h * GDK + c];
    const float bg = PT(7)[h * GDK + c]; float run = 0.f;
#pragma unroll
    for (int i = 0; i < 16; ++i) { const LAS float* gr = glrS + (tg * 16 + i) * 16; float z = bg;
#pragma unroll
        for (int r = 0; r < 16; ++r) z += gr[r] * wg[r];
        run += logsigmoidf(z) * (1.0f / 16.0f); p[i] = run; }
    totS[tg * GDK + c] = run;
    __syncthreads();
    float off = 0.f, tot = 0.f;
#pragma unroll
    for (int g = 0; g < 4; ++g) { const float tv = totS[g * GDK + c]; tot += tv; if (g < tg) off += tv; }
#pragma unroll
    for (int i = 0; i < 16; ++i) p[i] += off;
    return tot;
}
__device__ __forceinline__ void gla_state_item(Frame& F, int item) {
    const int n = item & (GNCH - 1), bh = item >> 7, h = bh & 3, b = bh >> 2; const size_t r0 = (size_t)b * SEQ + (size_t)n * GC;
    LAS bf16* KtS = (LAS bf16*)F.lds;
    LAS bf16* VS = (LAS bf16*)(F.lds + 17408);
    LAS float* glrS = (LAS float*)(F.lds + 17408 + 33792);
    LAS float* totS = glrS + 1024;
    if (((int)threadIdx.x) < 256) ((LAS f32x4*)glrS)[((int)threadIdx.x)] = ((const f32x4*)(WSP(float, WS_GLR) + r0 * 16))[((int)threadIdx.x)];
#pragma unroll
    for (int i = 0; i < 4; ++i) { const int pc = ((int)threadIdx.x) + i * NTHR, t = pc >> 5, ch = pc & 31;
        *(LAS v4u*)(VS + t * VST + ch * 8) = *(const v4u*)(WSP(bf16, WS_GV) + (r0 + t) * 1024 + h * GDV + ch * 8); }
    __syncthreads();
    float p[16]; const float blast = gla_decay(F, h, glrS, totS, p);
    const int c = ((int)threadIdx.x) & 127, tg = ((int)threadIdx.x) >> 7;
#pragma unroll
    for (int i = 0; i < 16; ++i) { const int t = tg * 16 + i; const float kv = bf1(WSP(bf16, WS_GK)[(r0 + t) * 512 + h * GDK + c]);
        KtS[t * KST + c] = (bf16)f2bf(kv * __expf(blast - p[i])); }
    if (tg == 0) WSP(float, WS_DLAST)[(size_t)item * GDK + c] = __expf(blast);
    __syncthreads();
    f32x16 acc[4];
#pragma unroll
    for (int cb = 0; cb < 4; ++cb) acc[cb] = (f32x16){};
#pragma unroll
    for (int ks = 0; ks < 4; ++ks) { const bf16x8 a = frag_tr(VS, VST, 16 * ks, 32 * F.wave, ((int)threadIdx.x & 63));
#pragma unroll
        for (int cb = 0; cb < 4; ++cb) { const bf16x8 bb = frag_tr(KtS, KST, 16 * ks, 32 * cb, ((int)threadIdx.x & 63)); acc[cb] = __builtin_amdgcn_mfma_f32_32x32x16_bf16(a, bb, acc[cb], 0, 0, 0); } }
    bf16* us = WSP(bf16, WS_US) + (size_t)item * GDK * GDV; const int hh = ((int)threadIdx.x & 63) >> 5;
#pragma unroll
    for (int cb = 0; cb < 4; ++cb) { const int cc = 32 * cb + (((int)threadIdx.x & 63) & 31);
#pragma unroll
        for (int g = 0; g < 4; ++g) { v2u w; w.x = pk2(acc[cb][4 * g], acc[cb][4 * g + 1]); w.y = pk2(acc[cb][4 * g + 2], acc[cb][4 * g + 3]);
            *(v2u*)(us + (size_t)cc * GDV + 32 * F.wave + 8 * g + 4 * hh) = w; } }
    __syncthreads();
}
__device__ __forceinline__ void phase3(Frame& F) {
    if (F.blk < 32) fox_cumsum_item(F, F.blk);
    for (int it = F.blk; it < GITEMS; it += F.G) gla_state_item(F, it);
}

__device__ __forceinline__ void gla_scan(Frame& F) {
    const int NTOT = 16 * GDK * GDV / 4;
    for (int gt = F.blk * NTHR + ((int)threadIdx.x); gt < NTOT; gt += F.G * NTHR) {
        const int bh = gt / (GDK * GDV / 4), e4 = gt % (GDK * GDV / 4), c = e4 >> 6;
        bf16* p = WSP(bf16, WS_US) + (size_t)bh * GNCH * GDK * GDV + (size_t)e4 * 4; const float* dl = WSP(float, WS_DLAST) + (size_t)bh * GNCH * GDK + c;
        float s0 = 0.f, s1 = 0.f, s2 = 0.f, s3 = 0.f;
        for (int n0 = 0; n0 < GNCH; n0 += 8) { v2u u[8]; float d[8];
#pragma unroll
            for (int j = 0; j < 8; ++j) { u[j] = *(const v2u*)(p + (size_t)(n0 + j) * GDK * GDV); d[j] = dl[(size_t)(n0 + j) * GDK]; }
#pragma unroll
            for (int j = 0; j < 8; ++j) { v2u o; o.x = pk2(s0, s1); o.y = pk2(s2, s3); *(v2u*)(p + (size_t)(n0 + j) * GDK * GDV) = o;
                s0 = d[j] * s0 + bfl(u[j].x); s1 = d[j] * s1 + bfh(u[j].x); s2 = d[j] * s2 + bfl(u[j].y); s3 = d[j] * s3 + bfh(u[j].y); } }
    }
}

__device__ __forceinline__ void gla_out_item(Frame& F, int item) {
    const int n = item & (GNCH - 1), bh = item >> 7, h = bh & 3, b = bh >> 2; const size_t r0 = (size_t)b * SEQ + (size_t)n * GC;
    LAS bf16* QhS = (LAS bf16*)F.lds;
    LAS bf16* KcS = (LAS bf16*)(F.lds + 17408);
    LAS bf16* PS = (LAS bf16*)(F.lds + 34816);
    LAS bf16* VS = (LAS bf16*)(F.lds + 44032);
    LAS bf16* SS = (LAS bf16*)(F.lds + 77824);
    LAS float* glrS = (LAS float*)(F.lds + 145408);
    LAS float* totS = glrS + 1024;
    LAS float* oS = (LAS float*)(F.lds + 44032);
    if (((int)threadIdx.x) < 256) ((LAS f32x4*)glrS)[((int)threadIdx.x)] = ((const f32x4*)(WSP(float, WS_GLR) + r0 * 16))[((int)threadIdx.x)];
#pragma unroll
    for (int i = 0; i < 4; ++i) { const int pc = ((int)threadIdx.x) + i * NTHR, t = pc >> 5, ch = pc & 31;
        *(LAS v4u*)(VS + t * VST + ch * 8) = *(const v4u*)(WSP(bf16, WS_GV) + (r0 + t) * 1024 + h * GDV + ch * 8); }
    { const bf16* sp = WSP(bf16, WS_US) + (size_t)item * GDK * GDV;
#pragma unroll
      for (int i = 0; i < 8; ++i) { const int pc = ((int)threadIdx.x) + i * NTHR, cc = pc >> 5, ch = pc & 31; *(LAS v4u*)(SS + cc * VST + ch * 8) = *(const v4u*)(sp + (size_t)cc * GDV + ch * 8); } }
    __syncthreads();
    float p[16]; (void)gla_decay(F, h, glrS, totS, p);
    { const int c = ((int)threadIdx.x) & 127, tg = ((int)threadIdx.x) >> 7;
#pragma unroll
      for (int i = 0; i < 16; ++i) { const int t = tg * 16 + i; const size_t go = (r0 + t) * 512 + h * GDK + c;
          const float qv = bf1(WSP(bf16, WS_GQ)[go]), kv = bf1(WSP(bf16, WS_GK)[go]);
          QhS[t * KST + c] = (bf16)f2bf(qv * __expf(p[i])); KcS[t * KST + c] = (bf16)f2bf(kv * __expf(-p[i])); } }
    __syncthreads();
    if (F.wave < 4) { const int tb = F.wave >> 1, sb = F.wave & 1; f32x16 pa = (f32x16){};
#pragma unroll
        for (int ks = 0; ks < 8; ++ks) pa = __builtin_amdgcn_mfma_f32_32x32x16_bf16(frag_row(QhS, KST, 32 * tb, 16 * ks, ((int)threadIdx.x & 63)), frag_row(KcS, KST, 32 * sb, 16 * ks, ((int)threadIdx.x & 63)), pa, 0, 0, 0);
        const int s = 32 * sb + (((int)threadIdx.x & 63) & 31), hh = ((int)threadIdx.x & 63) >> 5;
#pragma unroll
        for (int r = 0; r < 16; ++r) { const int t = 32 * tb + crow16(r, hh); PS[t * PST + s] = (bf16)f2bf(s <= t ? pa[r] : 0.f); } }
    __syncthreads();
    f32x16 acc[2]; acc[0] = (f32x16){}; acc[1] = (f32x16){};
#pragma unroll
    for (int ks = 0; ks < 8; ++ks) { const bf16x8 bb = frag_tr(SS, VST, 16 * ks, 32 * F.wave, ((int)threadIdx.x & 63));
#pragma unroll
        for (int tb = 0; tb < 2; ++tb) acc[tb] = __builtin_amdgcn_mfma_f32_32x32x16_bf16(frag_row(QhS, KST, 32 * tb, 16 * ks, ((int)threadIdx.x & 63)), bb, acc[tb], 0, 0, 0); }
#pragma unroll
    for (int ks = 0; ks < 4; ++ks) { const bf16x8 bb = frag_tr(VS, VST, 16 * ks, 32 * F.wave, ((int)threadIdx.x & 63));
#pragma unroll
        for (int tb = 0; tb < 2; ++tb) acc[tb] = __builtin_amdgcn_mfma_f32_32x32x16_bf16(frag_row(PS, PST, 32 * tb, 16 * ks, ((int)threadIdx.x & 63)), bb, acc[tb], 0, 0, 0); }
    __syncthreads();
    { const int dv = 32 * F.wave + (((int)threadIdx.x & 63) & 31), hh = ((int)threadIdx.x & 63) >> 5;
#pragma unroll
      for (int tb = 0; tb < 2; ++tb)
#pragma unroll
          for (int r = 0; r < 16; ++r) oS[(32 * tb + crow16(r, hh)) * 260 + dv] = acc[tb][r]; }
    __syncthreads();
    { const f32x4 gn = *(gf4ptr_t)(PT(8) + h * GDV + 4 * ((int)threadIdx.x & 63));
#pragma unroll 2
      for (int i = 0; i < 8; ++i) { const int t = 8 * F.wave + i; const f32x4 o = *(const LAS f32x4*)(oS + t * 260 + 4 * ((int)threadIdx.x & 63));
          const float ss = wave_sum((o.x * o.x + o.y * o.y) + (o.z * o.z + o.w * o.w)); const float rs = 1.f / sqrtf(ss * (1.f / GDV) + LN_EPS);
          const v2u g = *(const v2u*)(WSP(bf16, WS_GR) + (r0 + t) * 1024 + h * GDV + 4 * ((int)threadIdx.x & 63));
          const float g0 = bfl(g.x), g1 = bfh(g.x), g2 = bfl(g.y), g3 = bfh(g.y);
          v2u w; w.x = pk2(o.x * rs * gn.x * (g0 * sigmoidf_(g0)), o.y * rs * gn.y * (g1 * sigmoidf_(g1))); w.y = pk2(o.z * rs * gn.z * (g2 * sigmoidf_(g2)), o.w * rs * gn.w * (g3 * sigmoidf_(g3)));
          *(v2u*)(WSP(bf16, WS_GV) + (r0 + t) * 1024 + h * GDV + 4 * ((int)threadIdx.x & 63)) = w; } }
    __syncthreads();
}

__device__ __forceinline__ void phase9(Frame& F) {
    LAS float* wr = (LAS float*)F.lds;
    LAS int* lcnt = (LAS int*)(F.lds + MISC_OFF);
    LAS int* rec_e = lcnt + 64; LAS int* rec_i = rec_e + 512; LAS float* rec_g = (LAS float*)(rec_i + 512);
    const int rows_per_blk = T / F.G, rows_per_wave = rows_per_blk / NWAVES;
    const int b = F.blk / (F.G / NB); const int lane = ((int)threadIdx.x & 63);
    for (int i = ((int)threadIdx.x); i < 32 * 1024 / 4; i += NTHR) ((LAS f32x4*)wr)[i] = WSP(f32x4, WS_WRT)[i];
    if (((int)threadIdx.x) < 64) lcnt[((int)threadIdx.x)] = 0;
    __syncthreads();
    const float* modf = WSP(float, WS_MODF) + (size_t)b * 6144;
    const int ei = lane >> 1; const float rb = PT(15)[ei];
    for (int rr = 0; rr < rows_per_wave; ++rr) {
        const int rl = F.wave * rows_per_wave + rr, row = F.blk * rows_per_blk + rl;
        f32x4* zr = (f32x4*)(F.out + (size_t)row * DM) + lane;
        f32x4 v[4]; float s = 0.f;
#pragma unroll
        for (int j = 0; j < 4; ++j) { v[j] = zr[64 * j]; s += (v[j].x + v[j].y) + (v[j].z + v[j].w); }
        float mean = wave_sum(s) * (1.f / DM), s2 = 0.f;
#pragma unroll
        for (int j = 0; j < 4; ++j) { v[j] = v[j] - mean; s2 += (v[j].x * v[j].x + v[j].y * v[j].y) + (v[j].z * v[j].z + v[j].w * v[j].w); }
        float rstd = 1.f / sqrtf(wave_sum(s2) * (1.f / DM) + LN_EPS);
        s = 0.f;
#pragma unroll
        for (int j = 0; j < 4; ++j) { const f32x4 g = *(gf4ptr_t)(PT(12) + 256 * j + 4 * lane), bb = *(gf4ptr_t)(PT(13) + 256 * j + 4 * lane);
            v[j] = v[j] * rstd * g + bb; zr[64 * j] = v[j]; s += (v[j].x + v[j].y) + (v[j].z + v[j].w); }
        mean = wave_sum(s) * (1.f / DM); s2 = 0.f;
#pragma unroll
        for (int j = 0; j < 4; ++j) { v[j] = v[j] - mean; s2 += (v[j].x * v[j].x + v[j].y * v[j].y) + (v[j].z * v[j].z + v[j].w * v[j].w); }
        rstd = 1.f / sqrtf(wave_sum(s2) * (1.f / DM) + LN_EPS);
        unsigned long long* o8 = (unsigned long long*)(WSP(bf16, WS_U2) + (size_t)row * DM) + lane;
#pragma unroll
        for (int j = 0; j < 4; ++j) { const f32x4 sh = *(const f32x4*)(modf + 3072 + 256 * j + 4 * lane), scv = *(const f32x4*)(modf + 4096 + 256 * j + 4 * lane);
            v[j] = v[j] * rstd * (scv + 1.0f) + sh;
            o8[64 * j] = (unsigned long long)pk2(v[j].x, v[j].y) | ((unsigned long long)pk2(v[j].z, v[j].w) << 32); }
        float part[32];
#pragma unroll
        for (int o = 0; o < 32; ++o) { float a = 0.f;
#pragma unroll
            for (int j = 0; j < 4; ++j) { const f32x4 w = *(const LAS f32x4*)(wr + o * 1024 + 256 * j + 4 * lane); a += (v[j].x * w.x + v[j].y * w.y) + (v[j].z * w.z + v[j].w * w.w); }
            part[o] = a; if ((o & 3) == 3) asm volatile("" ::: "memory"); }
        float lg = reduce32(part, lane) + rb;
        int ek[4]; float vk[4];
#pragma unroll
        for (int k = 0; k < 4; ++k) { const float m = wave_max(lg); const unsigned long long bal = __ballot(lg == m); const int src = __ffsll((long long)bal) - 1;
            ek[k] = src >> 1; vk[k] = m; if (ei == ek[k]) lg = -INFINITY; }
        const float w1 = __expf(vk[1] - vk[0]), w2 = __expf(vk[2] - vk[0]), w3 = __expf(vk[3] - vk[0]); const float inv = 1.f / (1.f + w1 + w2 + w3);
        if (lane < 4) { const int e = lane == 0 ? ek[0] : lane == 1 ? ek[1] : lane == 2 ? ek[2] : ek[3]; const float gk = (lane == 0 ? 1.f : lane == 1 ? w1 : lane == 2 ? w2 : w3) * inv;
            const int li = atomicAdd((int*)(lcnt + e), 1);
            rec_e[rl * 4 + lane] = e; rec_i[rl * 4 + lane] = li; rec_g[rl * 4 + lane] = gk; }
    }
    __syncthreads();
    if (((int)threadIdx.x) < 32) lcnt[32 + ((int)threadIdx.x)] = (int)atomicAdd(WSP(unsigned, WS_CTL) + ((int)threadIdx.x), (unsigned)lcnt[((int)threadIdx.x)]);
    __syncthreads();
    for (int r = ((int)threadIdx.x); r < rows_per_blk * 4; r += NTHR) { const int e = rec_e[r], idx = lcnt[32 + e] + rec_i[r], tok = F.blk * rows_per_blk + (r >> 2);
        WSP(int, WS_RTOK)[e * ECAP + idx] = tok; WSP(int, WS_TSLOT)[(size_t)tok * 4 + (r & 3)] = e * ECAP + idx; WSP(float, WS_TGATE)[(size_t)tok * 4 + (r & 3)] = rec_g[r]; }
    __syncthreads();
}
__device__ __forceinline__ void moe_tables(Frame& F, LAS int* tstart) {
    if (((int)threadIdx.x) == 0) { int run = 0; for (int e = 0; e < NEXP; ++e) { tstart[e] = run; run += (int)((WSP(unsigned, WS_CTL)[e] + 255u) >> 8); } tstart[NEXP] = run; }
    __syncthreads();
}
__device__ __forceinline__ void phase12(Frame& F) {
    LAS int* tstart = (LAS int*)(F.lds + MISC_OFF);
    moe_tables(F, tstart);
    const int rows_per_blk = T / F.G, rows_per_wave = rows_per_blk / NWAVES; const int b = F.blk / (F.G / NB); const int lane = ((int)threadIdx.x & 63);
    const float* modf = WSP(float, WS_MODF) + (size_t)b * 6144;
    for (int rr = 0; rr < rows_per_wave; ++rr) {
        const int row = F.blk * rows_per_blk + F.wave * rows_per_wave + rr;
        f32x4* xr = (f32x4*)(F.out + (size_t)row * DM) + lane;
        f32x4 y[4];
#pragma unroll
        for (int j = 0; j < 4; ++j) y[j] = (f32x4){0.f, 0.f, 0.f, 0.f};
#pragma unroll
        for (int k = 0; k < 4; ++k) { const int sl = WSP(int, WS_TSLOT)[(size_t)row * 4 + k]; const float gk = WSP(float, WS_TGATE)[(size_t)row * 4 + k];
            const int e = sl >> 15, idx = sl & (ECAP - 1); const size_t srow = (size_t)tstart[e] * 256 + idx;
            const v2u* mp = (const v2u*)(WSP(bf16, WS_MOE) + srow * DM) + lane;
#pragma unroll
            for (int j = 0; j < 4; ++j) { const v2u w = mp[64 * j]; y[j].x += gk * bfl(w.x); y[j].y += gk * bfh(w.x); y[j].z += gk * bfl(w.y); y[j].w += gk * bfh(w.y); } }
        f32x4 v[4]; float s = 0.f;
#pragma unroll
        for (int j = 0; j < 4; ++j) { const f32x4 g2 = *(const f32x4*)(modf + 5120 + 256 * j + 4 * lane); v[j] = xr[64 * j] * ALPHA + (g2 + 1.0f) * y[j]; s += (v[j].x + v[j].y) + (v[j].z + v[j].w); }
        const float mean = wave_sum(s) * (1.f / DM); float s2 = 0.f;
#pragma unroll
        for (int j = 0; j < 4; ++j) { v[j] = v[j] - mean; s2 += (v[j].x * v[j].x + v[j].y * v[j].y) + (v[j].z * v[j].z + v[j].w * v[j].w); }
        const float rstd = 1.f / sqrtf(wave_sum(s2) * (1.f / DM) + LN_EPS);
#pragma unroll
        for (int j = 0; j < 4; ++j) { const f32x4 g = *(gf4ptr_t)(PT(20) + 256 * j + 4 * lane), bb = *(gf4ptr_t)(PT(21) + 256 * j + 4 * lane); xr[64 * j] = v[j] * rstd * g + bb; }
    }
}

constexpr int NPHASE = 13;
__global__ void __launch_bounds__(NTHR, 2) fwd_kernel(Args args) {
    extern __shared__ __attribute__((aligned(16))) unsigned char lds[];
    Frame F;
    F.lds = (LAS unsigned char*)lds; F.wave = __builtin_amdgcn_readfirstlane((int)threadIdx.x >> 6); F.G = gridDim.x; F.blk = blockIdx.x;
    F.out = args.out; F.ws = args.ws;
    const int lo = args.ph_lo, hi = args.ph_hi;
#ifndef PH_MASK
#define PH_MASK 0xffff
#endif
#define IN(k) (((PH_MASK >> (k)) & 1) && lo <= (k) && (k) < hi)
#if MK_N_LAUNCHES == 1
    if (threadIdx.x < 2) ((LAS unsigned*)(F.lds + BARLDS_OFF))[threadIdx.x] = 0u;
    __syncthreads();
    const XcdBarrier bar = xcd_barrier_post(WSP(unsigned, WS_CTL) + CW_BAR, (volatile LAS unsigned*)(F.lds + BARLDS_OFF));
#define SEAM(k) do { if (IN(k) && IN((k) + 1)) { if ((k) == 0) cg::this_grid().sync(); else xcd_barrier(bar); } } while (0)
#else
#define SEAM(k) do { } while (0)
#endif
    typedef pg8::bf16_t pbf;
    if (IN(0)) { phase0(F, args); } SEAM(0);
    if (IN(1)) { phase1(F, args); } SEAM(1);
    if (IN(2)) {
        pg8::Gemm g{WSP(pbf, WS_U), WSP(pbf, WS_WIN), 1024, nullptr}; pg8::DenseOrder S{T / 256, NPROJ / 256, F.G, F.blk};
        pg8::EpiInProj E{WSP(pbf, WS_FQ), WSP(pbf, WS_FK), WSP(pbf, WS_FV), WSP(pbf, WS_GQ), WSP(pbf, WS_GK), WSP(pbf, WS_GV), WSP(pbf, WS_GR), WSP(pbf, WS_GA), WSP(pbf, WS_GB), 0.125f * LOG2E, 0.08838834764831845f};
        pg8::gemm_phase<pg8::EpiInProj, pg8::DenseOrder, false, true>(F.lds, g, S, E);
    } SEAM(2);
    if (IN(3)) { phase3(F); } SEAM(3);
    if (IN(4)) {
        gla_scan(F);
        __syncthreads();
        const attn_body::AttnTensors AT{(const attn_body::bf16*)WSP(pbf, WS_FQ), (const attn_body::bf16*)WSP(pbf, WS_FK), (const attn_body::bf16*)WSP(pbf, WS_FV), (attn_body::bf16*)WSP(pbf, WS_FQ), WSP(float, WS_CUM)};
        const attn_body::StaticOrder S((int)F.G, (int)F.blk);
        attn_body::attn_phase<attn_body::StaticOrder>((char*)lds, AT, S);
    } SEAM(4);
    if (IN(5)) { for (int it = F.blk; it < GITEMS; it += F.G) gla_out_item(F, it); } SEAM(5);
    if (IN(6)) {
        pg8::Gemm g{WSP(pbf, WS_FQ), WSP(pbf, WS_WA), 512, nullptr}; pg8::DenseOrder S{T / 256, 4, F.G, F.blk};
        pg8::EpiGate<false> E{WSP(pbf, WS_U), WSP(pbf, WS_GA)};
        pg8::gemm_phase<pg8::EpiGate<false>, pg8::DenseOrder, false, true>(F.lds, g, S, E);
    }
    if (IN(6) && IN(7)) { __syncthreads(); }
    if (IN(7)) {
        pg8::Gemm g{WSP(pbf, WS_GV), WSP(pbf, WS_WB), 1024, nullptr}; pg8::DenseOrder S{T / 256, 4, F.G, F.blk};
        pg8::EpiGate<true> E{WSP(pbf, WS_U), WSP(pbf, WS_GB)};
        pg8::gemm_phase<pg8::EpiGate<true>, pg8::DenseOrder, false, true>(F.lds, g, S, E);
    } SEAM(7);
    if (IN(8)) {
        pg8::Gemm g{WSP(pbf, WS_U), WSP(pbf, WS_WO), 1024, nullptr}; pg8::DenseOrder S{T / 256, 4, F.G, F.blk};
        pg8::EpiResid E{PT(0), F.out, WSP(float, WS_MODF) + 2048, 6144, SEQ, ALPHA};
        pg8::gemm_phase<pg8::EpiResid, pg8::DenseOrder, false, true>(F.lds, g, S, E);
    } SEAM(8);
    if (IN(9)) { phase9(F); } SEAM(9);
    if (IN(10)) {
        LAS int* tstart = (LAS int*)(F.lds + MISC_OFF); moe_tables(F, tstart);
        pg8::Gemm g{WSP(pbf, WS_U2), WSP(pbf, WS_WUP), 1024, WSP(int, WS_RTOK)}; pg8::MoeOrder S{tstart[NEXP], 8, F.G, F.blk, tstart};
        pg8::EpiSwiglu E{WSP(pbf, WS_ACT), PT(17), 8};
        pg8::gemm_phase<pg8::EpiSwiglu, pg8::MoeOrder, true, true>(F.lds, g, S, E);
    } SEAM(10);
    if (IN(11)) {
        LAS int* tstart = (LAS int*)(F.lds + MISC_OFF); moe_tables(F, tstart);
        pg8::Gemm g{WSP(pbf, WS_ACT), WSP(pbf, WS_WDN), 1024, nullptr}; pg8::MoeOrder S{tstart[NEXP], 4, F.G, F.blk, tstart};
        pg8::EpiDown E{WSP(pbf, WS_MOE), PT(19), 4};
        pg8::gemm_phase<pg8::EpiDown, pg8::MoeOrder, false, true>(F.lds, g, S, E);
    } SEAM(11);
    if (IN(12)) { phase12(F); }
#undef IN
#undef SEAM
}

extern "C" void kernel_launch(void* const* d_in, const int* in_sizes, int n_in, void* d_out, int out_size, void* d_ws, size_t ws_size, hipStream_t stream) {
    static int grid = 0;
    if (grid == 0) {
        if (n_in != 22 || in_sizes[0] != T * DM || out_size != T * DM || ws_size < WS_END) { fprintf(stderr, "kernel_launch: unexpected shapes (n_in %d, x %d, out %d, ws %zu < %zu); nothing launched\n", n_in, n_in > 0 ? in_sizes[0] : -1, out_size, ws_size, (size_t)WS_END); grid = -1; return; }
        int dev = 0, cus = 0, per_cu = 0;
        if (hipGetDevice(&dev) != hipSuccess || hipDeviceGetAttribute(&cus, hipDeviceAttributeMultiprocessorCount, dev) != hipSuccess) { grid = -1; return; }
        if (hipFuncSetAttribute((const void*)fwd_kernel, hipFuncAttributeMaxDynamicSharedMemorySize, LDS_BYTES) != hipSuccess) { fprintf(stderr, "kernel_launch: hipFuncSetAttribute failed\n"); grid = -1; return; }
        if (hipOccupancyMaxActiveBlocksPerMultiprocessor(&per_cu, (const void*)fwd_kernel, NTHR, LDS_BYTES) != hipSuccess || per_cu < 1) { fprintf(stderr, "kernel_launch: occupancy query says %d blocks per CU\n", per_cu); (void)hipGetLastError(); grid = -1; return; }
        grid = cus;
        if (grid != 256) { fprintf(stderr, "kernel_launch: built for a 256-CU device, found %d CUs; nothing launched\n", cus); grid = -1; return; }
    }
    if (grid < 0) return;
    if (hipMemsetAsync((char*)d_ws + WS_CTL, 0, CTL_ZERO_BYTES, stream) != hipSuccess) { fprintf(stderr, "kernel_launch: hipMemsetAsync failed\n"); return; }
    Args a{};
    for (int i = 0; i < 22; ++i) a.in[i] = (const float*)d_in[i];
    a.out = (float*)d_out; a.ws = (unsigned char*)d_ws;
#if MK_N_LAUNCHES == 1
    a.ph_lo = 0; a.ph_hi = NPHASE;
    void* kargs[] = {&a};
    hipError_t e = hipLaunchCooperativeKernel((const void*)fwd_kernel, dim3(grid), dim3(NTHR), kargs, LDS_BYTES, stream);
    if (e != hipSuccess) fprintf(stderr, "kernel_launch: cooperative launch failed: %s\n", hipGetErrorString(e));
#else
    for (int p = 0; p < NPHASE; ++p) {
        if (p == 7) continue;
        a.ph_lo = p; a.ph_hi = (p == 6) ? 8 : p + 1;
        hipLaunchKernelGGL(fwd_kernel, dim3(grid), dim3(NTHR), LDS_BYTES, stream, a);
    }
#endif
}
```

```cpp
#include <hip/hip_runtime.h>
#include <hip/hip_bf16.h>
#include <hip/hip_cooperative_groups.h>
#include <cstdio>
#include <cstdint>
#include <cmath>
namespace cg = cooperative_groups;

#ifndef MK_N_LAUNCHES
#define MK_N_LAUNCHES 1
#endif

namespace pg8 {
#define PG8_LAS __attribute__((address_space(3)))
#define PG8_GAS __attribute__((address_space(1)))
typedef unsigned short bf16_t;
typedef short bf16x8 __attribute__((ext_vector_type(8)));
typedef float f32x4 __attribute__((ext_vector_type(4)));
typedef float f32x2 __attribute__((ext_vector_type(2)));
typedef unsigned u32x4 __attribute__((ext_vector_type(4)));
constexpr int BM = 256, BK = 64, HALF = 128, HTB = HALF * BK * 2, STAGE_BYTES = 8 * HTB, NXCD = 8, WGM = 8;

__host__ __device__ __forceinline__ int lds_byte(int r, int c) { const int st = (r >> 4) * 2 + (c >> 5), rr = r & 15, cc = c & 31, ob = rr * 64 + cc * 2; return st * 1024 + (ob ^ (((ob >> 9) & 1) << 5)); }
__host__ __device__ __forceinline__ void stage_rc(int b, int& R, int& C) { const int st = b / 1024, sb = b % 1024, swz = sb ^ (((sb >> 9) & 1) << 5); R = (st >> 1) * 16 + swz / 64; C = (st & 1) * 32 + (swz % 64) / 2; }
__host__ __device__ __forceinline__ int perm32(int rho) { const int n = rho >> 4, i = rho & 15; return 8 * (i >> 2) + 4 * n + (i & 3); }

struct Unit { int pm, pn, e, rl; };
struct Gemm { const bf16_t* A; const bf16_t* Bt; int K; const int* rows; };

__device__ __forceinline__ bool tile_of(long L, int nM, int nN, int& pm, int& pn) {
    const int nwg = nM * nN; if (L >= nwg) return false;
    int wgid = (int)L; { const int q = nwg / NXCD, r = nwg % NXCD, xcd = wgid % NXCD, off = wgid / NXCD; wgid = (xcd < r ? xcd * (q + 1) : r * (q + 1) + (xcd - r) * q) + off; }
    const int nig = WGM * nN, gid = wgid / nig, fm = gid * WGM, gsz = (nM - fm) < WGM ? (nM - fm) : WGM;
    pm = fm + ((wgid % nig) % gsz); pn = (wgid % nig) / gsz; return true;
}
struct DenseOrder {
    int nM, nN, G, c;
    __device__ __forceinline__ bool next(int i, Unit& u) const { u.e = 0; u.rl = 0; return tile_of((long)i * G + c, nM, nN, u.pm, u.pn); }
};
struct MoeOrder {
    int nM, nN, G, c; const PG8_LAS int* tstart;
    __device__ __forceinline__ bool next(int i, Unit& u) const {
        int rt, pnl; if (!tile_of((long)i * G + c, nM, nN, rt, pnl)) return false;
        int e = 0;
#pragma unroll 1
        for (int j = 1; j < 32; ++j) if (tstart[j] <= rt) e = j;
        u.pm = rt; u.e = e; u.pn = e * nN + pnl; u.rl = e * 32768 + (rt - tstart[e]) * 256; return true;
    }
};

__device__ __forceinline__ unsigned cvt_pk_bf16(float lo, float hi) { unsigned r; asm volatile("v_cvt_pk_bf16_f32 %0, %1, %2" : "=v"(r) : "v"(lo), "v"(hi)); return r; }
__device__ __forceinline__ float bf_lo(unsigned w) { return __uint_as_float(w << 16); }
__device__ __forceinline__ float bf_hi(unsigned w) { return __uint_as_float(w & 0xffff0000u); }
__device__ __forceinline__ float sigm(float x) { return 1.0f / (1.0f + __expf(-x)); }


struct EpiInProj {
    static constexpr bool PERM = true;
    bf16_t *fq, *fk, *fv, *gq, *gk, *gv, *gr, *ga, *gb; float qscale, gqscale;
    __device__ __forceinline__ void operator()(const f32x4 (&acc)[2][2][4][2], const Unit& u, int wr, int wc, int fr, int fq_) const {
        const int pn = u.pn; bf16_t* base; int ldc, ct; float sc = 1.f; bool sg = false;
        if (pn < 2) { base = fq; ldc = 512; ct = pn; sc = qscale; } else if (pn < 4) { base = fk; ldc = 512; ct = pn - 2; } else if (pn < 6) { base = fv; ldc = 512; ct = pn - 4; }
        else if (pn < 8) { base = gq; ldc = 512; ct = pn - 6; sc = gqscale; } else if (pn < 10) { base = gk; ldc = 512; ct = pn - 8; }
        else if (pn < 14) { base = gv; ldc = 1024; ct = pn - 10; } else if (pn < 18) { base = gr; ldc = 1024; ct = pn - 14; }
        else if (pn < 22) { base = ga; ldc = 1024; ct = pn - 18; sg = true; } else { base = gb; ldc = 1024; ct = pn - 22; sg = true; }
        const int row0 = u.pm * BM + wr * 64 + fr, col0 = ct * BM + wc * 32 + 8 * fq_;
#pragma unroll
        for (int ai = 0; ai < 2; ++ai)
#pragma unroll
            for (int m = 0; m < 4; ++m) { bf16_t* rowp = base + (size_t)(row0 + ai * HALF + m * 16) * ldc + col0;
#pragma unroll
                for (int bj = 0; bj < 2; ++bj) { f32x4 v0 = acc[ai][bj][m][0], v1 = acc[ai][bj][m][1];
                    if (sg) {
#pragma unroll
                        for (int i = 0; i < 4; ++i) { v0[i] = sigm(v0[i]); v1[i] = sigm(v1[i]); } }
                    else { v0 = v0 * sc; v1 = v1 * sc; }
                    u32x4 w; w.x = cvt_pk_bf16(v0[0], v0[1]); w.y = cvt_pk_bf16(v0[2], v0[3]); w.z = cvt_pk_bf16(v1[0], v1[1]); w.w = cvt_pk_bf16(v1[2], v1[3]);
                    *(u32x4*)(rowp + bj * HALF) = w; } }
    }
};
template <bool ADD> struct EpiGate {
    static constexpr bool PERM = true;
    bf16_t* O; const bf16_t* gate;
    __device__ __forceinline__ void operator()(const f32x4 (&acc)[2][2][4][2], const Unit& u, int wr, int wc, int fr, int fq_) const {
        const int row0 = u.pm * BM + wr * 64 + fr, col0 = u.pn * BM + wc * 32 + 8 * fq_;
#pragma unroll
        for (int ai = 0; ai < 2; ++ai)
#pragma unroll
            for (int m = 0; m < 4; ++m) { const size_t off = (size_t)(row0 + ai * HALF + m * 16) * 1024 + col0;
#pragma unroll
                for (int bj = 0; bj < 2; ++bj) { const f32x4 a0 = acc[ai][bj][m][0], a1 = acc[ai][bj][m][1];
                    const u32x4 g = *(const u32x4*)(gate + off + bj * HALF);
                    float r[8] = { a0[0] * bf_lo(g.x), a0[1] * bf_hi(g.x), a0[2] * bf_lo(g.y), a0[3] * bf_hi(g.y), a1[0] * bf_lo(g.z), a1[1] * bf_hi(g.z), a1[2] * bf_lo(g.w), a1[3] * bf_hi(g.w) };
                    if (ADD) { const u32x4 o = *(const u32x4*)(O + off + bj * HALF);
                        r[0] += bf_lo(o.x); r[1] += bf_hi(o.x); r[2] += bf_lo(o.y); r[3] += bf_hi(o.y); r[4] += bf_lo(o.z); r[5] += bf_hi(o.z); r[6] += bf_lo(o.w); r[7] += bf_hi(o.w); }
                    u32x4 w; w.x = cvt_pk_bf16(r[0], r[1]); w.y = cvt_pk_bf16(r[2], r[3]); w.z = cvt_pk_bf16(r[4], r[5]); w.w = cvt_pk_bf16(r[6], r[7]);
                    *(u32x4*)(O + off + bj * HALF) = w; } }
    }
};
struct EpiResid {
    static constexpr bool PERM = false;
    const PG8_GAS float* x; float* z; const float* g1; int g1_bstride; int rows_per_batch; float alpha;
    __device__ __forceinline__ void operator()(const f32x4 (&acc)[2][2][4][2], const Unit& u, int wr, int wc, int fr, int fq_) const {
        const int row0 = u.pm * BM + wr * 64 + fr, col0 = u.pn * BM + wc * 32 + 4 * fq_;
        const float* gp = g1 + (size_t)((u.pm * BM) / rows_per_batch) * g1_bstride + col0;
        f32x4 gv[2][2];
#pragma unroll
        for (int bj = 0; bj < 2; ++bj)
#pragma unroll
            for (int n = 0; n < 2; ++n) gv[bj][n] = *(const f32x4*)(gp + bj * HALF + n * 16) + 1.0f;
#pragma unroll
        for (int ai = 0; ai < 2; ++ai)
#pragma unroll
            for (int m = 0; m < 4; ++m) { const size_t off = (size_t)(row0 + ai * HALF + m * 16) * 1024 + col0;
#pragma unroll
                for (int bj = 0; bj < 2; ++bj)
#pragma unroll
                    for (int n = 0; n < 2; ++n) { const f32x4 xv = *(const PG8_GAS f32x4*)(x + off + bj * HALF + n * 16);
                        *(f32x4*)(z + off + bj * HALF + n * 16) = xv * alpha + gv[bj][n] * acc[ai][bj][m][n]; } }
    }
};
struct EpiSwiglu {
    static constexpr bool PERM = true;
    bf16_t* act; const PG8_GAS float* b_up; int nNe;
    __device__ __forceinline__ void operator()(const f32x4 (&acc)[2][2][4][2], const Unit& u, int wr, int wc, int fr, int fq_) const {
        const int pnl = u.pn - u.e * nNe; const int row0 = u.pm * BM + wr * 64 + fr, cl = pnl * HALF + wc * 32 + 8 * fq_;
        const PG8_GAS float* bp = b_up + (size_t)u.e * 2048 + cl;
        const f32x4 bg0 = *(const PG8_GAS f32x4*)(bp), bg1 = *(const PG8_GAS f32x4*)(bp + 4), bl0 = *(const PG8_GAS f32x4*)(bp + 1024), bl1 = *(const PG8_GAS f32x4*)(bp + 1028);
#pragma unroll
        for (int ai = 0; ai < 2; ++ai)
#pragma unroll
            for (int m = 0; m < 4; ++m) {
                f32x4 g0 = acc[ai][0][m][0] + bg0, g1 = acc[ai][0][m][1] + bg1, l0 = acc[ai][1][m][0] + bl0, l1 = acc[ai][1][m][1] + bl1; float r[8];
#pragma unroll
                for (int i = 0; i < 4; ++i) { float g = fminf(g0[i], 7.0f), l = fminf(fmaxf(l0[i], -7.0f), 7.0f); r[i] = g * sigm(1.702f * g) * (l + 1.0f);
                    g = fminf(g1[i], 7.0f); l = fminf(fmaxf(l1[i], -7.0f), 7.0f); r[4 + i] = g * sigm(1.702f * g) * (l + 1.0f); }
                u32x4 w; w.x = cvt_pk_bf16(r[0], r[1]); w.y = cvt_pk_bf16(r[2], r[3]); w.z = cvt_pk_bf16(r[4], r[5]); w.w = cvt_pk_bf16(r[6], r[7]);
                *(u32x4*)(act + (size_t)(row0 + ai * HALF + m * 16) * 1024 + cl) = w; }
    }
};
struct EpiDown {
    static constexpr bool PERM = true;
    bf16_t* O; const PG8_GAS float* b_down; int nNe;
    __device__ __forceinline__ void operator()(const f32x4 (&acc)[2][2][4][2], const Unit& u, int wr, int wc, int fr, int fq_) const {
        const int pnl = u.pn - u.e * nNe; const int row0 = u.pm * BM + wr * 64 + fr, col0 = pnl * BM + wc * 32 + 8 * fq_;
        const PG8_GAS float* bp = b_down + (size_t)u.e * 1024 + col0;
        f32x4 bv[2][2];
#pragma unroll
        for (int bj = 0; bj < 2; ++bj)
#pragma unroll
            for (int n = 0; n < 2; ++n) bv[bj][n] = *(const PG8_GAS f32x4*)(bp + bj * HALF + 4 * n);
#pragma unroll
        for (int ai = 0; ai < 2; ++ai)
#pragma unroll
            for (int m = 0; m < 4; ++m) { bf16_t* rowp = O + (size_t)(row0 + ai * HALF + m * 16) * 1024 + col0;
#pragma unroll
                for (int bj = 0; bj < 2; ++bj) { const f32x4 v0 = acc[ai][bj][m][0] + bv[bj][0], v1 = acc[ai][bj][m][1] + bv[bj][1];
                    u32x4 w; w.x = cvt_pk_bf16(v0[0], v0[1]); w.y = cvt_pk_bf16(v0[2], v0[3]); w.z = cvt_pk_bf16(v1[0], v1[1]); w.w = cvt_pk_bf16(v1[2], v1[3]);
                    *(u32x4*)(rowp + bj * HALF) = w; } }
    }
};

template <class Epi, class Sched, bool GATHER, bool ALIGN_EPI>
__device__ __forceinline__ void gemm_phase(PG8_LAS unsigned char* lds, const Gemm g, const Sched& S, const Epi& E) {
    int tid_l = threadIdx.x; asm volatile("" : "+v"(tid_l));
    const int tid = tid_l, wid = __builtin_amdgcn_readfirstlane(tid >> 6), lane = tid & 63, wr = wid >> 2, wc = wid & 3, fr = lane & 15, fq = lane >> 4;
    const int K = g.K, nt = K / BK;
    unsigned voffB[2], vA0[2], vA1[2], nA0[2], nA1[2]; int Rr[2], Cc[2];
#pragma unroll
    for (int i = 0; i < 2; ++i) { int R, C; stage_rc(tid * 16 + i * 8192, R, C); const int Rb = Epi::PERM ? ((R & ~31) + perm32(R & 31)) : R;
        voffB[i] = (unsigned)(Rb * K + C) * 2u; Rr[i] = R; Cc[i] = C; vA0[i] = vA1[i] = nA0[i] = nA1[i] = (unsigned)(R * K + C) * 2u; }
    const size_t kstep = (size_t)(BK * 2);
    const size_t hstep = (size_t)HALF * K * 2;
    const size_t tstep = 2 * hstep;
    const size_t hsA = GATHER ? 0 : hstep;
    const unsigned ldsw = (unsigned)wid * 1024u;
    const int aoff = lds_byte(wr * 64 + fr, fq * 8), boff = lds_byte(wc * 32 + fr, fq * 8);
#define PG8_SA(b, h) (((b) * 2 + (h)) * HTB)
#define PG8_SB(b, h) ((4 + (b) * 2 + (h)) * HTB)
#define PG8_STAGE(bufoff, gbase, voff) do { _Pragma("unroll") for (int _i = 0; _i < 2; ++_i) \
        __builtin_amdgcn_global_load_lds((const unsigned*)((const char*)(gbase) + (voff)[_i]), (PG8_LAS unsigned*)(lds + (bufoff) + ldsw + _i * 8192), 16, 0, 0); } while (0)
#define PG8_LDA(dst, b, h) do { _Pragma("unroll") for (int m = 0; m < 4; ++m) _Pragma("unroll") for (int k = 0; k < 2; ++k) dst[m][k] = *(const PG8_LAS bf16x8*)(lds + PG8_SA(b, h) + aoff + m * 2048 + k * 1024); } while (0)
#define PG8_LDB(dst, b, h) do { _Pragma("unroll") for (int n = 0; n < 2; ++n) _Pragma("unroll") for (int k = 0; k < 2; ++k) dst[n][k] = *(const PG8_LAS bf16x8*)(lds + PG8_SB(b, h) + boff + n * 2048 + k * 1024); } while (0)
#define PG8_MMA(ai, bj, At, Bt) do { __builtin_amdgcn_s_setprio(1); _Pragma("unroll") for (int m = 0; m < 4; ++m) _Pragma("unroll") for (int n = 0; n < 2; ++n) _Pragma("unroll") for (int k = 0; k < 2; ++k) \
        acc[ai][bj][m][n] = __builtin_amdgcn_mfma_f32_16x16x32_bf16(Bt[n][k], At[m][k], acc[ai][bj][m][n], 0, 0, 0); __builtin_amdgcn_s_setprio(0); } while (0)
#define PG8_WAIT_V(n) asm volatile("s_waitcnt vmcnt(" #n ")" ::: "memory")
#define PG8_WAIT_L(n) asm volatile("s_waitcnt lgkmcnt(" #n ")" ::: "memory")
#define PG8_BAR __builtin_amdgcn_s_barrier()
#define PG8_SCHED __builtin_amdgcn_sched_barrier(0)
#define PG8_GOFFS(u, o0, o1) do { if constexpr (GATHER) { _Pragma("unroll") for (int _i = 0; _i < 2; ++_i) { \
        const int t0_ = g.rows[(u).rl + Rr[_i]], t1_ = g.rows[(u).rl + HALF + Rr[_i]]; \
        o0[_i] = (unsigned)(t0_ * K + Cc[_i]) * 2u; o1[_i] = (unsigned)(t1_ * K + Cc[_i]) * 2u; } } } while (0)
    Unit cur, nxt; int ui = 0;
    if (!S.next(0, cur)) return;
    f32x4 acc[2][2][4][2];
#pragma unroll
    for (int a = 0; a < 2; ++a)
#pragma unroll
        for (int b = 0; b < 2; ++b)
#pragma unroll
            for (int m = 0; m < 4; ++m)
#pragma unroll
                for (int n = 0; n < 2; ++n) acc[a][b][m][n] = (f32x4){0.f, 0.f, 0.f, 0.f};
    bf16x8 At[4][2], B0[2][2], B1[2][2];
    const char* cA = (const char*)g.A + (GATHER ? (size_t)0 : (size_t)cur.pm * tstep); const char* cB = (const char*)g.Bt + (size_t)cur.pn * tstep;
    PG8_GOFFS(cur, vA0, vA1);
    PG8_STAGE(PG8_SB(0, 0), cB, voffB); PG8_STAGE(PG8_SB(0, 1), cB + hstep, voffB); PG8_STAGE(PG8_SA(0, 0), cA, vA0); PG8_STAGE(PG8_SA(0, 1), cA + hsA, vA1);
    if (wr == 1) PG8_BAR;
    PG8_WAIT_V(2); PG8_BAR;
    PG8_STAGE(PG8_SB(1, 0), cB + kstep, voffB); PG8_STAGE(PG8_SA(1, 0), cA + kstep, vA0); PG8_STAGE(PG8_SB(1, 1), cB + hstep + kstep, voffB);
    PG8_WAIT_V(6); PG8_BAR;
    for (;;) {
        const bool has_next = S.next(ui + 1, nxt);
        const char* nA = has_next ? (const char*)g.A + (GATHER ? (size_t)0 : (size_t)nxt.pm * tstep) : cA; const char* nB = has_next ? (const char*)g.Bt + (size_t)nxt.pn * tstep : cB;
        if constexpr (GATHER) { if (has_next) { PG8_GOFFS(nxt, nA0, nA1); } else {
#pragma unroll
            for (int i = 0; i < 2; ++i) { nA0[i] = vA0[i]; nA1[i] = vA1[i]; } } }
        for (int t = 0; t < nt; t += 2) {
            const bool last = (t == nt - 2);
            const char* a1 = cA + (size_t)(t + 1) * kstep;
            const char* a2 = last ? nA : cA + (size_t)(t + 2) * kstep; const char* b2 = last ? nB : cB + (size_t)(t + 2) * kstep;
            const char* a3 = a2 + kstep; const char* b3 = b2 + kstep;
            unsigned s0[2], s1[2];
#pragma unroll
            for (int i = 0; i < 2; ++i) { s0[i] = (GATHER && last) ? nA0[i] : vA0[i]; s1[i] = (GATHER && last) ? nA1[i] : vA1[i]; }
            PG8_LDB(B0, 0, 0); PG8_LDB(B1, 0, 1); PG8_SCHED; PG8_LDA(At, 0, 0); PG8_STAGE(PG8_SA(1, 1), a1 + hsA, vA1);
            PG8_WAIT_V(8); PG8_WAIT_L(0); PG8_BAR; PG8_MMA(0, 0, At, B0); PG8_MMA(0, 1, At, B1); PG8_BAR; PG8_SCHED;
            PG8_LDA(At, 0, 1); PG8_STAGE(PG8_SB(0, 0), b2, voffB); PG8_STAGE(PG8_SB(0, 1), b2 + hstep, voffB); PG8_STAGE(PG8_SA(0, 0), a2, s0);
            PG8_WAIT_V(8); PG8_WAIT_L(0); PG8_BAR; PG8_MMA(1, 0, At, B0); PG8_MMA(1, 1, At, B1); PG8_BAR; PG8_SCHED;
            PG8_LDB(B0, 1, 0); PG8_LDB(B1, 1, 1); PG8_SCHED; PG8_LDA(At, 1, 0); PG8_STAGE(PG8_SA(0, 1), a2 + hsA, s1);
            PG8_WAIT_V(8); PG8_WAIT_L(0); PG8_BAR; PG8_MMA(0, 0, At, B0); PG8_MMA(0, 1, At, B1); PG8_BAR; PG8_SCHED;
            PG8_LDA(At, 1, 1); PG8_STAGE(PG8_SB(1, 0), b3, voffB); PG8_STAGE(PG8_SB(1, 1), b3 + hstep, voffB); PG8_STAGE(PG8_SA(1, 0), a3, s0);
            PG8_WAIT_V(8); PG8_WAIT_L(0); PG8_BAR; PG8_MMA(1, 0, At, B0); PG8_MMA(1, 1, At, B1); PG8_BAR; PG8_SCHED;
        }
        if constexpr (ALIGN_EPI) { if (wr == 0) PG8_BAR; }
        E(acc, cur, wr, wc, fr, fq);
        if (!has_next) break;
#pragma unroll
        for (int a = 0; a < 2; ++a)
#pragma unroll
            for (int b = 0; b < 2; ++b)
#pragma unroll
                for (int m = 0; m < 4; ++m)
#pragma unroll
                    for (int n = 0; n < 2; ++n) acc[a][b][m][n] = (f32x4){0.f, 0.f, 0.f, 0.f};
        cur = nxt; cA = nA; cB = nB; ++ui;
        if constexpr (GATHER) {
#pragma unroll
            for (int i = 0; i < 2; ++i) { vA0[i] = nA0[i]; vA1[i] = nA1[i]; } }
        if constexpr (ALIGN_EPI) { if (wr == 1) PG8_BAR; }
    }
    PG8_WAIT_V(0);
    if constexpr (!ALIGN_EPI) { if (wr == 0) PG8_BAR; }
    PG8_BAR;
#undef PG8_SA
#undef PG8_SB
#undef PG8_STAGE
#undef PG8_LDA
#undef PG8_LDB
#undef PG8_MMA
#undef PG8_WAIT_V
#undef PG8_WAIT_L
#undef PG8_BAR
#undef PG8_SCHED
#undef PG8_GOFFS
}
}
#include <hip/hip_bf16.h>
#include <cmath>
namespace attn_body {
using bf16=__hip_bfloat16;
using bf16x8=__attribute__((ext_vector_type(8)))short;
using s16x4=__attribute__((ext_vector_type(4)))short;
using f32x16=__attribute__((ext_vector_type(16)))float;
using u32x4=__attribute__((ext_vector_type(4)))unsigned;
constexpr int BATCH=4,NHEAD=8,SEQ=8192,D=64,DM=NHEAD*D;
constexpr int NW=8,QBLK=32,QB=QBLK*NW,KVBLK=64,NQB=SEQ/QB;
constexpr int ATTN_PITCH=DM, ATTN_UNIT_ROWS=QB;
__device__ __forceinline__ int crow(int r,int hi){return (r&3)+8*(r>>2)+4*hi;}
#define SBAR() __builtin_amdgcn_sched_barrier(0)
__device__ __forceinline__ void cmask(f32x16&p0,f32x16&p1,int jb,int qrel,int hi){
  const float NEG=-INFINITY; int kb=64*jb+4*hi;
  #pragma unroll
  for(int r=0;r<16;++r){int kv=kb+(r&3)+8*(r>>2); if(kv>qrel)p0[r]=NEG; if(kv+32>qrel)p1[r]=NEG;}
}

constexpr int NSLOT=3, SLOTB=8192;
constexpr int LDS_K=0, LDS_V=NSLOT*SLOTB, LDS_WS=2*NSLOT*SLOTB, LDS_OST=LDS_WS+NW*64*4, LDS_CUM=LDS_OST+NW*4096, LDS_BYTES=LDS_CUM+SEQ*4;
constexpr float C2=0.125f*1.4426950408889634f;
__device__ __forceinline__ void glds16(const void*gsrc,unsigned lds_dst){unsigned keep;
  asm volatile("s_mov_b32 %0, m0\n\ts_mov_b32 m0, %2\n\ts_nop 0\n\tglobal_load_lds_dwordx4 %1, off\n\ts_mov_b32 m0, %0":"=&s"(keep):"v"(gsrc),"s"(lds_dst):"memory");}
__device__ __forceinline__ float max3f(float a,float b,float c){float r;asm("v_max3_f32 %0, %1, %2, %3":"=v"(r):"v"(a),"v"(b),"v"(c));return r;}
__device__ __forceinline__ float max2f(float a,float b){float r;asm("v_max_f32_e32 %0, %1, %2":"=v"(r):"v"(a),"v"(b));return r;}
__device__ __forceinline__ float fadd_s(float a,float b){float r;asm("v_add_f32_e32 %0, %1, %2":"=v"(r):"v"(a),"v"(b));return r;}
__device__ __forceinline__ float fsub_s(float a,float b){float r;asm("v_sub_f32_e32 %0, %1, %2":"=v"(r):"v"(a),"v"(b));return r;}
typedef float f32x2_t __attribute__((ext_vector_type(2))); typedef __bf16 bf16x2_t __attribute__((ext_vector_type(2)));
__device__ __forceinline__ unsigned cvtpk_s(float lo,float hi){f32x2_t v={lo,hi};bf16x2_t b=__builtin_convertvector(v,bf16x2_t);return __builtin_bit_cast(unsigned,b);}
#define WAIT_BAR(N) asm volatile("s_waitcnt vmcnt(" #N ") lgkmcnt(0)\n\ts_barrier":::"memory")

typedef __attribute__((address_space(3))) const float* lds_fptr;
typedef float f32x4a __attribute__((ext_vector_type(4)));
__device__ __forceinline__ void ckinit(f32x16&c0,f32x16&c1,lds_fptr ck,float nm,int hi){
  #pragma unroll
  for(int g=0;g<4;++g){
    const f32x4a a=*(const __attribute__((address_space(3))) f32x4a*)(ck+8*g+4*hi);
    const f32x4a b=*(const __attribute__((address_space(3))) f32x4a*)(ck+32+8*g+4*hi);
    c0[4*g+0]=nm-a[0];c0[4*g+1]=nm-a[1];c0[4*g+2]=nm-a[2];c0[4*g+3]=nm-a[3];
    c1[4*g+0]=nm-b[0];c1[4*g+1]=nm-b[1];c1[4*g+2]=nm-b[2];c1[4*g+3]=nm-b[3];}
}
__device__ __forceinline__ void qkt(f32x16&p0,f32x16&p1,const char*Kslot,const bf16x8*qr,lds_fptr ck,float nm,int r32,int hi){
  const char*kb=Kslot+hi*1024+r32*16;
  ckinit(p0,p1,ck,nm,hi);
  #pragma unroll
  for(int d0=0;d0<4;++d0){
    const bf16x8 b0=*reinterpret_cast<const bf16x8*>(kb+d0*2048);
    const bf16x8 b1=*reinterpret_cast<const bf16x8*>(kb+d0*2048+512);
    p0=__builtin_amdgcn_mfma_f32_32x32x16_bf16(b0,qr[d0],p0,0,0,0);p1=__builtin_amdgcn_mfma_f32_32x32x16_bf16(b1,qr[d0],p1,0,0,0);}
}
typedef __attribute__((address_space(3))) const char* lds_cptr;
typedef short v4i16_t __attribute__((ext_vector_type(4)));
__device__ __forceinline__ void kload8(bf16x8*kf,lds_cptr kp){
  kf[0]=*(const __attribute__((address_space(3))) bf16x8*)(kp);      kf[1]=*(const __attribute__((address_space(3))) bf16x8*)(kp+512);
  kf[2]=*(const __attribute__((address_space(3))) bf16x8*)(kp+2048); kf[3]=*(const __attribute__((address_space(3))) bf16x8*)(kp+2560);
  kf[4]=*(const __attribute__((address_space(3))) bf16x8*)(kp+4096); kf[5]=*(const __attribute__((address_space(3))) bf16x8*)(kp+4608);
  kf[6]=*(const __attribute__((address_space(3))) bf16x8*)(kp+6144); kf[7]=*(const __attribute__((address_space(3))) bf16x8*)(kp+6656);
}
__device__ __forceinline__ void kload2(bf16x8*kf,lds_cptr kp,int j){ kf[2*j]=*(const __attribute__((address_space(3))) bf16x8*)(kp+j*2048); kf[2*j+1]=*(const __attribute__((address_space(3))) bf16x8*)(kp+j*2048+512); }
__device__ __forceinline__ s16x4 vtr(lds_cptr p){ return __builtin_bit_cast(s16x4,__builtin_amdgcn_ds_read_tr16_b64_v4i16((__attribute__((address_space(3))) v4i16_t*)p)); }
__device__ __forceinline__ float rowmax(const f32x16&p0,const f32x16&p1){
  float a=max3f(p0[0],p0[1],p1[0]),b=max3f(p0[2],p0[3],p1[1]);a=max3f(a,p1[2],p1[3]);
  #pragma unroll
  for(int r=4;r<16;r+=4){a=max3f(a,p0[r],p0[r+1]);b=max3f(b,p0[r+2],p0[r+3]);a=max3f(a,p1[r],p1[r+1]);b=max3f(b,p1[r+2],p1[r+3]);}
  const float m=max2f(a,b);
  auto rr=__builtin_amdgcn_permlane32_swap(__float_as_uint(m),__float_as_uint(m),false,false);
  return max2f(__uint_as_float(rr[0]),__uint_as_float(rr[1]));
}
__device__ __forceinline__ void pv(f32x16*o,int vb,bf16x8 pa0,bf16x8 pa1,bf16x8 pa2,bf16x8 pa3){
  #pragma unroll
  for(int d0=0;d0<2;++d0){s16x4 lo[4],hi[4];
    #pragma unroll
    for(int ks=0;ks<4;++ks){
      asm volatile("ds_read_b64_tr_b16 %0,%1 offset:%c2":"=&v"(lo[ks]):"v"(vb),"i"(d0*4096+ks*1024):"memory");
      asm volatile("ds_read_b64_tr_b16 %0,%1 offset:%c2":"=&v"(hi[ks]):"v"(vb),"i"(d0*4096+ks*1024+512):"memory");}
    asm volatile("s_waitcnt lgkmcnt(0)":::"memory");SBAR();
    #define PK(k) (bf16x8){lo[k][0],lo[k][1],lo[k][2],lo[k][3],hi[k][0],hi[k][1],hi[k][2],hi[k][3]}
    o[d0]=__builtin_amdgcn_mfma_f32_32x32x16_bf16(pa0,PK(0),o[d0],0,0,0);
    o[d0]=__builtin_amdgcn_mfma_f32_32x32x16_bf16(pa1,PK(1),o[d0],0,0,0);
    o[d0]=__builtin_amdgcn_mfma_f32_32x32x16_bf16(pa2,PK(2),o[d0],0,0,0);
    o[d0]=__builtin_amdgcn_mfma_f32_32x32x16_bf16(pa3,PK(3),o[d0],0,0,0);
    #undef PK
  }
}

#ifndef ATTN_STORE16
#define ATTN_STORE16(p,v) (*(u32x4*)(p)=(v))
#endif
template<int THRL> __device__ __forceinline__ void attn_unit(int b,int h,int qb,const bf16*Q,const bf16*__restrict__ K,const bf16*__restrict__ V,bf16*O,const float*__restrict__ cum,const unsigned*__restrict__ qkm,char*shm){
  int tid_l=threadIdx.x; asm volatile("":"+v"(tid_l));
  const int tid=tid_l,lane=tid&63,r32=lane&31,hi=lane>>5; const int wid=__builtin_amdgcn_readfirstlane(tid>>6);
  const long rowbase=(long)b*SEQ; const int q0=qb*QB;
  const bf16*Qw=Q+(rowbase+q0+wid*QBLK)*DM+h*D;
  const bf16*Kh=K+rowbase*DM+h*D,*Vh=V+rowbase*DM+h*D;
  const unsigned lds0=(unsigned)(uintptr_t)shm;
  float*wsf=(float*)(shm+LDS_WS)+wid*64;
  const bf16*ksrc=Kh+(long)lane*DM+wid*8;
  const bf16*vsrc=Vh+(long)(16*(wid&3)+(lane>>2))*DM+(wid>>2)*32+(lane&3)*8;
  const unsigned kdst=lds0+LDS_K+wid*1024, vdst=lds0+LDS_V+wid*1024;
  #define DMA_K(t,slot) glds16(ksrc+(long)TILE(t)*KVBLK*DM,(unsigned)__builtin_amdgcn_readfirstlane(kdst+(slot)))
  #define DMA_V(t,slot) glds16(vsrc+(long)TILE(t)*KVBLK*DM,(unsigned)__builtin_amdgcn_readfirstlane(vdst+(slot)))
  const int vb0=(int)(lds0+LDS_V)+((lane>>4)&1)*32+(lane&3)*8+(4*hi+((lane&15)>>2))*64;
  const char*Kbase=shm+LDS_K; bf16x8 kf[8];
  const lds_cptr shm3=(lds_cptr)shm; const lds_cptr kp0=shm3+LDS_K+hi*1024+r32*16; const lds_cptr vp0=shm3+LDS_V+((lane>>4)&1)*32+(lane&3)*8+(4*hi+((lane&15)>>2))*64;
  const int NT=(q0+QB)/KVBLK;
  const lds_fptr cumS=(lds_fptr)(shm3+LDS_CUM);
  const float* cgp=cum+(long)(b*NHEAD+h)*SEQ;
  int tmin;
  { const float qk=sqrtf(__uint_as_float(qkm[b*NHEAD+h])*__uint_as_float(qkm[32+b*NHEAD+h]));
    const float thr=cgp[q0]+2.0f*qk+40.0f;
    const bool c0=(lane<NT-4)&&(cgp[64*lane+63]>=thr), c1=(lane+64<NT-4)&&(cgp[64*(lane+64)+63]>=thr);
    tmin=(__popcll(__ballot(c0))+__popcll(__ballot(c1)))&~1; }
  const int NTp=NT-tmin;
  #define TILE(j) (((j)<4)?(NT-4+(j)):(NT-1-(j)))
  { const f32x4a* cg4=(const f32x4a*)cgp; __attribute__((address_space(3))) f32x4a* cs4=(__attribute__((address_space(3))) f32x4a*)(shm3+LDS_CUM);
    for(int i=16*tmin+tid;i<(q0+QB)/4;i+=NW*64)cs4[i]=cg4[i]; }
  DMA_K(0,0);DMA_V(0,0);DMA_K(1,SLOTB);
  bf16x8 qr[4];
  #pragma unroll
  for(int d0=0;d0<4;++d0)qr[d0]=*reinterpret_cast<const bf16x8*>(&Qw[(long)r32*DM+d0*16+hi*8]);
  float mhat=0.f,l_reg=0.f;f32x16 o[2];o[0]=f32x16{};o[1]=f32x16{};float cq=0.f,nm=0.f;
  const int qrel=wid*QBLK+r32;
  #define CMASK(P0,P1,t) do{ if((t)<4)cmask(P0,P1,(t),qrel,hi);}while(0)
  bool resc=false;
  #define START(P0,P1) do{ const float rm=rowmax(P0,P1); resc=false; \
    { const float dl=rm; mhat=fadd_s(mhat,dl); \
      _Pragma("unroll") for(int r=0;r<16;++r){P0[r]=fsub_s(P0[r],dl);P1[r]=fsub_s(P1[r],dl);} \
      nm=cq-mhat; } \
    _Pragma("unroll") for(int r=0;r<16;++r)P0[r]=__builtin_amdgcn_exp2f(P0[r]); }while(0)
  #define RESC() do{ if(resc){ asm volatile("s_waitcnt lgkmcnt(0)":::"memory"); \
      _Pragma("unroll") for(int d_=0;d_<2;++d_) _Pragma("unroll") for(int r=0;r<16;++r)o[d_][r]*=wsf[crow(r,hi)]; } }while(0)
  f32x16 pA0,pA1,pB0,pB1;
  int sl_prev=0,sl_cur=0,sl_next=SLOTB;
  #define ROT() do{sl_prev=sl_cur;sl_cur=sl_next;sl_next=(sl_next==(NSLOT-1)*SLOTB)?0:sl_next+SLOTB;}while(0)
  DMA_K(2,2*SLOTB);
  WAIT_BAR(3);
  cq=cumS[q0+qrel]; nm=cq;
  qkt(pA0,pA1,Kbase,qr,cumS+64*TILE(0),nm,r32,hi);asm volatile("s_nop 15\n\ts_nop 7":"+v"(pA0),"+v"(pA1));CMASK(pA0,pA1,0);
  START(pA0,pA1);
  _Pragma("unroll") for(int r=0;r<16;++r)pA1[r]=__builtin_amdgcn_exp2f(pA1[r]);
  WAIT_BAR(0);
  DMA_K(3,0);DMA_V(1,SLOTB);
  ROT();
  kload8(kf,kp0+sl_cur);
  WAIT_BAR(2);
  s16x4 vlo[8],vhi[8]; u32x4 pw0,pw1,pw2,pw3;
  #define PKW(P,B) cvtpk_s(P[B],P[B+1])
  #define PAF(k) __builtin_bit_cast(bf16x8,pw##k)
  #define VFR(i) (bf16x8){vlo[i][0],vlo[i][1],vlo[i][2],vlo[i][3],vhi[i][0],vhi[i][1],vhi[i][2],vhi[i][3]}
  #define PIN(x) asm volatile("":"+v"(x))
  #define MX3(a,b,c) __builtin_fmaxf(__builtin_fmaxf((a),(b)),(c))
  #define GAPA(MF,A0,A1,A2,A3,W0,W1,PW) do{ MF; sacc+=A0; sacc+=A1; sacc+=A2; sacc+=A3; PIN(sacc); W0; W1; PIN(PW); SBAR(); }while(0)
  #define EX(v) __builtin_amdgcn_exp2f(v)
  #define GAPB(MF,X,B) do{ MF; X[B]=EX(X[B]); X[B+1]=EX(X[B+1]); X[B+2]=EX(X[B+2]); X[B+3]=EX(X[B+3]); PIN(X); SBAR(); }while(0)
  #define VRD(i) do{ vlo[i]=vtr(vp_+(((i)>>2)*4096+((i)&3)*1024)); vhi[i]=vtr(vp_+(((i)>>2)*4096+((i)&3)*1024+512)); }while(0)
  #define KRD(G,j) do{ if(G){ kload2(kf,kp0+sl_next,j); SBAR(); } }while(0)
  #define STEP(C0,C1,P0,P1,t,GK,GV,GL) do{ SBAR(); \
    ckinit(C0,C1,cumS+64*TILE(t),nm,hi); SBAR(); \
    const lds_cptr vp_=vp0+sl_prev; \
    VRD(0); SBAR(); float sacc=(P0[0]+P0[1]); \
    GAPA(C0=__builtin_amdgcn_mfma_f32_32x32x16_bf16(kf[0],qr[0],C0,0,0,0), P0[2],P0[3],P0[4],P0[5],     pw0[0]=PKW(P0,0), pw0[1]=PKW(P0,2), pw0); \
    VRD(4); SBAR(); GAPA(C1=__builtin_amdgcn_mfma_f32_32x32x16_bf16(kf[1],qr[0],C1,0,0,0), P0[6],P0[7],P0[8],P0[9],     pw0[2]=PKW(P0,4), pw0[3]=PKW(P0,6), pw0); \
    VRD(1); SBAR(); GAPA(C0=__builtin_amdgcn_mfma_f32_32x32x16_bf16(kf[2],qr[1],C0,0,0,0),   P0[10],P0[11],P0[12],P0[13], pw1[0]=PKW(P0,8), pw1[1]=PKW(P0,10), pw1); \
    VRD(5); SBAR(); GAPA(C1=__builtin_amdgcn_mfma_f32_32x32x16_bf16(kf[3],qr[1],C1,0,0,0),   P0[14],P0[15],P1[0],P1[1],   pw1[2]=PKW(P0,12),pw1[3]=PKW(P0,14), pw1); \
    VRD(2); SBAR(); GAPA(C0=__builtin_amdgcn_mfma_f32_32x32x16_bf16(kf[4],qr[2],C0,0,0,0),   P1[2],P1[3],P1[4],P1[5],     pw2[0]=PKW(P1,0), pw2[1]=PKW(P1,2), pw2); \
    VRD(6); SBAR(); GAPA(C1=__builtin_amdgcn_mfma_f32_32x32x16_bf16(kf[5],qr[2],C1,0,0,0),   P1[6],P1[7],P1[8],P1[9],     pw2[2]=PKW(P1,4), pw2[3]=PKW(P1,6), pw2); \
    VRD(3); SBAR(); GAPA(C0=__builtin_amdgcn_mfma_f32_32x32x16_bf16(kf[6],qr[3],C0,0,0,0),   P1[10],P1[11],P1[12],P1[13], pw3[0]=PKW(P1,8), pw3[1]=PKW(P1,10), pw3); \
    VRD(7); SBAR(); GAPA(C1=__builtin_amdgcn_mfma_f32_32x32x16_bf16(kf[7],qr[3],C1,0,0,0),   P1[14],P1[15],0.f,0.f,       pw3[2]=PKW(P1,12),pw3[3]=PKW(P1,14), pw3); \
    l_reg+=sacc; \
    if(GK){DMA_K((t)+3,sl_cur);} if(GV){DMA_V((t)+1,sl_next);} \
    CMASK(C0,C1,t); \
    { float a=MX3(C0[0],C0[1],C1[0]),b=MX3(C0[2],C0[3],C1[1]); a=MX3(a,C1[2],C1[3]); \
      _Pragma("unroll") for(int r=4;r<16;r+=4){a=MX3(a,C0[r],C0[r+1]);b=MX3(b,C0[r+2],C0[r+3]);a=MX3(a,C1[r],C1[r+1]);b=MX3(b,C1[r+2],C1[r+3]);} \
      float rm=__builtin_fmaxf(a,b); { auto rr=__builtin_amdgcn_permlane32_swap(__float_as_uint(rm),__float_as_uint(rm),false,false); rm=__builtin_fmaxf(__uint_as_float(rr[0]),__uint_as_float(rr[1])); } \
      resc=false; \
      if(__builtin_expect(__any(rm>(float)THRL),0)){ const float dl=__builtin_fmaxf(rm,0.f); mhat+=dl; \
        _Pragma("unroll") for(int r=0;r<16;++r){C0[r]-=dl;C1[r]-=dl;} \
        nm=cq-mhat; \
        const float f=__builtin_amdgcn_exp2f(-dl); l_reg*=f; if(hi==0)wsf[r32]=f; resc=true; } } \
    SBAR(); \
    GAPB(o[0]=__builtin_amdgcn_mfma_f32_32x32x16_bf16(PAF(0),VFR(0),o[0],0,0,0), C0,0); \
    GAPB(o[1]=__builtin_amdgcn_mfma_f32_32x32x16_bf16(PAF(0),VFR(4),o[1],0,0,0), C0,4); \
    KRD(GL,0); GAPB(o[0]=__builtin_amdgcn_mfma_f32_32x32x16_bf16(PAF(1),VFR(1),o[0],0,0,0), C0,8); \
    KRD(GL,1); GAPB(o[1]=__builtin_amdgcn_mfma_f32_32x32x16_bf16(PAF(1),VFR(5),o[1],0,0,0), C0,12); \
    KRD(GL,2); GAPB(o[0]=__builtin_amdgcn_mfma_f32_32x32x16_bf16(PAF(2),VFR(2),o[0],0,0,0), C1,0); \
    KRD(GL,3); GAPB(o[1]=__builtin_amdgcn_mfma_f32_32x32x16_bf16(PAF(2),VFR(6),o[1],0,0,0), C1,4); \
    GAPB(o[0]=__builtin_amdgcn_mfma_f32_32x32x16_bf16(PAF(3),VFR(3),o[0],0,0,0), C1,8); \
    GAPB(o[1]=__builtin_amdgcn_mfma_f32_32x32x16_bf16(PAF(3),VFR(7),o[1],0,0,0), C1,12); \
    }while(0)
  int t=1;
  for(;t+5<NTp;t+=2){
    STEP(pB0,pB1,pA0,pA1,t,true,true,true);     WAIT_BAR(2); RESC(); ROT();
    STEP(pA0,pA1,pB0,pB1,t+1,true,true,true);   WAIT_BAR(2); RESC(); ROT();
  }
  #define ENDW(tt) do{ if((tt)+3<NTp){WAIT_BAR(2);} else if((tt)+2<NTp){WAIT_BAR(1);} else {WAIT_BAR(0);} }while(0)
  for(;t+1<NTp;t+=2){
    STEP(pB0,pB1,pA0,pA1,t,(t+3<NTp),(t+1<NTp),(t+1<NTp));       ENDW(t);   RESC(); ROT();
    STEP(pA0,pA1,pB0,pB1,t+1,(t+4<NTp),(t+2<NTp),(t+2<NTp));     ENDW(t+1); RESC(); ROT();
  }
  STEP(pB0,pB1,pA0,pA1,NTp-1,false,false,false); RESC();
  { float sacc=pB0[0]+pB0[1]; _Pragma("unroll") for(int r=2;r<16;++r)sacc+=pB0[r]; _Pragma("unroll") for(int r=0;r<16;++r)sacc+=pB1[r]; l_reg+=sacc;
    pw0=(u32x4){PKW(pB0,0),PKW(pB0,2),PKW(pB0,4),PKW(pB0,6)};pw1=(u32x4){PKW(pB0,8),PKW(pB0,10),PKW(pB0,12),PKW(pB0,14)};pw2=(u32x4){PKW(pB1,0),PKW(pB1,2),PKW(pB1,4),PKW(pB1,6)};pw3=(u32x4){PKW(pB1,8),PKW(pB1,10),PKW(pB1,12),PKW(pB1,14)};
    SBAR(); pv(o,vb0+sl_cur,PAF(0),PAF(1),PAF(2),PAF(3)); }
  #undef PKW
  #undef PAF
  #undef VFR
  #undef PIN
  #undef MX3
  #undef GAPA
  #undef GAPB
  #undef EX
  #undef VRD
  #undef KRD
  #undef STEP
  #undef ENDW
  {auto rr=__builtin_amdgcn_permlane32_swap(__float_as_uint(l_reg),__float_as_uint(l_reg),false,false);l_reg=__uint_as_float(rr[0])+__uint_as_float(rr[1]);}
  if(hi==0)wsf[32+r32]=l_reg;asm volatile("s_waitcnt lgkmcnt(0)":::"memory");
  float rli[16];
  #pragma unroll
  for(int r=0;r<16;++r)rli[r]=__builtin_amdgcn_rcpf(wsf[32+crow(r,hi)]);
  bf16*Ow=O+(rowbase+q0+wid*QBLK)*DM+h*D;
  { bf16*stg=(bf16*)(shm+LDS_OST)+wid*2048;
    #pragma unroll
    for(int r=0;r<16;++r){const int orow=crow(r,hi);
      #pragma unroll
      for(int d0=0;d0<2;++d0)stg[orow*64+d0*32+r32]=__float2bfloat16(o[d0][r]*rli[r]);}
    asm volatile("s_waitcnt lgkmcnt(0)":::"memory");
    #pragma unroll
    for(int i=0;i<4;++i){const int row=i*8+(lane>>3),ch=lane&7; const u32x4 v=*(const u32x4*)(stg+row*64+ch*8); ATTN_STORE16(Ow+(long)row*DM+ch*8,v);} }
  asm volatile("s_waitcnt lgkmcnt(0)\n\ts_barrier":::"memory");
  #undef DMA_K
  #undef TILE
  #undef DMA_V
  #undef CMASK
  #undef START
  #undef RESC
  #undef ROT
}
constexpr int ATTN_LDS_BYTES=LDS_BYTES;
struct AttnTensors { const bf16* Q; const bf16* K; const bf16* V; bf16* O; const float* cum; const unsigned* qkm; };
struct AttnUnit { int bh; int qb; };
struct StaticOrder {
  int vcu;
  __device__ __forceinline__ explicit StaticOrder(int grid,int block):vcu((block%8)*(grid/8)+block/8){}
  __device__ __forceinline__ bool next(int i,AttnUnit&u)const{ if(i>=4)return false; const int s=vcu&7; u.bh=vcu>>3; u.qb=(i==0)?s:(i==1)?15-s:(i==2)?16+s:31-s; return true; }
  __device__ __forceinline__ void a_ready(const AttnUnit&)const{}
  __device__ __forceinline__ void done(const AttnUnit&)const{}
};
template<class Sched,int THRL=8> __device__ __forceinline__ void attn_phase(char*lds,const AttnTensors&T,const Sched&S){
  AttnUnit u;
  for(int i=0;S.next(i,u);++i){ S.a_ready(u); attn_unit<THRL>(u.bh/NHEAD,u.bh%NHEAD,u.qb,T.Q,T.K,T.V,T.O,T.cum,T.qkm,lds); S.done(u); }
}
#undef SBAR
#undef WAIT_BAR
}

constexpr int NWAVES = 8, NTHR = 512;
constexpr int NB = 4, SEQ = 8192, DM = 1024, T = NB * SEQ;
constexpr int NEXP = 32, TOPK = 4, ECAP = 32768;
constexpr int NSLOT_ROWS = T * TOPK + NEXP * 256;
constexpr int INW = 6680, NPROJ = 6656;
constexpr float LN_EPS = 1e-5f, ALPHA = 1.18920711500272f, LOG2E = 1.4426950408889634f;
constexpr size_t MiB = 1u << 20;
constexpr size_t WS_CTL = 0;
constexpr size_t WS_MODP = 1 * MiB, WS_MODF = WS_MODP + 512 * 1024;
constexpr size_t WS_WSM = 2 * MiB, WS_WRT = WS_WSM + 256 * 1024;
constexpr size_t WS_FFL = 3 * MiB, WS_GLR = 4 * MiB, WS_CUM = 6 * MiB, WS_DLAST = 7 * MiB;
constexpr size_t WS_TSLOT = 8 * MiB, WS_TGATE = WS_TSLOT + 512 * 1024, WS_RTOK = 9 * MiB;
constexpr size_t WS_WIN = 16 * MiB, WS_WA = 29 * MiB, WS_WB = 30 * MiB, WS_WO = 32 * MiB, WS_WUP = 34 * MiB, WS_WDN = 162 * MiB;
constexpr size_t WS_U = 226 * MiB;
constexpr size_t WS_FQ = 290 * MiB, WS_FK = 322 * MiB, WS_FV = 354 * MiB, WS_GQ = 386 * MiB, WS_GK = 418 * MiB, WS_GV = 450 * MiB, WS_GR = 514 * MiB, WS_GA = 578 * MiB, WS_GB = 642 * MiB;
constexpr size_t WS_US = 706 * MiB;
constexpr size_t WS_U2 = 834 * MiB;
constexpr size_t WS_ACT = 290 * MiB, WS_MOE = 562 * MiB;
constexpr size_t WS_END = 898 * MiB;
static_assert(WS_ACT + (size_t)NSLOT_ROWS * 1024 * 2 <= WS_MOE && WS_MOE + (size_t)NSLOT_ROWS * 1024 * 2 <= WS_U2, "overlay map");

constexpr int LDS_BYTES = 160 * 1024;
constexpr int MISC_OFF = 131072;
constexpr int BARLDS_OFF = LDS_BYTES - 64;
constexpr int CW_BAR = 4096;
constexpr size_t CTL_ZERO_BYTES = 65536;

#define LAS __attribute__((address_space(3)))
typedef unsigned short bf16;
typedef unsigned v4u __attribute__((ext_vector_type(4)));
typedef unsigned v2u __attribute__((ext_vector_type(2)));
typedef float f32x4 __attribute__((ext_vector_type(4)));
typedef float f32x16 __attribute__((ext_vector_type(16)));
typedef short bf16x8 __attribute__((ext_vector_type(8)));
typedef short s16x4 __attribute__((ext_vector_type(4)));
#define LDS_WAIT() asm volatile("s_waitcnt lgkmcnt(0)" ::: "memory")
__device__ __forceinline__ unsigned f2bf(float f) { unsigned u = __builtin_bit_cast(unsigned, f); return (u + 0x7fffu + ((u >> 16) & 1u)) >> 16; }
__device__ __forceinline__ unsigned pk2(float lo, float hi) { return f2bf(lo) | (f2bf(hi) << 16); }
__device__ __forceinline__ float bfl(unsigned w) { return __uint_as_float(w << 16); }
__device__ __forceinline__ float bfh(unsigned w) { return __uint_as_float(w & 0xffff0000u); }
__device__ __forceinline__ float bf1(bf16 h) { return __uint_as_float((unsigned)h << 16); }
__device__ __forceinline__ float wave_sum(float v) {
#pragma unroll
    for (int o = 1; o < 64; o <<= 1) v += __shfl_xor(v, o);
    return v;
}
__device__ __forceinline__ float wave_max(float v) {
#pragma unroll
    for (int o = 1; o < 64; o <<= 1) v = fmaxf(v, __shfl_xor(v, o));
    return v;
}
__device__ __forceinline__ float logsigmoidf(float x) { return fminf(x, 0.f) - log1pf(__expf(-fabsf(x))); }
__device__ __forceinline__ float sigmoidf_(float x) { return 1.0f / (1.0f + __expf(-x)); }
__device__ __forceinline__ float reduce32(const float (&v)[32], int lane) {
    float a[16], b[8], c[4], d[2], e;
    { const bool up = lane & 32;
#pragma unroll
      for (int i = 0; i < 16; ++i) { const float keep = up ? v[16 + i] : v[i], send = up ? v[i] : v[16 + i]; a[i] = keep + __shfl_xor(send, 32); } }
    { const bool up = lane & 16;
#pragma unroll
      for (int i = 0; i < 8; ++i) { const float keep = up ? a[8 + i] : a[i], send = up ? a[i] : a[8 + i]; b[i] = keep + __shfl_xor(send, 16); } }
    { const bool up = lane & 8;
#pragma unroll
      for (int i = 0; i < 4; ++i) { const float keep = up ? b[4 + i] : b[i], send = up ? b[i] : b[4 + i]; c[i] = keep + __shfl_xor(send, 8); } }
    { const bool up = lane & 4;
#pragma unroll
      for (int i = 0; i < 2; ++i) { const float keep = up ? c[2 + i] : c[i], send = up ? c[i] : c[2 + i]; d[i] = keep + __shfl_xor(send, 4); } }
    { const bool up = lane & 2; const float keep = up ? d[1] : d[0], send = up ? d[0] : d[1]; e = keep + __shfl_xor(send, 2); }
    e += __shfl_xor(e, 1);
    return e;
}

__device__ __forceinline__ bf16x8 frag_row(const LAS bf16* img, int stride, int row0, int k0, int lane) {
    return *(const LAS bf16x8*)(img + (row0 + (lane & 31)) * stride + k0 + 8 * (lane >> 5));
}
__device__ __forceinline__ bf16x8 frag_tr(const LAS bf16* img, int stride, int k0, int n0, int lane) {
    const int g = lane >> 4, q = (lane >> 2) & 3, p = lane & 3, h = g >> 1;
    const LAS bf16* a = img + (k0 + 8 * h + q) * stride + n0 + 16 * (g & 1) + 4 * p;
    const s16x4 lo = __builtin_bit_cast(s16x4, __builtin_amdgcn_ds_read_tr16_b64_v4i16((LAS s16x4*)a));
    const s16x4 hi = __builtin_bit_cast(s16x4, __builtin_amdgcn_ds_read_tr16_b64_v4i16((LAS s16x4*)(a + 4 * stride)));
    return (bf16x8){lo[0], lo[1], lo[2], lo[3], hi[0], hi[1], hi[2], hi[3]};
}
__device__ __forceinline__ int crow16(int r, int h) { return (r & 3) + 8 * (r >> 2) + 4 * h; }

typedef __attribute__((address_space(1))) unsigned gu32;
#define XB_TMO      128
#define XB_XCNT(j)  (256  + 64 * (j))
#define XB_XSUB(j)  (1280 + 64 * (j))
#define XB_XGEN(j)  (2304 + 64 * (j))
#define XB_TOP      3328
#define XB_TOPGEN   3392
#define XCD_BAR_WORDS 3456
#define XB_SPIN_CAP (1u << 18)

__device__ __forceinline__ unsigned xb_ld(unsigned* p)              { return __hip_atomic_load(p, __ATOMIC_RELAXED, __HIP_MEMORY_SCOPE_AGENT); }
__device__ __forceinline__ unsigned xb_add(unsigned* p, unsigned v) { return __hip_atomic_fetch_add(p, v, __ATOMIC_RELAXED, __HIP_MEMORY_SCOPE_AGENT); }
__device__ __forceinline__ unsigned xb_xcc_id() { return (unsigned)__builtin_amdgcn_s_getreg((3 << 11) | 20) & 0xFu; }
#define XB_SPIN(cond, bar) do { unsigned _sp = 0; while (cond) { __builtin_amdgcn_s_sleep(1); \
    if ((++_sp & 255u) == 0u) { if (xb_ld(&(bar)[XB_TMO])) break; if (_sp > XB_SPIN_CAP) { atomicAdd(&(bar)[XB_TMO], 1u); break; } } } } while (0)

struct XcdBarrier {
    unsigned* bar; unsigned x;
    volatile LAS unsigned* st;
};

__device__ __forceinline__ XcdBarrier xcd_barrier_post(unsigned* bar, volatile LAS unsigned* st) {
    XcdBarrier b; b.bar = bar; b.x = xb_xcc_id(); b.st = st;
    if (threadIdx.x == 0) (void)xb_add(&bar[XB_XCNT(b.x)], 1u);
    return b;
}
__device__ __forceinline__ void xcd_barrier_complete(unsigned* bar, unsigned x, unsigned& nloc, unsigned& nx) {
    const unsigned G = gridDim.x * gridDim.y * gridDim.z;
    unsigned sum, cnt, mine, sp = 0u;
    for (;;) {
        sum = 0u; cnt = 0u; mine = 0u;
#pragma unroll
        for (unsigned j = 0; j < 16; ++j) { const unsigned c = xb_ld(&bar[XB_XCNT(j)]); sum += c; cnt += (c > 0u) ? 1u : 0u; mine = (j == x) ? c : mine; }
        if (sum == G) break;
        __builtin_amdgcn_s_sleep(1);
        if ((++sp & 255u) == 0u) { if (xb_ld(&bar[XB_TMO])) break; if (sp > XB_SPIN_CAP) { atomicAdd(&bar[XB_TMO], 1u); break; } }
    }
    nloc = mine > 0u ? mine : 1u; nx = cnt > 0u ? cnt : 1u;
}

__device__ __forceinline__ void xcd_barrier(const XcdBarrier& b) {
    asm volatile("s_waitcnt vmcnt(0)" ::: "memory");
    __syncthreads();
    if (threadIdx.x == 0) {
        unsigned* bar = b.bar;
        __builtin_amdgcn_s_waitcnt(0);
        unsigned nloc = b.st[0], nx = b.st[1];
        if (nloc == 0u) { xcd_barrier_complete(bar, b.x, nloc, nx); b.st[0] = nloc; b.st[1] = nx; }
        const unsigned old = xb_add(&bar[XB_XSUB(b.x)], 1u);
        const unsigned gen = old / nloc;
        if (old + 1u == (gen + 1u) * nloc) {
            __builtin_amdgcn_fence(__ATOMIC_RELEASE, "agent");
            asm volatile("s_waitcnt vmcnt(0)" ::: "memory");
            const unsigned og = xb_add(&bar[XB_TOP], 1u);
            const unsigned tg = og / nx;
            if (og + 1u == (tg + 1u) * nx) xb_add(&bar[XB_TOPGEN], 1u);
            else XB_SPIN(xb_ld(&bar[XB_TOPGEN]) == tg, bar);
            __builtin_amdgcn_fence(__ATOMIC_ACQUIRE, "agent");
            xb_add(&bar[XB_XGEN(b.x)], 1u);
            asm volatile("s_waitcnt vmcnt(0)" ::: "memory");
        } else {
            XB_SPIN(xb_ld(&bar[XB_XGEN(b.x)]) == gen, bar);
            __builtin_amdgcn_fence(__ATOMIC_ACQUIRE, "agent");
            asm volatile("s_waitcnt vmcnt(0)" ::: "memory");
        }
    }
    __syncthreads();
}

__device__ __forceinline__ int tid_() { int t = threadIdx.x; asm volatile("" : "+v"(t)); return t; }
struct Frame {
    LAS unsigned char* lds;
    int wave, G, blk;
    float* out; unsigned char* ws;
};
#define WSP(type, off) ((type*)(F.ws + (off)))
constexpr size_t WS_PTRS = 2048;
#define GAS __attribute__((address_space(1)))
typedef const GAS float* gfptr_t;
typedef const GAS f32x4* gf4ptr_t;
#define PT(k) (((const gfptr_t*)(F.ws + WS_PTRS))[k])
struct Args { const float* in[22]; float* out; unsigned char* ws; int ph_lo, ph_hi; };

__device__ __forceinline__ void p0_transpose_item(const float* W, int ldw, int sc0, bf16* WT, int Kd, int drow0, int k0, LAS float* scr, int lane) {
#pragma unroll 8
    for (int i = 0; i < 32; ++i) { const int kk = 2 * i + (lane >> 5); scr[kk * 33 + (lane & 31)] = W[(size_t)(k0 + kk) * ldw + sc0 + (lane & 31)]; }
    LDS_WAIT(); asm volatile("" ::: "memory");
    const int c = lane & 7;
#pragma unroll
    for (int j = 0; j < 4; ++j) { const int n = (lane >> 3) + 8 * j; const LAS float* s = scr + (8 * c) * 33 + n;
        v4u o; o.x = pk2(s[0 * 33], s[1 * 33]); o.y = pk2(s[2 * 33], s[3 * 33]); o.z = pk2(s[4 * 33], s[5 * 33]); o.w = pk2(s[6 * 33], s[7 * 33]);
        *(v4u*)(WT + (size_t)(drow0 + n) * Kd + k0 + 8 * c) = o; }
    LDS_WAIT(); asm volatile("" ::: "memory");
}
__device__ __forceinline__ void phase0(Frame& F, const Args& A) {
    const int tid = tid_(), lane = tid & 63; (void)lane;
    const int gtid = F.blk * NTHR + tid, NT_ALL = F.G * NTHR;
    if (F.blk == 0 && tid < 64) WSP(unsigned, WS_CTL)[tid] = 0u;
    if (F.blk == 0 && tid < 22) ((const float**)(F.ws + WS_PTRS))[tid] = A.in[tid];
    { v4u* p = WSP(v4u, WS_RTOK); for (int i = gtid; i < NEXP * ECAP / 4; i += NT_ALL) p[i] = (v4u){0u, 0u, 0u, 0u}; }
    for (int i = gtid; i < 24 * 1024; i += NT_ALL) { const int o = i >> 10, k = i & 1023; const int col = o < 8 ? 1536 + o : 4616 + (o - 8); WSP(float, WS_WSM)[i] = A.in[4][(size_t)k * INW + col]; }
    for (int i = gtid; i < 32 * 1024; i += NT_ALL) { const int e = i >> 10, k = i & 1023; WSP(float, WS_WRT)[i] = A.in[14][k * 32 + e]; }
    if (F.blk < 48) {
        LAS float* sc = (LAS float*)F.lds;
        for (int i = tid; i < 4096; i += NTHR) { const float v = A.in[1][i]; sc[i] = v * sigmoidf_(v); }
        __syncthreads();
        const int ks = gtid / 6144, j = gtid % 6144; float a0 = 0.f, a1 = 0.f, a2 = 0.f, a3 = 0.f;
        const float* wp = A.in[2] + (size_t)(ks * 256) * 6144 + j; const LAS float* s = sc + ks * 256;
#pragma unroll 8
        for (int k = 0; k < 256; ++k) { const float w = wp[(size_t)k * 6144]; a0 += s[k] * w; a1 += s[1024 + k] * w; a2 += s[2048 + k] * w; a3 += s[3072 + k] * w; }
        const float bb = ks == 0 ? A.in[3][j] : 0.f; float* mp = WSP(float, WS_MODP) + (size_t)ks * 4 * 6144 + j;
        mp[0] = a0 + bb; mp[6144] = a1 + bb; mp[2 * 6144] = a2 + bb; mp[3 * 6144] = a3 + bb;
        __syncthreads();
    }
    LAS float* scr = (LAS float*)(F.lds + 16384 + F.wave * 16384);
    const int gw = F.blk * NWAVES + F.wave, NGW = F.G * NWAVES;
    constexpr int I_IN = 16 * (NPROJ / 32), I_A = 8 * 32, I_B = 16 * 32, I_O = 16 * 32, I_UP = 16 * 64, I_DN = 16 * 32;
    constexpr int NITEMS = I_IN + I_A + I_B + I_O + NEXP * (I_UP + I_DN);
    for (int it = gw; it < NITEMS; it += NGW) {
        int r = it;
        if (r < I_IN) { const int nblk = NPROJ / 32, kb = r / nblk, nb = r % nblk, n0 = 32 * nb; const int sc0 = n0 + (n0 < 1536 ? 0 : (n0 < 4608 ? 8 : 24));
            p0_transpose_item(A.in[4], INW, sc0, WSP(bf16, WS_WIN), 1024, n0, 64 * kb, scr, lane); continue; } r -= I_IN;
        if (r < I_A) { const int kb = r / 32, nb = r % 32; p0_transpose_item(A.in[9], 1024, 32 * nb, WSP(bf16, WS_WA), 512, 32 * nb, 64 * kb, scr, lane); continue; } r -= I_A;
        if (r < I_B) { const int kb = r / 32, nb = r % 32; p0_transpose_item(A.in[10], 1024, 32 * nb, WSP(bf16, WS_WB), 1024, 32 * nb, 64 * kb, scr, lane); continue; } r -= I_B;
        if (r < I_O) { const int kb = r / 32, nb = r % 32; p0_transpose_item(A.in[11], 1024, 32 * nb, WSP(bf16, WS_WO), 1024, 32 * nb, 64 * kb, scr, lane); continue; } r -= I_O;
        const int e = r / (I_UP + I_DN); r -= e * (I_UP + I_DN);
        if (r < I_UP) { const int kb = r / 64, nb = r % 64, n0 = 32 * nb, tile = n0 >> 8, w = n0 & 255; const int sc0 = w < 128 ? 128 * tile + w : 1024 + 128 * tile + (w - 128);
            p0_transpose_item(A.in[16] + (size_t)e * 1024 * 2048, 2048, sc0, WSP(bf16, WS_WUP) + (size_t)e * 2048 * 1024, 1024, n0, 64 * kb, scr, lane); continue; } r -= I_UP;
        { const int kb = r / 32, nb = r % 32; p0_transpose_item(A.in[18] + (size_t)e * 1024 * 1024, 1024, 32 * nb, WSP(bf16, WS_WDN) + (size_t)e * 1024 * 1024, 1024, 32 * nb, 64 * kb, scr, lane); }
    }
}

__device__ __forceinline__ void phase1(Frame& F, const Args& A) {
    const int tid = tid_(), lane = tid & 63; (void)lane;
    LAS float* wsm = (LAS float*)F.lds;
    LAS float* mods = (LAS float*)(F.lds + 98304);
    const int b = F.blk / (F.G / NB);
    for (int i = tid; i < 24 * 1024 / 4; i += NTHR) ((LAS f32x4*)wsm)[i] = WSP(f32x4, WS_WSM)[i];
    for (int i = tid; i < 2048; i += NTHR) { const float* mp = WSP(float, WS_MODP) + (size_t)b * 6144 + i; mods[i] = (mp[0] + mp[4 * 6144]) + (mp[2 * 4 * 6144] + mp[3 * 4 * 6144]); }
    { const int gtid = F.blk * NTHR + tid; if (gtid < 4 * 6144) { const float* mp = WSP(float, WS_MODP) + gtid; WSP(float, WS_MODF)[gtid] = (mp[0] + mp[4 * 6144]) + (mp[2 * 4 * 6144] + mp[3 * 4 * 6144]); } }
    __syncthreads();
    const int rows_per_blk = T / F.G, rows_per_wave = rows_per_blk / NWAVES;
    const int row0 = F.blk * rows_per_blk + F.wave * rows_per_wave;
    const int oi = lane >> 1; const float fb = oi < 8 ? A.in[5][oi] : 0.f;
    for (int rr = 0; rr < rows_per_wave; ++rr) {
        const int row = row0 + rr;
        const f32x4* xr = (const f32x4*)(A.in[0] + (size_t)row * DM) + lane;
        f32x4 v[4]; float s = 0.f;
#pragma unroll
        for (int j = 0; j < 4; ++j) { v[j] = xr[64 * j]; s += (v[j].x + v[j].y) + (v[j].z + v[j].w); }
        const float mean = wave_sum(s) * (1.f / DM); float s2 = 0.f;
#pragma unroll
        for (int j = 0; j < 4; ++j) { v[j] = v[j] - mean; s2 += (v[j].x * v[j].x + v[j].y * v[j].y) + (v[j].z * v[j].z + v[j].w * v[j].w); }
        const float rstd = 1.f / sqrtf(wave_sum(s2) * (1.f / DM) + LN_EPS);
        unsigned long long* o8 = (unsigned long long*)(WSP(bf16, WS_U) + (size_t)row * DM) + lane;
#pragma unroll
        for (int j = 0; j < 4; ++j) { const f32x4 sh = *(const LAS f32x4*)(mods + 256 * j + 4 * lane), scv = *(const LAS f32x4*)(mods + 1024 + 256 * j + 4 * lane);
            v[j] = v[j] * rstd * (scv + 1.0f) + sh;
            o8[64 * j] = (unsigned long long)pk2(v[j].x, v[j].y) | ((unsigned long long)pk2(v[j].z, v[j].w) << 32); }
        float part[32];
#pragma unroll
        for (int o = 0; o < 24; ++o) { float a = 0.f;
#pragma unroll
            for (int j = 0; j < 4; ++j) { const f32x4 w = *(const LAS f32x4*)(wsm + o * 1024 + 256 * j + 4 * lane); a += (v[j].x * w.x + v[j].y * w.y) + (v[j].z * w.z + v[j].w * w.w); }
            part[o] = a; if ((o & 3) == 3) asm volatile("" ::: "memory"); }
#pragma unroll
        for (int o = 24; o < 32; ++o) part[o] = 0.f;
        const float tot = reduce32(part, lane);
        if ((lane & 1) == 0) {
            if (oi < 8) WSP(float, WS_FFL)[(size_t)row * 8 + oi] = logsigmoidf(tot + fb) * LOG2E;
            else if (oi < 24) WSP(float, WS_GLR)[(size_t)row * 16 + (oi - 8)] = tot;
        }
    }
}

constexpr int GC = 64, GDK = 128, GDV = 256, GNCH = SEQ / GC, GITEMS = NB * 4 * GNCH;
constexpr int KST = 136, VST = 264, PST = 72;
__device__ __forceinline__ void fox_cumsum_item(Frame& F, int bh) {
    const int tid = tid_(), lane = tid & 63; (void)lane;
    const int b = bh >> 3, h = bh & 7; LAS float* wt = (LAS float*)(F.lds + MISC_OFF);
    const float* src = WSP(float, WS_FFL) + (size_t)b * SEQ * 8 + h; float v[16]; float run = 0.f;
#pragma unroll
    for (int i = 0; i < 16; ++i) { run += src[(size_t)(tid * 16 + i) * 8]; v[i] = run; }
    float incl = run;
#pragma unroll
    for (int o = 1; o < 64; o <<= 1) { const float n = __shfl_up(incl, o); if (lane >= o) incl += n; }
    if (lane == 63) wt[F.wave] = incl;
    __syncthreads();
    float base = incl - run;
    for (int w = 0; w < F.wave; ++w) base += wt[w];
    float* dst = WSP(float, WS_CUM) + (size_t)bh * SEQ + tid * 16;
#pragma unroll
    for (int i = 0; i < 16; i += 4) *(f32x4*)(dst + i) = (f32x4){v[i] + base, v[i + 1] + base, v[i + 2] + base, v[i + 3] + base};
    __syncthreads();
}
__device__ __forceinline__ float gla_decay(Frame& F, int h, const LAS float* glrS, LAS float* totS, float (&p)[16]) {
    const int tid = tid_(), lane = tid & 63; (void)lane;
    const int c = tid & 127, tg = tid >> 7; float wg[16];
#pragma unroll
    for (int r = 0; r < 16; ++r) wg[r] = PT(6)[r * 512 + h * GDK + c];
    const float bg = PT(7)[h * GDK + c]; float run = 0.f;
#pragma unroll
    for (int i = 0; i < 16; ++i) { const LAS float* gr = glrS + (tg * 16 + i) * 16; float z = bg;
#pragma unroll
        for (int r = 0; r < 16; ++r) z += gr[r] * wg[r];
        run += logsigmoidf(z) * (1.0f / 16.0f); p[i] = run; }
    totS[tg * GDK + c] = run;
    __syncthreads();
    float off = 0.f, tot = 0.f;
#pragma unroll
    for (int g = 0; g < 4; ++g) { const float tv = totS[g * GDK + c]; tot += tv; if (g < tg) off += tv; }
#pragma unroll
    for (int i = 0; i < 16; ++i) p[i] += off;
    return tot;
}
__device__ __forceinline__ void gla_state_item(Frame& F, int item) {
    const int tid = tid_(), lane = tid & 63; (void)lane;
    const int n = item & (GNCH - 1), bh = item >> 7, h = bh & 3, b = bh >> 2; const size_t r0 = (size_t)b * SEQ + (size_t)n * GC;
    LAS bf16* KtS = (LAS bf16*)F.lds;
    LAS bf16* VS = (LAS bf16*)(F.lds + 17408);
    LAS float* glrS = (LAS float*)(F.lds + 17408 + 33792);
    LAS float* totS = glrS + 1024;
    if (tid < 256) ((LAS f32x4*)glrS)[tid] = ((const f32x4*)(WSP(float, WS_GLR) + r0 * 16))[tid];
#pragma unroll
    for (int i = 0; i < 4; ++i) { const int pc = tid + i * NTHR, t = pc >> 5, ch = pc & 31;
        *(LAS v4u*)(VS + t * VST + ch * 8) = *(const v4u*)(WSP(bf16, WS_GV) + (r0 + t) * 1024 + h * GDV + ch * 8); }
    __syncthreads();
    float p[16]; const float blast = gla_decay(F, h, glrS, totS, p);
    const int c = tid & 127, tg = tid >> 7;
#pragma unroll
    for (int i = 0; i < 16; ++i) { const int t = tg * 16 + i; const float kv = bf1(WSP(bf16, WS_GK)[(r0 + t) * 512 + h * GDK + c]);
        KtS[t * KST + c] = (bf16)f2bf(kv * __expf(blast - p[i])); }
    if (tg == 0) WSP(float, WS_DLAST)[(size_t)item * GDK + c] = __expf(blast);
    __syncthreads();
    f32x16 acc[4];
#pragma unroll
    for (int cb = 0; cb < 4; ++cb) acc[cb] = (f32x16){};
#pragma unroll
    for (int ks = 0; ks < 4; ++ks) { const bf16x8 a = frag_tr(VS, VST, 16 * ks, 32 * F.wave, lane);
#pragma unroll
        for (int cb = 0; cb < 4; ++cb) { const bf16x8 bb = frag_tr(KtS, KST, 16 * ks, 32 * cb, lane); acc[cb] = __builtin_amdgcn_mfma_f32_32x32x16_bf16(a, bb, acc[cb], 0, 0, 0); } }
    bf16* us = WSP(bf16, WS_US) + (size_t)item * GDK * GDV; const int hh = lane >> 5;
#pragma unroll
    for (int cb = 0; cb < 4; ++cb) { const int cc = 32 * cb + (lane & 31);
#pragma unroll
        for (int g = 0; g < 4; ++g) { v2u w; w.x = pk2(acc[cb][4 * g], acc[cb][4 * g + 1]); w.y = pk2(acc[cb][4 * g + 2], acc[cb][4 * g + 3]);
            *(v2u*)(us + (size_t)cc * GDV + 32 * F.wave + 8 * g + 4 * hh) = w; } }
    __syncthreads();
}
constexpr int CW_QKM = 64;
__device__ __forceinline__ void fox_norm_item(Frame& F, int item) {
    const int tid = tid_(), lane = tid & 63; (void)lane;
    const int bh = item >> 4, sl = item & 15, b = bh >> 3, h = bh & 7; const size_t row = (size_t)b * SEQ + sl * 512 + tid;
    const v4u* qp = (const v4u*)(WSP(bf16, WS_FQ) + row * 512 + h * 64); const v4u* kp = (const v4u*)(WSP(bf16, WS_FK) + row * 512 + h * 64);
    float q2 = 0.f, k2 = 0.f;
#pragma unroll
    for (int i = 0; i < 8; ++i) { const v4u a = qp[i], c = kp[i];
        q2 += (bfl(a.x) * bfl(a.x) + bfh(a.x) * bfh(a.x)) + (bfl(a.y) * bfl(a.y) + bfh(a.y) * bfh(a.y)) + (bfl(a.z) * bfl(a.z) + bfh(a.z) * bfh(a.z)) + (bfl(a.w) * bfl(a.w) + bfh(a.w) * bfh(a.w));
        k2 += (bfl(c.x) * bfl(c.x) + bfh(c.x) * bfh(c.x)) + (bfl(c.y) * bfl(c.y) + bfh(c.y) * bfh(c.y)) + (bfl(c.z) * bfl(c.z) + bfh(c.z) * bfh(c.z)) + (bfl(c.w) * bfl(c.w) + bfh(c.w) * bfh(c.w)); }
    q2 = wave_max(q2) * 1.0001f; k2 = wave_max(k2) * 1.0001f;
    if (lane == 0) { atomicMax(WSP(unsigned, WS_CTL) + CW_QKM + bh, __float_as_uint(q2)); atomicMax(WSP(unsigned, WS_CTL) + CW_QKM + 32 + bh, __float_as_uint(k2)); }
}
__device__ __forceinline__ void phase3(Frame& F) {
    if (F.blk < 32) fox_cumsum_item(F, F.blk);
    for (int it = F.blk; it < 512; it += F.G) fox_norm_item(F, it);
    for (int it = F.blk; it < GITEMS; it += F.G) gla_state_item(F, it);
}

__device__ __forceinline__ void gla_scan(Frame& F) {
    const int tid = tid_(), lane = tid & 63; (void)lane;
    const int NTOT = 16 * GDK * GDV / 4;
    for (int gt = F.blk * NTHR + tid; gt < NTOT; gt += F.G * NTHR) {
        const int bh = gt / (GDK * GDV / 4), e4 = gt % (GDK * GDV / 4), c = e4 >> 6;
        bf16* p = WSP(bf16, WS_US) + (size_t)bh * GNCH * GDK * GDV + (size_t)e4 * 4; const float* dl = WSP(float, WS_DLAST) + (size_t)bh * GNCH * GDK + c;
        float s0 = 0.f, s1 = 0.f, s2 = 0.f, s3 = 0.f;
        for (int n0 = 0; n0 < GNCH; n0 += 8) { v2u u[8]; float d[8];
#pragma unroll
            for (int j = 0; j < 8; ++j) { u[j] = *(const v2u*)(p + (size_t)(n0 + j) * GDK * GDV); d[j] = dl[(size_t)(n0 + j) * GDK]; }
#pragma unroll
            for (int j = 0; j < 8; ++j) { v2u o; o.x = pk2(s0, s1); o.y = pk2(s2, s3); *(v2u*)(p + (size_t)(n0 + j) * GDK * GDV) = o;
                s0 = d[j] * s0 + bfl(u[j].x); s1 = d[j] * s1 + bfh(u[j].x); s2 = d[j] * s2 + bfl(u[j].y); s3 = d[j] * s3 + bfh(u[j].y); } }
    }
}

__device__ __forceinline__ void gla_out_item(Frame& F, int item) {
    const int tid = tid_(), lane = tid & 63; (void)lane;
    const int n = item & (GNCH - 1), bh = item >> 7, h = bh & 3, b = bh >> 2; const size_t r0 = (size_t)b * SEQ + (size_t)n * GC;
    LAS bf16* QhS = (LAS bf16*)F.lds;
    LAS bf16* KcS = (LAS bf16*)(F.lds + 17408);
    LAS bf16* PS = (LAS bf16*)(F.lds + 34816);
    LAS bf16* VS = (LAS bf16*)(F.lds + 44032);
    LAS bf16* SS = (LAS bf16*)(F.lds + 77824);
    LAS float* glrS = (LAS float*)(F.lds + 145408);
    LAS float* totS = glrS + 1024;
    LAS float* oS = (LAS float*)(F.lds + 44032);
    if (tid < 256) ((LAS f32x4*)glrS)[tid] = ((const f32x4*)(WSP(float, WS_GLR) + r0 * 16))[tid];
#pragma unroll
    for (int i = 0; i < 4; ++i) { const int pc = tid + i * NTHR, t = pc >> 5, ch = pc & 31;
        *(LAS v4u*)(VS + t * VST + ch * 8) = *(const v4u*)(WSP(bf16, WS_GV) + (r0 + t) * 1024 + h * GDV + ch * 8); }
    { const bf16* sp = WSP(bf16, WS_US) + (size_t)item * GDK * GDV;
#pragma unroll
      for (int i = 0; i < 8; ++i) { const int pc = tid + i * NTHR, cc = pc >> 5, ch = pc & 31; *(LAS v4u*)(SS + cc * VST + ch * 8) = *(const v4u*)(sp + (size_t)cc * GDV + ch * 8); } }
    __syncthreads();
    float p[16]; (void)gla_decay(F, h, glrS, totS, p);
    { const int c = tid & 127, tg = tid >> 7;
#pragma unroll
      for (int i = 0; i < 16; ++i) { const int t = tg * 16 + i; const size_t go = (r0 + t) * 512 + h * GDK + c;
          const float qv = bf1(WSP(bf16, WS_GQ)[go]), kv = bf1(WSP(bf16, WS_GK)[go]);
          QhS[t * KST + c] = (bf16)f2bf(qv * __expf(p[i])); KcS[t * KST + c] = (bf16)f2bf(kv * __expf(-p[i])); } }
    __syncthreads();
    if (F.wave < 4) { const int tb = F.wave >> 1, sb = F.wave & 1; f32x16 pa = (f32x16){};
#pragma unroll
        for (int ks = 0; ks < 8; ++ks) pa = __builtin_amdgcn_mfma_f32_32x32x16_bf16(frag_row(QhS, KST, 32 * tb, 16 * ks, lane), frag_row(KcS, KST, 32 * sb, 16 * ks, lane), pa, 0, 0, 0);
        const int s = 32 * sb + (lane & 31), hh = lane >> 5;
#pragma unroll
        for (int r = 0; r < 16; ++r) { const int t = 32 * tb + crow16(r, hh); PS[t * PST + s] = (bf16)f2bf(s <= t ? pa[r] : 0.f); } }
    __syncthreads();
    f32x16 acc[2]; acc[0] = (f32x16){}; acc[1] = (f32x16){};
#pragma unroll
    for (int ks = 0; ks < 8; ++ks) { const bf16x8 bb = frag_tr(SS, VST, 16 * ks, 32 * F.wave, lane);
#pragma unroll
        for (int tb = 0; tb < 2; ++tb) acc[tb] = __builtin_amdgcn_mfma_f32_32x32x16_bf16(frag_row(QhS, KST, 32 * tb, 16 * ks, lane), bb, acc[tb], 0, 0, 0); }
#pragma unroll
    for (int ks = 0; ks < 4; ++ks) { const bf16x8 bb = frag_tr(VS, VST, 16 * ks, 32 * F.wave, lane);
#pragma unroll
        for (int tb = 0; tb < 2; ++tb) acc[tb] = __builtin_amdgcn_mfma_f32_32x32x16_bf16(frag_row(PS, PST, 32 * tb, 16 * ks, lane), bb, acc[tb], 0, 0, 0); }
    __syncthreads();
    { const int dv = 32 * F.wave + (lane & 31), hh = lane >> 5;
#pragma unroll
      for (int tb = 0; tb < 2; ++tb)
#pragma unroll
          for (int r = 0; r < 16; ++r) oS[(32 * tb + crow16(r, hh)) * 260 + dv] = acc[tb][r]; }
    __syncthreads();
    { const f32x4 gn = *(gf4ptr_t)(PT(8) + h * GDV + 4 * lane);
#pragma unroll 2
      for (int i = 0; i < 8; ++i) { const int t = 8 * F.wave + i; const f32x4 o = *(const LAS f32x4*)(oS + t * 260 + 4 * lane);
          const float ss = wave_sum((o.x * o.x + o.y * o.y) + (o.z * o.z + o.w * o.w)); const float rs = 1.f / sqrtf(ss * (1.f / GDV) + LN_EPS);
          const v2u g = *(const v2u*)(WSP(bf16, WS_GR) + (r0 + t) * 1024 + h * GDV + 4 * lane);
          const float g0 = bfl(g.x), g1 = bfh(g.x), g2 = bfl(g.y), g3 = bfh(g.y);
          v2u w; w.x = pk2(o.x * rs * gn.x * (g0 * sigmoidf_(g0)), o.y * rs * gn.y * (g1 * sigmoidf_(g1))); w.y = pk2(o.z * rs * gn.z * (g2 * sigmoidf_(g2)), o.w * rs * gn.w * (g3 * sigmoidf_(g3)));
          *(v2u*)(WSP(bf16, WS_GV) + (r0 + t) * 1024 + h * GDV + 4 * lane) = w; } }
    __syncthreads();
}

__device__ __forceinline__ void phase9(Frame& F) {
    const int tid = tid_(), lane = tid & 63; (void)lane;
    LAS float* wr = (LAS float*)F.lds;
    LAS int* lcnt = (LAS int*)(F.lds + MISC_OFF);
    LAS int* rec_e = lcnt + 64; LAS int* rec_i = rec_e + 512; LAS float* rec_g = (LAS float*)(rec_i + 512);
    const int rows_per_blk = T / F.G, rows_per_wave = rows_per_blk / NWAVES;
    const int b = F.blk / (F.G / NB);
    for (int i = tid; i < 32 * 1024 / 4; i += NTHR) ((LAS f32x4*)wr)[i] = WSP(f32x4, WS_WRT)[i];
    if (tid < 64) lcnt[tid] = 0;
    __syncthreads();
    const float* modf = WSP(float, WS_MODF) + (size_t)b * 6144;
    const int ei = lane >> 1; const float rb = PT(15)[ei];
    for (int rr = 0; rr < rows_per_wave; ++rr) {
        const int rl = F.wave * rows_per_wave + rr, row = F.blk * rows_per_blk + rl;
        f32x4* zr = (f32x4*)(F.out + (size_t)row * DM) + lane;
        f32x4 v[4]; float s = 0.f;
#pragma unroll
        for (int j = 0; j < 4; ++j) { v[j] = zr[64 * j]; s += (v[j].x + v[j].y) + (v[j].z + v[j].w); }
        float mean = wave_sum(s) * (1.f / DM), s2 = 0.f;
#pragma unroll
        for (int j = 0; j < 4; ++j) { v[j] = v[j] - mean; s2 += (v[j].x * v[j].x + v[j].y * v[j].y) + (v[j].z * v[j].z + v[j].w * v[j].w); }
        float rstd = 1.f / sqrtf(wave_sum(s2) * (1.f / DM) + LN_EPS);
        s = 0.f;
#pragma unroll
        for (int j = 0; j < 4; ++j) { const f32x4 g = *(gf4ptr_t)(PT(12) + 256 * j + 4 * lane), bb = *(gf4ptr_t)(PT(13) + 256 * j + 4 * lane);
            v[j] = v[j] * rstd * g + bb; zr[64 * j] = v[j]; s += (v[j].x + v[j].y) + (v[j].z + v[j].w); }
        mean = wave_sum(s) * (1.f / DM); s2 = 0.f;
#pragma unroll
        for (int j = 0; j < 4; ++j) { v[j] = v[j] - mean; s2 += (v[j].x * v[j].x + v[j].y * v[j].y) + (v[j].z * v[j].z + v[j].w * v[j].w); }
        rstd = 1.f / sqrtf(wave_sum(s2) * (1.f / DM) + LN_EPS);
        unsigned long long* o8 = (unsigned long long*)(WSP(bf16, WS_U2) + (size_t)row * DM) + lane;
#pragma unroll
        for (int j = 0; j < 4; ++j) { const f32x4 sh = *(const f32x4*)(modf + 3072 + 256 * j + 4 * lane), scv = *(const f32x4*)(modf + 4096 + 256 * j + 4 * lane);
            v[j] = v[j] * rstd * (scv + 1.0f) + sh;
            o8[64 * j] = (unsigned long long)pk2(v[j].x, v[j].y) | ((unsigned long long)pk2(v[j].z, v[j].w) << 32); }
        float part[32];
#pragma unroll
        for (int o = 0; o < 32; ++o) { float a = 0.f;
#pragma unroll
            for (int j = 0; j < 4; ++j) { const f32x4 w = *(const LAS f32x4*)(wr + o * 1024 + 256 * j + 4 * lane); a += (v[j].x * w.x + v[j].y * w.y) + (v[j].z * w.z + v[j].w * w.w); }
            part[o] = a; if ((o & 3) == 3) asm volatile("" ::: "memory"); }
        float lg = reduce32(part, lane) + rb;
        int ek[4]; float vk[4];
#pragma unroll
        for (int k = 0; k < 4; ++k) { const float m = wave_max(lg); const unsigned long long bal = __ballot(lg == m); const int src = __ffsll((long long)bal) - 1;
            ek[k] = src >> 1; vk[k] = m; if (ei == ek[k]) lg = -INFINITY; }
        const float w1 = __expf(vk[1] - vk[0]), w2 = __expf(vk[2] - vk[0]), w3 = __expf(vk[3] - vk[0]); const float inv = 1.f / (1.f + w1 + w2 + w3);
        if (lane < 4) { const int e = lane == 0 ? ek[0] : lane == 1 ? ek[1] : lane == 2 ? ek[2] : ek[3]; const float gk = (lane == 0 ? 1.f : lane == 1 ? w1 : lane == 2 ? w2 : w3) * inv;
            const int li = atomicAdd((int*)(lcnt + e), 1);
            rec_e[rl * 4 + lane] = e; rec_i[rl * 4 + lane] = li; rec_g[rl * 4 + lane] = gk; }
    }
    __syncthreads();
    if (tid < 32) lcnt[32 + tid] = (int)atomicAdd(WSP(unsigned, WS_CTL) + tid, (unsigned)lcnt[tid]);
    __syncthreads();
    for (int r = tid; r < rows_per_blk * 4; r += NTHR) { const int e = rec_e[r], idx = lcnt[32 + e] + rec_i[r], tok = F.blk * rows_per_blk + (r >> 2);
        WSP(int, WS_RTOK)[e * ECAP + idx] = tok; WSP(int, WS_TSLOT)[(size_t)tok * 4 + (r & 3)] = e * ECAP + idx; WSP(float, WS_TGATE)[(size_t)tok * 4 + (r & 3)] = rec_g[r]; }
    __syncthreads();
}
__device__ __forceinline__ void moe_tables(Frame& F, LAS int* tstart) {
    const int tid = tid_(), lane = tid & 63; (void)lane;
    if (tid == 0) { int run = 0; for (int e = 0; e < NEXP; ++e) { tstart[e] = run; run += (int)((WSP(unsigned, WS_CTL)[e] + 255u) >> 8); } tstart[NEXP] = run; }
    __syncthreads();
}
__device__ __forceinline__ void phase12(Frame& F) {
    const int tid = tid_(), lane = tid & 63; (void)lane;
    LAS int* tstart = (LAS int*)(F.lds + MISC_OFF);
    moe_tables(F, tstart);
    const int rows_per_blk = T / F.G, rows_per_wave = rows_per_blk / NWAVES; const int b = F.blk / (F.G / NB);
    const float* modf = WSP(float, WS_MODF) + (size_t)b * 6144;
    for (int rr = 0; rr < rows_per_wave; ++rr) {
        const int row = F.blk * rows_per_blk + F.wave * rows_per_wave + rr;
        f32x4* xr = (f32x4*)(F.out + (size_t)row * DM) + lane;
        f32x4 y[4];
#pragma unroll
        for (int j = 0; j < 4; ++j) y[j] = (f32x4){0.f, 0.f, 0.f, 0.f};
#pragma unroll
        for (int k = 0; k < 4; ++k) { const int sl = WSP(int, WS_TSLOT)[(size_t)row * 4 + k]; const float gk = WSP(float, WS_TGATE)[(size_t)row * 4 + k];
            const int e = sl >> 15, idx = sl & (ECAP - 1); const size_t srow = (size_t)tstart[e] * 256 + idx;
            const v2u* mp = (const v2u*)(WSP(bf16, WS_MOE) + srow * DM) + lane;
#pragma unroll
            for (int j = 0; j < 4; ++j) { const v2u w = mp[64 * j]; y[j].x += gk * bfl(w.x); y[j].y += gk * bfh(w.x); y[j].z += gk * bfl(w.y); y[j].w += gk * bfh(w.y); } }
        f32x4 v[4]; float s = 0.f;
#pragma unroll
        for (int j = 0; j < 4; ++j) { const f32x4 g2 = *(const f32x4*)(modf + 5120 + 256 * j + 4 * lane); v[j] = xr[64 * j] * ALPHA + (g2 + 1.0f) * y[j]; s += (v[j].x + v[j].y) + (v[j].z + v[j].w); }
        const float mean = wave_sum(s) * (1.f / DM); float s2 = 0.f;
#pragma unroll
        for (int j = 0; j < 4; ++j) { v[j] = v[j] - mean; s2 += (v[j].x * v[j].x + v[j].y * v[j].y) + (v[j].z * v[j].z + v[j].w * v[j].w); }
        const float rstd = 1.f / sqrtf(wave_sum(s2) * (1.f / DM) + LN_EPS);
#pragma unroll
        for (int j = 0; j < 4; ++j) { const f32x4 g = *(gf4ptr_t)(PT(20) + 256 * j + 4 * lane), bb = *(gf4ptr_t)(PT(21) + 256 * j + 4 * lane); xr[64 * j] = v[j] * rstd * g + bb; }
    }
}

constexpr int NPHASE = 13;
__global__ void __launch_bounds__(NTHR, 2) fwd_kernel(Args args) {
    extern __shared__ __attribute__((aligned(16))) unsigned char lds[];
    Frame F;
    F.lds = (LAS unsigned char*)lds; F.wave = __builtin_amdgcn_readfirstlane((int)threadIdx.x >> 6); F.G = gridDim.x; F.blk = blockIdx.x;
    F.out = args.out; F.ws = args.ws;
    const int lo = args.ph_lo, hi = args.ph_hi;
#ifndef PH_MASK
#define PH_MASK 0xffff
#endif
#define IN(k) (((PH_MASK >> (k)) & 1) && lo <= (k) && (k) < hi)
#if MK_N_LAUNCHES == 1
    if (threadIdx.x < 2) ((LAS unsigned*)(F.lds + BARLDS_OFF))[threadIdx.x] = 0u;
    __syncthreads();
    const XcdBarrier bar = xcd_barrier_post(WSP(unsigned, WS_CTL) + CW_BAR, (volatile LAS unsigned*)(F.lds + BARLDS_OFF));
#define SEAM(k) do { if (IN(k) && IN((k) + 1)) { if ((k) == 0) cg::this_grid().sync(); else xcd_barrier(bar); } } while (0)
#else
#define SEAM(k) do { } while (0)
#endif
    typedef pg8::bf16_t pbf;
    if (IN(0)) { phase0(F, args); } SEAM(0);
    if (IN(1)) { phase1(F, args); } SEAM(1);
    if (IN(2)) {
        pg8::Gemm g{WSP(pbf, WS_U), WSP(pbf, WS_WIN), 1024, nullptr}; pg8::DenseOrder S{T / 256, NPROJ / 256, F.G, F.blk};
        pg8::EpiInProj E{WSP(pbf, WS_FQ), WSP(pbf, WS_FK), WSP(pbf, WS_FV), WSP(pbf, WS_GQ), WSP(pbf, WS_GK), WSP(pbf, WS_GV), WSP(pbf, WS_GR), WSP(pbf, WS_GA), WSP(pbf, WS_GB), 0.125f * LOG2E, 0.08838834764831845f};
        pg8::gemm_phase<pg8::EpiInProj, pg8::DenseOrder, false, true>(F.lds, g, S, E);
    } SEAM(2);
    if (IN(3)) { phase3(F); } SEAM(3);
    if (IN(4)) {
        gla_scan(F);
        __syncthreads();
        const attn_body::AttnTensors AT{(const attn_body::bf16*)WSP(pbf, WS_FQ), (const attn_body::bf16*)WSP(pbf, WS_FK), (const attn_body::bf16*)WSP(pbf, WS_FV), (attn_body::bf16*)WSP(pbf, WS_FQ), WSP(float, WS_CUM), WSP(unsigned, WS_CTL) + CW_QKM};
        const attn_body::StaticOrder S((int)F.G, (int)F.blk);
        attn_body::attn_phase<attn_body::StaticOrder>((char*)lds, AT, S);
    } SEAM(4);
    if (IN(5)) { for (int it = F.blk; it < GITEMS; it += F.G) gla_out_item(F, it); } SEAM(5);
    if (IN(6)) {
        pg8::Gemm g{WSP(pbf, WS_FQ), WSP(pbf, WS_WA), 512, nullptr}; pg8::DenseOrder S{T / 256, 4, F.G, F.blk};
        pg8::EpiGate<false> E{WSP(pbf, WS_U), WSP(pbf, WS_GA)};
        pg8::gemm_phase<pg8::EpiGate<false>, pg8::DenseOrder, false, true>(F.lds, g, S, E);
    }
    if (IN(6) && IN(7)) { __syncthreads(); }
    if (IN(7)) {
        pg8::Gemm g{WSP(pbf, WS_GV), WSP(pbf, WS_WB), 1024, nullptr}; pg8::DenseOrder S{T / 256, 4, F.G, F.blk};
        pg8::EpiGate<true> E{WSP(pbf, WS_U), WSP(pbf, WS_GB)};
        pg8::gemm_phase<pg8::EpiGate<true>, pg8::DenseOrder, false, true>(F.lds, g, S, E);
    } SEAM(7);
    if (IN(8)) {
        pg8::Gemm g{WSP(pbf, WS_U), WSP(pbf, WS_WO), 1024, nullptr}; pg8::DenseOrder S{T / 256, 4, F.G, F.blk};
        pg8::EpiResid E{PT(0), F.out, WSP(float, WS_MODF) + 2048, 6144, SEQ, ALPHA};
        pg8::gemm_phase<pg8::EpiResid, pg8::DenseOrder, false, true>(F.lds, g, S, E);
    } SEAM(8);
    if (IN(9)) { phase9(F); } SEAM(9);
    if (IN(10)) {
        LAS int* tstart = (LAS int*)(F.lds + MISC_OFF); moe_tables(F, tstart);
        pg8::Gemm g{WSP(pbf, WS_U2), WSP(pbf, WS_WUP), 1024, WSP(int, WS_RTOK)}; pg8::MoeOrder S{tstart[NEXP], 8, F.G, F.blk, tstart};
        pg8::EpiSwiglu E{WSP(pbf, WS_ACT), PT(17), 8};
        pg8::gemm_phase<pg8::EpiSwiglu, pg8::MoeOrder, true, true>(F.lds, g, S, E);
    } SEAM(10);
    if (IN(11)) {
        LAS int* tstart = (LAS int*)(F.lds + MISC_OFF); moe_tables(F, tstart);
        pg8::Gemm g{WSP(pbf, WS_ACT), WSP(pbf, WS_WDN), 1024, nullptr}; pg8::MoeOrder S{tstart[NEXP], 4, F.G, F.blk, tstart};
        pg8::EpiDown E{WSP(pbf, WS_MOE), PT(19), 4};
        pg8::gemm_phase<pg8::EpiDown, pg8::MoeOrder, false, true>(F.lds, g, S, E);
    } SEAM(11);
    if (IN(12)) { phase12(F); }
#undef IN
#undef SEAM
}

extern "C" void kernel_launch(void* const* d_in, const int* in_sizes, int n_in, void* d_out, int out_size, void* d_ws, size_t ws_size, hipStream_t stream) {
    static int grid = 0;
    if (grid == 0) {
        if (n_in != 22 || in_sizes[0] != T * DM || out_size != T * DM || ws_size < WS_END) { fprintf(stderr, "kernel_launch: unexpected shapes (n_in %d, x %d, out %d, ws %zu < %zu); nothing launched\n", n_in, n_in > 0 ? in_sizes[0] : -1, out_size, ws_size, (size_t)WS_END); grid = -1; return; }
        int dev = 0, cus = 0, per_cu = 0;
        if (hipGetDevice(&dev) != hipSuccess || hipDeviceGetAttribute(&cus, hipDeviceAttributeMultiprocessorCount, dev) != hipSuccess) { grid = -1; return; }
        if (hipFuncSetAttribute((const void*)fwd_kernel, hipFuncAttributeMaxDynamicSharedMemorySize, LDS_BYTES) != hipSuccess) { fprintf(stderr, "kernel_launch: hipFuncSetAttribute failed\n"); grid = -1; return; }
        if (hipOccupancyMaxActiveBlocksPerMultiprocessor(&per_cu, (const void*)fwd_kernel, NTHR, LDS_BYTES) != hipSuccess || per_cu < 1) { fprintf(stderr, "kernel_launch: occupancy query says %d blocks per CU\n", per_cu); (void)hipGetLastError(); grid = -1; return; }
        grid = cus;
        if (grid != 256) { fprintf(stderr, "kernel_launch: built for a 256-CU device, found %d CUs; nothing launched\n", cus); grid = -1; return; }
    }
    if (grid < 0) return;
    if (hipMemsetAsync((char*)d_ws + WS_CTL, 0, CTL_ZERO_BYTES, stream) != hipSuccess) { fprintf(stderr, "kernel_launch: hipMemsetAsync failed\n"); return; }
    Args a{};
    for (int i = 0; i < 22; ++i) a.in[i] = (const float*)d_in[i];
    a.out = (float*)d_out; a.ws = (unsigned char*)d_ws;
#if MK_N_LAUNCHES == 1
    a.ph_lo = 0; a.ph_hi = NPHASE;
    void* kargs[] = {&a};
    hipError_t e = hipLaunchCooperativeKernel((const void*)fwd_kernel, dim3(grid), dim3(NTHR), kargs, LDS_BYTES, stream);
    if (e != hipSuccess) fprintf(stderr, "kernel_launch: cooperative launch failed: %s\n", hipGetErrorString(e));
#else
    for (int p = 0; p < NPHASE; ++p) {
        if (p == 7) continue;
        a.ph_lo = p; a.ph_hi = (p == 6) ? 8 : p + 1;
        hipLaunchKernelGGL(fwd_kernel, dim3(grid), dim3(NTHR), LDS_BYTES, stream, a);
    }
#endif
}
```

```cpp
#include <hip/hip_runtime.h>
#include <hip/hip_bf16.h>
#include <hip/hip_cooperative_groups.h>
#include <cstdio>
#include <cstdint>
#include <cmath>
namespace cg = cooperative_groups;

#ifndef MK_N_LAUNCHES
#define MK_N_LAUNCHES 1
#endif

namespace pg8 {
#define PG8_LAS __attribute__((address_space(3)))
#define PG8_GAS __attribute__((address_space(1)))
typedef unsigned short bf16_t;
typedef short bf16x8 __attribute__((ext_vector_type(8)));
typedef float f32x4 __attribute__((ext_vector_type(4)));
typedef float f32x2 __attribute__((ext_vector_type(2)));
typedef unsigned u32x4 __attribute__((ext_vector_type(4)));
constexpr int BM = 256, BK = 64, HALF = 128, HTB = HALF * BK * 2, STAGE_BYTES = 8 * HTB, NXCD = 8, WGM = 8;

__host__ __device__ __forceinline__ int lds_byte(int r, int c) { const int st = (r >> 4) * 2 + (c >> 5), rr = r & 15, cc = c & 31, ob = rr * 64 + cc * 2; return st * 1024 + (ob ^ (((ob >> 9) & 1) << 5)); }
__host__ __device__ __forceinline__ void stage_rc(int b, int& R, int& C) { const int st = b / 1024, sb = b % 1024, swz = sb ^ (((sb >> 9) & 1) << 5); R = (st >> 1) * 16 + swz / 64; C = (st & 1) * 32 + (swz % 64) / 2; }
__host__ __device__ __forceinline__ int perm32(int rho) { const int n = rho >> 4, i = rho & 15; return 8 * (i >> 2) + 4 * n + (i & 3); }

struct Unit { int pm, pn, e, rl; };
struct Gemm { const bf16_t* A; const bf16_t* Bt; int K; const int* rows; };

__device__ __forceinline__ bool tile_of(long L, int nM, int nN, int& pm, int& pn) {
    const int nwg = nM * nN; if (L >= nwg) return false;
    int wgid = (int)L; { const int q = nwg / NXCD, r = nwg % NXCD, xcd = wgid % NXCD, off = wgid / NXCD; wgid = (xcd < r ? xcd * (q + 1) : r * (q + 1) + (xcd - r) * q) + off; }
    const int nig = WGM * nN, gid = wgid / nig, fm = gid * WGM, gsz = (nM - fm) < WGM ? (nM - fm) : WGM;
    pm = fm + ((wgid % nig) % gsz); pn = (wgid % nig) / gsz; return true;
}
struct DenseOrder {
    int nM, nN, G, c;
    __device__ __forceinline__ bool next(int i, Unit& u) const { u.e = 0; u.rl = 0; return tile_of((long)i * G + c, nM, nN, u.pm, u.pn); }
};
struct MoeOrder {
    int nM, nN, G, c; const PG8_LAS int* tstart;
    __device__ __forceinline__ bool next(int i, Unit& u) const {
        int rt, pnl; if (!tile_of((long)i * G + c, nM, nN, rt, pnl)) return false;
        int e = 0;
#pragma unroll 1
        for (int j = 1; j < 32; ++j) if (tstart[j] <= rt) e = j;
        u.pm = rt; u.e = e; u.pn = e * nN + pnl; u.rl = e * 32768 + (rt - tstart[e]) * 256; return true;
    }
};

__device__ __forceinline__ unsigned cvt_pk_bf16(float lo, float hi) { unsigned r; asm volatile("v_cvt_pk_bf16_f32 %0, %1, %2" : "=v"(r) : "v"(lo), "v"(hi)); return r; }
__device__ __forceinline__ float bf_lo(unsigned w) { return __uint_as_float(w << 16); }
__device__ __forceinline__ float bf_hi(unsigned w) { return __uint_as_float(w & 0xffff0000u); }
__device__ __forceinline__ float sigm(float x) { return 1.0f / (1.0f + __expf(-x)); }


struct EpiInProj {
    static constexpr bool PERM = true;
    bf16_t *fq, *fk, *fv, *gq, *gk, *gv, *gr, *ga, *gb; float qscale, gqscale;
    __device__ __forceinline__ void operator()(const f32x4 (&acc)[2][2][4][2], const Unit& u, int wr, int wc, int fr, int fq_) const {
        const int pn = u.pn; bf16_t* base; int ldc, ct; float sc = 1.f; bool sg = false;
        if (pn < 2) { base = fq; ldc = 512; ct = pn; sc = qscale; } else if (pn < 4) { base = fk; ldc = 512; ct = pn - 2; } else if (pn < 6) { base = fv; ldc = 512; ct = pn - 4; }
        else if (pn < 8) { base = gq; ldc = 512; ct = pn - 6; sc = gqscale; } else if (pn < 10) { base = gk; ldc = 512; ct = pn - 8; }
        else if (pn < 14) { base = gv; ldc = 1024; ct = pn - 10; } else if (pn < 18) { base = gr; ldc = 1024; ct = pn - 14; }
        else if (pn < 22) { base = ga; ldc = 1024; ct = pn - 18; sg = true; } else { base = gb; ldc = 1024; ct = pn - 22; sg = true; }
        const int row0 = u.pm * BM + wr * 64 + fr, col0 = ct * BM + wc * 32 + 8 * fq_;
#pragma unroll
        for (int ai = 0; ai < 2; ++ai)
#pragma unroll
            for (int m = 0; m < 4; ++m) { bf16_t* rowp = base + (size_t)(row0 + ai * HALF + m * 16) * ldc + col0;
#pragma unroll
                for (int bj = 0; bj < 2; ++bj) { f32x4 v0 = acc[ai][bj][m][0], v1 = acc[ai][bj][m][1];
                    if (sg) {
#pragma unroll
                        for (int i = 0; i < 4; ++i) { v0[i] = sigm(v0[i]); v1[i] = sigm(v1[i]); } }
                    else { v0 = v0 * sc; v1 = v1 * sc; }
                    u32x4 w; w.x = cvt_pk_bf16(v0[0], v0[1]); w.y = cvt_pk_bf16(v0[2], v0[3]); w.z = cvt_pk_bf16(v1[0], v1[1]); w.w = cvt_pk_bf16(v1[2], v1[3]);
                    *(u32x4*)(rowp + bj * HALF) = w; } }
    }
};
template <bool ADD> struct EpiGate {
    static constexpr bool PERM = true;
    bf16_t* O; const bf16_t* gate;
    __device__ __forceinline__ void operator()(const f32x4 (&acc)[2][2][4][2], const Unit& u, int wr, int wc, int fr, int fq_) const {
        const int row0 = u.pm * BM + wr * 64 + fr, col0 = u.pn * BM + wc * 32 + 8 * fq_;
#pragma unroll
        for (int ai = 0; ai < 2; ++ai)
#pragma unroll
            for (int m = 0; m < 4; ++m) { const size_t off = (size_t)(row0 + ai * HALF + m * 16) * 1024 + col0;
#pragma unroll
                for (int bj = 0; bj < 2; ++bj) { const f32x4 a0 = acc[ai][bj][m][0], a1 = acc[ai][bj][m][1];
                    const u32x4 g = *(const u32x4*)(gate + off + bj * HALF);
                    float r[8] = { a0[0] * bf_lo(g.x), a0[1] * bf_hi(g.x), a0[2] * bf_lo(g.y), a0[3] * bf_hi(g.y), a1[0] * bf_lo(g.z), a1[1] * bf_hi(g.z), a1[2] * bf_lo(g.w), a1[3] * bf_hi(g.w) };
                    if (ADD) { const u32x4 o = *(const u32x4*)(O + off + bj * HALF);
                        r[0] += bf_lo(o.x); r[1] += bf_hi(o.x); r[2] += bf_lo(o.y); r[3] += bf_hi(o.y); r[4] += bf_lo(o.z); r[5] += bf_hi(o.z); r[6] += bf_lo(o.w); r[7] += bf_hi(o.w); }
                    u32x4 w; w.x = cvt_pk_bf16(r[0], r[1]); w.y = cvt_pk_bf16(r[2], r[3]); w.z = cvt_pk_bf16(r[4], r[5]); w.w = cvt_pk_bf16(r[6], r[7]);
                    *(u32x4*)(O + off + bj * HALF) = w; } }
    }
};
struct EpiResid {
    static constexpr bool PERM = false;
    const PG8_GAS float* x; float* z; const float* g1; int g1_bstride; int rows_per_batch; float alpha;
    __device__ __forceinline__ void operator()(const f32x4 (&acc)[2][2][4][2], const Unit& u, int wr, int wc, int fr, int fq_) const {
        const int row0 = u.pm * BM + wr * 64 + fr, col0 = u.pn * BM + wc * 32 + 4 * fq_;
        const float* gp = g1 + (size_t)((u.pm * BM) / rows_per_batch) * g1_bstride + col0;
        f32x4 gv[2][2];
#pragma unroll
        for (int bj = 0; bj < 2; ++bj)
#pragma unroll
            for (int n = 0; n < 2; ++n) gv[bj][n] = *(const f32x4*)(gp + bj * HALF + n * 16) + 1.0f;
#pragma unroll
        for (int ai = 0; ai < 2; ++ai)
#pragma unroll
            for (int m = 0; m < 4; ++m) { const size_t off = (size_t)(row0 + ai * HALF + m * 16) * 1024 + col0;
#pragma unroll
                for (int bj = 0; bj < 2; ++bj)
#pragma unroll
                    for (int n = 0; n < 2; ++n) { const f32x4 xv = *(const PG8_GAS f32x4*)(x + off + bj * HALF + n * 16);
                        *(f32x4*)(z + off + bj * HALF + n * 16) = xv * alpha + gv[bj][n] * acc[ai][bj][m][n]; } }
    }
};
struct EpiSwiglu {
    static constexpr bool PERM = true;
    bf16_t* act; const PG8_GAS float* b_up; int nNe;
    __device__ __forceinline__ void operator()(const f32x4 (&acc)[2][2][4][2], const Unit& u, int wr, int wc, int fr, int fq_) const {
        const int pnl = u.pn - u.e * nNe; const int row0 = u.pm * BM + wr * 64 + fr, cl = pnl * HALF + wc * 32 + 8 * fq_;
        const PG8_GAS float* bp = b_up + (size_t)u.e * 2048 + cl;
        const f32x4 bg0 = *(const PG8_GAS f32x4*)(bp), bg1 = *(const PG8_GAS f32x4*)(bp + 4), bl0 = *(const PG8_GAS f32x4*)(bp + 1024), bl1 = *(const PG8_GAS f32x4*)(bp + 1028);
#pragma unroll
        for (int ai = 0; ai < 2; ++ai)
#pragma unroll
            for (int m = 0; m < 4; ++m) {
                f32x4 g0 = acc[ai][0][m][0] + bg0, g1 = acc[ai][0][m][1] + bg1, l0 = acc[ai][1][m][0] + bl0, l1 = acc[ai][1][m][1] + bl1; float r[8];
#pragma unroll
                for (int i = 0; i < 4; ++i) { float g = fminf(g0[i], 7.0f), l = fminf(fmaxf(l0[i], -7.0f), 7.0f); r[i] = g * sigm(1.702f * g) * (l + 1.0f);
                    g = fminf(g1[i], 7.0f); l = fminf(fmaxf(l1[i], -7.0f), 7.0f); r[4 + i] = g * sigm(1.702f * g) * (l + 1.0f); }
                u32x4 w; w.x = cvt_pk_bf16(r[0], r[1]); w.y = cvt_pk_bf16(r[2], r[3]); w.z = cvt_pk_bf16(r[4], r[5]); w.w = cvt_pk_bf16(r[6], r[7]);
                *(u32x4*)(act + (size_t)(row0 + ai * HALF + m * 16) * 1024 + cl) = w; }
    }
};
struct EpiDown {
    static constexpr bool PERM = true;
    bf16_t* O; const PG8_GAS float* b_down; int nNe;
    __device__ __forceinline__ void operator()(const f32x4 (&acc)[2][2][4][2], const Unit& u, int wr, int wc, int fr, int fq_) const {
        const int pnl = u.pn - u.e * nNe; const int row0 = u.pm * BM + wr * 64 + fr, col0 = pnl * BM + wc * 32 + 8 * fq_;
        const PG8_GAS float* bp = b_down + (size_t)u.e * 1024 + col0;
        f32x4 bv[2][2];
#pragma unroll
        for (int bj = 0; bj < 2; ++bj)
#pragma unroll
            for (int n = 0; n < 2; ++n) bv[bj][n] = *(const PG8_GAS f32x4*)(bp + bj * HALF + 4 * n);
#pragma unroll
        for (int ai = 0; ai < 2; ++ai)
#pragma unroll
            for (int m = 0; m < 4; ++m) { bf16_t* rowp = O + (size_t)(row0 + ai * HALF + m * 16) * 1024 + col0;
#pragma unroll
                for (int bj = 0; bj < 2; ++bj) { const f32x4 v0 = acc[ai][bj][m][0] + bv[bj][0], v1 = acc[ai][bj][m][1] + bv[bj][1];
                    u32x4 w; w.x = cvt_pk_bf16(v0[0], v0[1]); w.y = cvt_pk_bf16(v0[2], v0[3]); w.z = cvt_pk_bf16(v1[0], v1[1]); w.w = cvt_pk_bf16(v1[2], v1[3]);
                    *(u32x4*)(rowp + bj * HALF) = w; } }
    }
};

template <class Epi, class Sched, bool GATHER, bool ALIGN_EPI>
__device__ __forceinline__ void gemm_phase(PG8_LAS unsigned char* lds, const Gemm g, const Sched& S, const Epi& E) {
    int tid_l = threadIdx.x; asm volatile("" : "+v"(tid_l));
    const int tid = tid_l, wid = __builtin_amdgcn_readfirstlane(tid >> 6), lane = tid & 63, wr = wid >> 2, wc = wid & 3, fr = lane & 15, fq = lane >> 4;
    const int K = g.K, nt = K / BK;
    unsigned voffB[2], vA0[2], vA1[2], nA0[2], nA1[2]; int Rr[2], Cc[2];
#pragma unroll
    for (int i = 0; i < 2; ++i) { int R, C; stage_rc(tid * 16 + i * 8192, R, C); const int Rb = Epi::PERM ? ((R & ~31) + perm32(R & 31)) : R;
        voffB[i] = (unsigned)(Rb * K + C) * 2u; Rr[i] = R; Cc[i] = C; vA0[i] = vA1[i] = nA0[i] = nA1[i] = (unsigned)(R * K + C) * 2u; }
    const size_t kstep = (size_t)(BK * 2);
    const size_t hstep = (size_t)HALF * K * 2;
    const size_t tstep = 2 * hstep;
    const size_t hsA = GATHER ? 0 : hstep;
    const unsigned ldsw = (unsigned)wid * 1024u;
    const int aoff = lds_byte(wr * 64 + fr, fq * 8), boff = lds_byte(wc * 32 + fr, fq * 8);
#define PG8_SA(b, h) (((b) * 2 + (h)) * HTB)
#define PG8_SB(b, h) ((4 + (b) * 2 + (h)) * HTB)
#define PG8_STAGE(bufoff, gbase, voff) do { _Pragma("unroll") for (int _i = 0; _i < 2; ++_i) \
        __builtin_amdgcn_global_load_lds((const unsigned*)((const char*)(gbase) + (voff)[_i]), (PG8_LAS unsigned*)(lds + (bufoff) + ldsw + _i * 8192), 16, 0, 0); } while (0)
#define PG8_LDA(dst, b, h) do { _Pragma("unroll") for (int m = 0; m < 4; ++m) _Pragma("unroll") for (int k = 0; k < 2; ++k) dst[m][k] = *(const PG8_LAS bf16x8*)(lds + PG8_SA(b, h) + aoff + m * 2048 + k * 1024); } while (0)
#define PG8_LDB(dst, b, h) do { _Pragma("unroll") for (int n = 0; n < 2; ++n) _Pragma("unroll") for (int k = 0; k < 2; ++k) dst[n][k] = *(const PG8_LAS bf16x8*)(lds + PG8_SB(b, h) + boff + n * 2048 + k * 1024); } while (0)
#define PG8_MMA(ai, bj, At, Bt) do { __builtin_amdgcn_s_setprio(1); _Pragma("unroll") for (int m = 0; m < 4; ++m) _Pragma("unroll") for (int n = 0; n < 2; ++n) _Pragma("unroll") for (int k = 0; k < 2; ++k) \
        acc[ai][bj][m][n] = __builtin_amdgcn_mfma_f32_16x16x32_bf16(Bt[n][k], At[m][k], acc[ai][bj][m][n], 0, 0, 0); __builtin_amdgcn_s_setprio(0); } while (0)
#define PG8_WAIT_V(n) asm volatile("s_waitcnt vmcnt(" #n ")" ::: "memory")
#define PG8_WAIT_L(n) asm volatile("s_waitcnt lgkmcnt(" #n ")" ::: "memory")
#define PG8_BAR __builtin_amdgcn_s_barrier()
#define PG8_SCHED __builtin_amdgcn_sched_barrier(0)
#define PG8_GOFFS(u, o0, o1) do { if constexpr (GATHER) { _Pragma("unroll") for (int _i = 0; _i < 2; ++_i) { \
        const int t0_ = g.rows[(u).rl + Rr[_i]], t1_ = g.rows[(u).rl + HALF + Rr[_i]]; \
        o0[_i] = (unsigned)(t0_ * K + Cc[_i]) * 2u; o1[_i] = (unsigned)(t1_ * K + Cc[_i]) * 2u; } } } while (0)
    Unit cur, nxt; int ui = 0;
    if (!S.next(0, cur)) return;
    f32x4 acc[2][2][4][2];
#pragma unroll
    for (int a = 0; a < 2; ++a)
#pragma unroll
        for (int b = 0; b < 2; ++b)
#pragma unroll
            for (int m = 0; m < 4; ++m)
#pragma unroll
                for (int n = 0; n < 2; ++n) acc[a][b][m][n] = (f32x4){0.f, 0.f, 0.f, 0.f};
    bf16x8 At[4][2], B0[2][2], B1[2][2];
    const char* cA = (const char*)g.A + (GATHER ? (size_t)0 : (size_t)cur.pm * tstep); const char* cB = (const char*)g.Bt + (size_t)cur.pn * tstep;
    PG8_GOFFS(cur, vA0, vA1);
    PG8_STAGE(PG8_SB(0, 0), cB, voffB); PG8_STAGE(PG8_SB(0, 1), cB + hstep, voffB); PG8_STAGE(PG8_SA(0, 0), cA, vA0); PG8_STAGE(PG8_SA(0, 1), cA + hsA, vA1);
    if (wr == 1) PG8_BAR;
    PG8_WAIT_V(2); PG8_BAR;
    PG8_STAGE(PG8_SB(1, 0), cB + kstep, voffB); PG8_STAGE(PG8_SA(1, 0), cA + kstep, vA0); PG8_STAGE(PG8_SB(1, 1), cB + hstep + kstep, voffB);
    PG8_WAIT_V(6); PG8_BAR;
    for (;;) {
        const bool has_next = S.next(ui + 1, nxt);
        const char* nA = has_next ? (const char*)g.A + (GATHER ? (size_t)0 : (size_t)nxt.pm * tstep) : cA; const char* nB = has_next ? (const char*)g.Bt + (size_t)nxt.pn * tstep : cB;
        if constexpr (GATHER) { if (has_next) { PG8_GOFFS(nxt, nA0, nA1); } else {
#pragma unroll
            for (int i = 0; i < 2; ++i) { nA0[i] = vA0[i]; nA1[i] = vA1[i]; } } }
        for (int t = 0; t < nt; t += 2) {
            const bool last = (t == nt - 2);
            const char* a1 = cA + (size_t)(t + 1) * kstep;
            const char* a2 = last ? nA : cA + (size_t)(t + 2) * kstep; const char* b2 = last ? nB : cB + (size_t)(t + 2) * kstep;
            const char* a3 = a2 + kstep; const char* b3 = b2 + kstep;
            unsigned s0[2], s1[2];
#pragma unroll
            for (int i = 0; i < 2; ++i) { s0[i] = (GATHER && last) ? nA0[i] : vA0[i]; s1[i] = (GATHER && last) ? nA1[i] : vA1[i]; }
            PG8_LDB(B0, 0, 0); PG8_LDB(B1, 0, 1); PG8_SCHED; PG8_LDA(At, 0, 0); PG8_STAGE(PG8_SA(1, 1), a1 + hsA, vA1);
            PG8_WAIT_V(8); PG8_WAIT_L(0); PG8_BAR; PG8_MMA(0, 0, At, B0); PG8_MMA(0, 1, At, B1); PG8_BAR; PG8_SCHED;
            PG8_LDA(At, 0, 1); PG8_STAGE(PG8_SB(0, 0), b2, voffB); PG8_STAGE(PG8_SB(0, 1), b2 + hstep, voffB); PG8_STAGE(PG8_SA(0, 0), a2, s0);
            PG8_WAIT_V(8); PG8_WAIT_L(0); PG8_BAR; PG8_MMA(1, 0, At, B0); PG8_MMA(1, 1, At, B1); PG8_BAR; PG8_SCHED;
            PG8_LDB(B0, 1, 0); PG8_LDB(B1, 1, 1); PG8_SCHED; PG8_LDA(At, 1, 0); PG8_STAGE(PG8_SA(0, 1), a2 + hsA, s1);
            PG8_WAIT_V(8); PG8_WAIT_L(0); PG8_BAR; PG8_MMA(0, 0, At, B0); PG8_MMA(0, 1, At, B1); PG8_BAR; PG8_SCHED;
            PG8_LDA(At, 1, 1); PG8_STAGE(PG8_SB(1, 0), b3, voffB); PG8_STAGE(PG8_SB(1, 1), b3 + hstep, voffB); PG8_STAGE(PG8_SA(1, 0), a3, s0);
            PG8_WAIT_V(8); PG8_WAIT_L(0); PG8_BAR; PG8_MMA(1, 0, At, B0); PG8_MMA(1, 1, At, B1); PG8_BAR; PG8_SCHED;
        }
        if constexpr (ALIGN_EPI) { if (wr == 0) PG8_BAR; }
        E(acc, cur, wr, wc, fr, fq);
        if (!has_next) break;
#pragma unroll
        for (int a = 0; a < 2; ++a)
#pragma unroll
            for (int b = 0; b < 2; ++b)
#pragma unroll
                for (int m = 0; m < 4; ++m)
#pragma unroll
                    for (int n = 0; n < 2; ++n) acc[a][b][m][n] = (f32x4){0.f, 0.f, 0.f, 0.f};
        cur = nxt; cA = nA; cB = nB; ++ui;
        if constexpr (GATHER) {
#pragma unroll
            for (int i = 0; i < 2; ++i) { vA0[i] = nA0[i]; vA1[i] = nA1[i]; } }
        if constexpr (ALIGN_EPI) { if (wr == 1) PG8_BAR; }
    }
    PG8_WAIT_V(0);
    if constexpr (!ALIGN_EPI) { if (wr == 0) PG8_BAR; }
    PG8_BAR;
#undef PG8_SA
#undef PG8_SB
#undef PG8_STAGE
#undef PG8_LDA
#undef PG8_LDB
#undef PG8_MMA
#undef PG8_WAIT_V
#undef PG8_WAIT_L
#undef PG8_BAR
#undef PG8_SCHED
#undef PG8_GOFFS
}
}
#include <hip/hip_bf16.h>
#include <cmath>
namespace attn_body {
using bf16=__hip_bfloat16;
using bf16x8=__attribute__((ext_vector_type(8)))short;
using s16x4=__attribute__((ext_vector_type(4)))short;
using f32x16=__attribute__((ext_vector_type(16)))float;
using u32x4=__attribute__((ext_vector_type(4)))unsigned;
constexpr int BATCH=4,NHEAD=8,SEQ=8192,D=64,DM=NHEAD*D;
constexpr int NW=8,QBLK=32,QB=QBLK*NW,KVBLK=64,NQB=SEQ/QB;
constexpr int ATTN_PITCH=DM, ATTN_UNIT_ROWS=QB;
__device__ __forceinline__ int crow(int r,int hi){return (r&3)+8*(r>>2)+4*hi;}
#define SBAR() __builtin_amdgcn_sched_barrier(0)
__device__ __forceinline__ void cmask(f32x16&p0,f32x16&p1,int jb,int qrel,int hi){
  const float NEG=-INFINITY; int kb=64*jb+4*hi;
  #pragma unroll
  for(int r=0;r<16;++r){int kv=kb+(r&3)+8*(r>>2); if(kv>qrel)p0[r]=NEG; if(kv+32>qrel)p1[r]=NEG;}
}

constexpr int NSLOT=3, SLOTB=8192;
constexpr int LDS_K=0, LDS_V=NSLOT*SLOTB, LDS_WS=2*NSLOT*SLOTB, LDS_OST=LDS_WS+NW*64*4, LDS_CUM=LDS_OST+NW*4096, LDS_BYTES=LDS_CUM+SEQ*4;
constexpr float C2=0.125f*1.4426950408889634f;
__device__ __forceinline__ void glds16(const void*gsrc,unsigned lds_dst){unsigned keep;
  asm volatile("s_mov_b32 %0, m0\n\ts_mov_b32 m0, %2\n\ts_nop 0\n\tglobal_load_lds_dwordx4 %1, off\n\ts_mov_b32 m0, %0":"=&s"(keep):"v"(gsrc),"s"(lds_dst):"memory");}
__device__ __forceinline__ float max3f(float a,float b,float c){float r;asm("v_max3_f32 %0, %1, %2, %3":"=v"(r):"v"(a),"v"(b),"v"(c));return r;}
__device__ __forceinline__ float max2f(float a,float b){float r;asm("v_max_f32_e32 %0, %1, %2":"=v"(r):"v"(a),"v"(b));return r;}
__device__ __forceinline__ float fadd_s(float a,float b){float r;asm("v_add_f32_e32 %0, %1, %2":"=v"(r):"v"(a),"v"(b));return r;}
__device__ __forceinline__ float fsub_s(float a,float b){float r;asm("v_sub_f32_e32 %0, %1, %2":"=v"(r):"v"(a),"v"(b));return r;}
typedef float f32x2_t __attribute__((ext_vector_type(2))); typedef __bf16 bf16x2_t __attribute__((ext_vector_type(2)));
__device__ __forceinline__ unsigned cvtpk_s(float lo,float hi){f32x2_t v={lo,hi};bf16x2_t b=__builtin_convertvector(v,bf16x2_t);return __builtin_bit_cast(unsigned,b);}
#define WAIT_BAR(N) asm volatile("s_waitcnt vmcnt(" #N ") lgkmcnt(0)\n\ts_barrier":::"memory")

typedef __attribute__((address_space(3))) const float* lds_fptr;
typedef float f32x4a __attribute__((ext_vector_type(4)));
__device__ __forceinline__ void ckinit(f32x16&c0,f32x16&c1,lds_fptr ck,float nm,int hi){
  #pragma unroll
  for(int g=0;g<4;++g){
    const f32x4a a=*(const __attribute__((address_space(3))) f32x4a*)(ck+8*g+4*hi);
    const f32x4a b=*(const __attribute__((address_space(3))) f32x4a*)(ck+32+8*g+4*hi);
    c0[4*g+0]=nm-a[0];c0[4*g+1]=nm-a[1];c0[4*g+2]=nm-a[2];c0[4*g+3]=nm-a[3];
    c1[4*g+0]=nm-b[0];c1[4*g+1]=nm-b[1];c1[4*g+2]=nm-b[2];c1[4*g+3]=nm-b[3];}
}
__device__ __forceinline__ void qkt(f32x16&p0,f32x16&p1,const char*Kslot,const bf16x8*qr,lds_fptr ck,float nm,int r32,int hi){
  const char*kb=Kslot+hi*1024+r32*16;
  ckinit(p0,p1,ck,nm,hi);
  #pragma unroll
  for(int d0=0;d0<4;++d0){
    const bf16x8 b0=*reinterpret_cast<const bf16x8*>(kb+d0*2048);
    const bf16x8 b1=*reinterpret_cast<const bf16x8*>(kb+d0*2048+512);
    p0=__builtin_amdgcn_mfma_f32_32x32x16_bf16(b0,qr[d0],p0,0,0,0);p1=__builtin_amdgcn_mfma_f32_32x32x16_bf16(b1,qr[d0],p1,0,0,0);}
}
typedef __attribute__((address_space(3))) const char* lds_cptr;
typedef short v4i16_t __attribute__((ext_vector_type(4)));
__device__ __forceinline__ void kload8(bf16x8*kf,lds_cptr kp){
  kf[0]=*(const __attribute__((address_space(3))) bf16x8*)(kp);      kf[1]=*(const __attribute__((address_space(3))) bf16x8*)(kp+512);
  kf[2]=*(const __attribute__((address_space(3))) bf16x8*)(kp+2048); kf[3]=*(const __attribute__((address_space(3))) bf16x8*)(kp+2560);
  kf[4]=*(const __attribute__((address_space(3))) bf16x8*)(kp+4096); kf[5]=*(const __attribute__((address_space(3))) bf16x8*)(kp+4608);
  kf[6]=*(const __attribute__((address_space(3))) bf16x8*)(kp+6144); kf[7]=*(const __attribute__((address_space(3))) bf16x8*)(kp+6656);
}
__device__ __forceinline__ void kload2(bf16x8*kf,lds_cptr kp,int j){ kf[2*j]=*(const __attribute__((address_space(3))) bf16x8*)(kp+j*2048); kf[2*j+1]=*(const __attribute__((address_space(3))) bf16x8*)(kp+j*2048+512); }
__device__ __forceinline__ s16x4 vtr(lds_cptr p){ return __builtin_bit_cast(s16x4,__builtin_amdgcn_ds_read_tr16_b64_v4i16((__attribute__((address_space(3))) v4i16_t*)p)); }
__device__ __forceinline__ float rowmax(const f32x16&p0,const f32x16&p1){
  float a=max3f(p0[0],p0[1],p1[0]),b=max3f(p0[2],p0[3],p1[1]);a=max3f(a,p1[2],p1[3]);
  #pragma unroll
  for(int r=4;r<16;r+=4){a=max3f(a,p0[r],p0[r+1]);b=max3f(b,p0[r+2],p0[r+3]);a=max3f(a,p1[r],p1[r+1]);b=max3f(b,p1[r+2],p1[r+3]);}
  const float m=max2f(a,b);
  auto rr=__builtin_amdgcn_permlane32_swap(__float_as_uint(m),__float_as_uint(m),false,false);
  return max2f(__uint_as_float(rr[0]),__uint_as_float(rr[1]));
}
__device__ __forceinline__ void pv(f32x16*o,int vb,bf16x8 pa0,bf16x8 pa1,bf16x8 pa2,bf16x8 pa3){
  #pragma unroll
  for(int d0=0;d0<2;++d0){s16x4 lo[4],hi[4];
    #pragma unroll
    for(int ks=0;ks<4;++ks){
      asm volatile("ds_read_b64_tr_b16 %0,%1 offset:%c2":"=&v"(lo[ks]):"v"(vb),"i"(d0*4096+ks*1024):"memory");
      asm volatile("ds_read_b64_tr_b16 %0,%1 offset:%c2":"=&v"(hi[ks]):"v"(vb),"i"(d0*4096+ks*1024+512):"memory");}
    asm volatile("s_waitcnt lgkmcnt(0)":::"memory");SBAR();
    #define PK(k) (bf16x8){lo[k][0],lo[k][1],lo[k][2],lo[k][3],hi[k][0],hi[k][1],hi[k][2],hi[k][3]}
    o[d0]=__builtin_amdgcn_mfma_f32_32x32x16_bf16(pa0,PK(0),o[d0],0,0,0);
    o[d0]=__builtin_amdgcn_mfma_f32_32x32x16_bf16(pa1,PK(1),o[d0],0,0,0);
    o[d0]=__builtin_amdgcn_mfma_f32_32x32x16_bf16(pa2,PK(2),o[d0],0,0,0);
    o[d0]=__builtin_amdgcn_mfma_f32_32x32x16_bf16(pa3,PK(3),o[d0],0,0,0);
    #undef PK
  }
}

#ifndef ATTN_STORE16
#define ATTN_STORE16(p,v) (*(u32x4*)(p)=(v))
#endif
template<int THRL> __device__ __forceinline__ void attn_unit(int b,int h,int qb,const bf16*Q,const bf16*__restrict__ K,const bf16*__restrict__ V,bf16*O,const float*__restrict__ cum,const unsigned*__restrict__ qkm,char*shm){
  int tid_l=threadIdx.x; asm volatile("":"+v"(tid_l));
  const int tid=tid_l,lane=tid&63,r32=lane&31,hi=lane>>5; const int wid=__builtin_amdgcn_readfirstlane(tid>>6);
  const long rowbase=(long)b*SEQ; const int q0=qb*QB;
  const bf16*Qw=Q+(rowbase+q0+wid*QBLK)*DM+h*D;
  const bf16*Kh=K+rowbase*DM+h*D,*Vh=V+rowbase*DM+h*D;
  const unsigned lds0=(unsigned)(uintptr_t)shm;
  float*wsf=(float*)(shm+LDS_WS)+wid*64;
  const bf16*ksrc=Kh+(long)lane*DM+wid*8;
  const bf16*vsrc=Vh+(long)(16*(wid&3)+(lane>>2))*DM+(wid>>2)*32+(lane&3)*8;
  const unsigned kdst=lds0+LDS_K+wid*1024, vdst=lds0+LDS_V+wid*1024;
  #define DMA_K(t,slot) glds16(ksrc+(long)TILE(t)*KVBLK*DM,(unsigned)__builtin_amdgcn_readfirstlane(kdst+(slot)))
  #define DMA_V(t,slot) glds16(vsrc+(long)TILE(t)*KVBLK*DM,(unsigned)__builtin_amdgcn_readfirstlane(vdst+(slot)))
  const int vb0=(int)(lds0+LDS_V)+((lane>>4)&1)*32+(lane&3)*8+(4*hi+((lane&15)>>2))*64;
  const char*Kbase=shm+LDS_K; bf16x8 kf[8];
  const lds_cptr shm3=(lds_cptr)shm; const lds_cptr kp0=shm3+LDS_K+hi*1024+r32*16; const lds_cptr vp0=shm3+LDS_V+((lane>>4)&1)*32+(lane&3)*8+(4*hi+((lane&15)>>2))*64;
  const int NT=(q0+QB)/KVBLK;
  const lds_fptr cumS=(lds_fptr)(shm3+LDS_CUM);
  const float* cgp=cum+(long)(b*NHEAD+h)*SEQ;
  int tmin;
  { const float qk=sqrtf(__uint_as_float(qkm[b*NHEAD+h])*__uint_as_float(qkm[32+b*NHEAD+h]));
    const float thr=cgp[q0]+2.0f*qk+40.0f;
    const bool c0=(lane<NT-4)&&(cgp[64*lane+63]>=thr), c1=(lane+64<NT-4)&&(cgp[64*(lane+64)+63]>=thr);
    tmin=(__popcll(__ballot(c0))+__popcll(__ballot(c1)))&~1; }
  const int NTp=NT-tmin;
  #define TILE(j) (((j)<4)?(NT-4+(j)):(NT-1-(j)))
  { const f32x4a* cg4=(const f32x4a*)cgp; __attribute__((address_space(3))) f32x4a* cs4=(__attribute__((address_space(3))) f32x4a*)(shm3+LDS_CUM);
    for(int i=16*tmin+tid;i<(q0+QB)/4;i+=NW*64)cs4[i]=cg4[i]; }
  DMA_K(0,0);DMA_V(0,0);DMA_K(1,SLOTB);
  bf16x8 qr[4];
  #pragma unroll
  for(int d0=0;d0<4;++d0)qr[d0]=*reinterpret_cast<const bf16x8*>(&Qw[(long)r32*DM+d0*16+hi*8]);
  float mhat=0.f,l_reg=0.f;f32x16 o[2];o[0]=f32x16{};o[1]=f32x16{};float cq=0.f,nm=0.f;
  const int qrel=wid*QBLK+r32;
  #define CMASK(P0,P1,t) do{ if((t)<4)cmask(P0,P1,(t),qrel,hi);}while(0)
  bool resc=false;
  #define START(P0,P1) do{ const float rm=rowmax(P0,P1); resc=false; \
    { const float dl=rm; mhat=fadd_s(mhat,dl); \
      _Pragma("unroll") for(int r=0;r<16;++r){P0[r]=fsub_s(P0[r],dl);P1[r]=fsub_s(P1[r],dl);} \
      nm=cq-mhat; } \
    _Pragma("unroll") for(int r=0;r<16;++r)P0[r]=__builtin_amdgcn_exp2f(P0[r]); }while(0)
  #define RESC() do{ if(resc){ asm volatile("s_waitcnt lgkmcnt(0)":::"memory"); \
      _Pragma("unroll") for(int d_=0;d_<2;++d_) _Pragma("unroll") for(int r=0;r<16;++r)o[d_][r]*=wsf[crow(r,hi)]; } }while(0)
  f32x16 pA0,pA1,pB0,pB1;
  int sl_prev=0,sl_cur=0,sl_next=SLOTB;
  #define ROT() do{sl_prev=sl_cur;sl_cur=sl_next;sl_next=(sl_next==(NSLOT-1)*SLOTB)?0:sl_next+SLOTB;}while(0)
  DMA_K(2,2*SLOTB);
  WAIT_BAR(3);
  cq=cumS[q0+qrel]; nm=cq;
  qkt(pA0,pA1,Kbase,qr,cumS+64*TILE(0),nm,r32,hi);asm volatile("s_nop 15\n\ts_nop 7":"+v"(pA0),"+v"(pA1));CMASK(pA0,pA1,0);
  START(pA0,pA1);
  _Pragma("unroll") for(int r=0;r<16;++r)pA1[r]=__builtin_amdgcn_exp2f(pA1[r]);
  WAIT_BAR(0);
  DMA_K(3,0);DMA_V(1,SLOTB);
  ROT();
  kload8(kf,kp0+sl_cur);
  WAIT_BAR(2);
  s16x4 vlo[8],vhi[8]; u32x4 pw0,pw1,pw2,pw3;
  #define PKW(P,B) cvtpk_s(P[B],P[B+1])
  #define PAF(k) __builtin_bit_cast(bf16x8,pw##k)
  #define VFR(i) (bf16x8){vlo[i][0],vlo[i][1],vlo[i][2],vlo[i][3],vhi[i][0],vhi[i][1],vhi[i][2],vhi[i][3]}
  #define PIN(x) asm volatile("":"+v"(x))
  #define MX3(a,b,c) __builtin_fmaxf(__builtin_fmaxf((a),(b)),(c))
  #define GAPA(MF,A0,A1,A2,A3,W0,W1,PW) do{ MF; sacc+=A0; sacc+=A1; sacc+=A2; sacc+=A3; PIN(sacc); W0; W1; PIN(PW); SBAR(); }while(0)
  #define EX(v) __builtin_amdgcn_exp2f(v)
  #define GAPB(MF,X,B) do{ MF; X[B]=EX(X[B]); X[B+1]=EX(X[B+1]); X[B+2]=EX(X[B+2]); X[B+3]=EX(X[B+3]); PIN(X); SBAR(); }while(0)
  #define VRD(i) do{ vlo[i]=vtr(vp_+(((i)>>2)*4096+((i)&3)*1024)); vhi[i]=vtr(vp_+(((i)>>2)*4096+((i)&3)*1024+512)); }while(0)
  #define KRD(G,j) do{ if(G){ kload2(kf,kp0+sl_next,j); SBAR(); } }while(0)
  #define STEP(C0,C1,P0,P1,t,GK,GV,GL) do{ SBAR(); \
    ckinit(C0,C1,cumS+64*TILE(t),nm,hi); SBAR(); \
    const lds_cptr vp_=vp0+sl_prev; \
    VRD(0); SBAR(); float sacc=(P0[0]+P0[1]); \
    GAPA(C0=__builtin_amdgcn_mfma_f32_32x32x16_bf16(kf[0],qr[0],C0,0,0,0), P0[2],P0[3],P0[4],P0[5],     pw0[0]=PKW(P0,0), pw0[1]=PKW(P0,2), pw0); \
    VRD(4); SBAR(); GAPA(C1=__builtin_amdgcn_mfma_f32_32x32x16_bf16(kf[1],qr[0],C1,0,0,0), P0[6],P0[7],P0[8],P0[9],     pw0[2]=PKW(P0,4), pw0[3]=PKW(P0,6), pw0); \
    VRD(1); SBAR(); GAPA(C0=__builtin_amdgcn_mfma_f32_32x32x16_bf16(kf[2],qr[1],C0,0,0,0),   P0[10],P0[11],P0[12],P0[13], pw1[0]=PKW(P0,8), pw1[1]=PKW(P0,10), pw1); \
    VRD(5); SBAR(); GAPA(C1=__builtin_amdgcn_mfma_f32_32x32x16_bf16(kf[3],qr[1],C1,0,0,0),   P0[14],P0[15],P1[0],P1[1],   pw1[2]=PKW(P0,12),pw1[3]=PKW(P0,14), pw1); \
    VRD(2); SBAR(); GAPA(C0=__builtin_amdgcn_mfma_f32_32x32x16_bf16(kf[4],qr[2],C0,0,0,0),   P1[2],P1[3],P1[4],P1[5],     pw2[0]=PKW(P1,0), pw2[1]=PKW(P1,2), pw2); \
    VRD(6); SBAR(); GAPA(C1=__builtin_amdgcn_mfma_f32_32x32x16_bf16(kf[5],qr[2],C1,0,0,0),   P1[6],P1[7],P1[8],P1[9],     pw2[2]=PKW(P1,4), pw2[3]=PKW(P1,6), pw2); \
    VRD(3); SBAR(); GAPA(C0=__builtin_amdgcn_mfma_f32_32x32x16_bf16(kf[6],qr[3],C0,0,0,0),   P1[10],P1[11],P1[12],P1[13], pw3[0]=PKW(P1,8), pw3[1]=PKW(P1,10), pw3); \
    VRD(7); SBAR(); GAPA(C1=__builtin_amdgcn_mfma_f32_32x32x16_bf16(kf[7],qr[3],C1,0,0,0),   P1[14],P1[15],0.f,0.f,       pw3[2]=PKW(P1,12),pw3[3]=PKW(P1,14), pw3); \
    l_reg+=sacc; \
    if(GK){DMA_K((t)+3,sl_cur);} if(GV){DMA_V((t)+1,sl_next);} \
    CMASK(C0,C1,t); \
    { float a=MX3(C0[0],C0[1],C1[0]),b=MX3(C0[2],C0[3],C1[1]); a=MX3(a,C1[2],C1[3]); \
      _Pragma("unroll") for(int r=4;r<16;r+=4){a=MX3(a,C0[r],C0[r+1]);b=MX3(b,C0[r+2],C0[r+3]);a=MX3(a,C1[r],C1[r+1]);b=MX3(b,C1[r+2],C1[r+3]);} \
      float rm=__builtin_fmaxf(a,b); { auto rr=__builtin_amdgcn_permlane32_swap(__float_as_uint(rm),__float_as_uint(rm),false,false); rm=__builtin_fmaxf(__uint_as_float(rr[0]),__uint_as_float(rr[1])); } \
      resc=false; \
      if(__builtin_expect(__any(rm>(float)THRL),0)){ const float dl=__builtin_fmaxf(rm,0.f); mhat+=dl; \
        _Pragma("unroll") for(int r=0;r<16;++r){C0[r]-=dl;C1[r]-=dl;} \
        nm=cq-mhat; \
        const float f=__builtin_amdgcn_exp2f(-dl); l_reg*=f; if(hi==0)wsf[r32]=f; resc=true; } } \
    SBAR(); \
    GAPB(o[0]=__builtin_amdgcn_mfma_f32_32x32x16_bf16(PAF(0),VFR(0),o[0],0,0,0), C0,0); \
    GAPB(o[1]=__builtin_amdgcn_mfma_f32_32x32x16_bf16(PAF(0),VFR(4),o[1],0,0,0), C0,4); \
    KRD(GL,0); GAPB(o[0]=__builtin_amdgcn_mfma_f32_32x32x16_bf16(PAF(1),VFR(1),o[0],0,0,0), C0,8); \
    KRD(GL,1); GAPB(o[1]=__builtin_amdgcn_mfma_f32_32x32x16_bf16(PAF(1),VFR(5),o[1],0,0,0), C0,12); \
    KRD(GL,2); GAPB(o[0]=__builtin_amdgcn_mfma_f32_32x32x16_bf16(PAF(2),VFR(2),o[0],0,0,0), C1,0); \
    KRD(GL,3); GAPB(o[1]=__builtin_amdgcn_mfma_f32_32x32x16_bf16(PAF(2),VFR(6),o[1],0,0,0), C1,4); \
    GAPB(o[0]=__builtin_amdgcn_mfma_f32_32x32x16_bf16(PAF(3),VFR(3),o[0],0,0,0), C1,8); \
    GAPB(o[1]=__builtin_amdgcn_mfma_f32_32x32x16_bf16(PAF(3),VFR(7),o[1],0,0,0), C1,12); \
    }while(0)
  int t=1;
  for(;t+5<NTp;t+=2){
    STEP(pB0,pB1,pA0,pA1,t,true,true,true);     WAIT_BAR(2); RESC(); ROT();
    STEP(pA0,pA1,pB0,pB1,t+1,true,true,true);   WAIT_BAR(2); RESC(); ROT();
  }
  #define ENDW(tt) do{ if((tt)+3<NTp){WAIT_BAR(2);} else if((tt)+2<NTp){WAIT_BAR(1);} else {WAIT_BAR(0);} }while(0)
  for(;t+1<NTp;t+=2){
    STEP(pB0,pB1,pA0,pA1,t,(t+3<NTp),(t+1<NTp),(t+1<NTp));       ENDW(t);   RESC(); ROT();
    STEP(pA0,pA1,pB0,pB1,t+1,(t+4<NTp),(t+2<NTp),(t+2<NTp));     ENDW(t+1); RESC(); ROT();
  }
  STEP(pB0,pB1,pA0,pA1,NTp-1,false,false,false); RESC();
  { float sacc=pB0[0]+pB0[1]; _Pragma("unroll") for(int r=2;r<16;++r)sacc+=pB0[r]; _Pragma("unroll") for(int r=0;r<16;++r)sacc+=pB1[r]; l_reg+=sacc;
    pw0=(u32x4){PKW(pB0,0),PKW(pB0,2),PKW(pB0,4),PKW(pB0,6)};pw1=(u32x4){PKW(pB0,8),PKW(pB0,10),PKW(pB0,12),PKW(pB0,14)};pw2=(u32x4){PKW(pB1,0),PKW(pB1,2),PKW(pB1,4),PKW(pB1,6)};pw3=(u32x4){PKW(pB1,8),PKW(pB1,10),PKW(pB1,12),PKW(pB1,14)};
    SBAR(); pv(o,vb0+sl_cur,PAF(0),PAF(1),PAF(2),PAF(3)); }
  #undef PKW
  #undef PAF
  #undef VFR
  #undef PIN
  #undef MX3
  #undef GAPA
  #undef GAPB
  #undef EX
  #undef VRD
  #undef KRD
  #undef STEP
  #undef ENDW
  {auto rr=__builtin_amdgcn_permlane32_swap(__float_as_uint(l_reg),__float_as_uint(l_reg),false,false);l_reg=__uint_as_float(rr[0])+__uint_as_float(rr[1]);}
  if(hi==0)wsf[32+r32]=l_reg;asm volatile("s_waitcnt lgkmcnt(0)":::"memory");
  float rli[16];
  #pragma unroll
  for(int r=0;r<16;++r)rli[r]=__builtin_amdgcn_rcpf(wsf[32+crow(r,hi)]);
  bf16*Ow=O+(rowbase+q0+wid*QBLK)*DM+h*D;
  { bf16*stg=(bf16*)(shm+LDS_OST)+wid*2048;
    #pragma unroll
    for(int r=0;r<16;++r){const int orow=crow(r,hi);
      #pragma unroll
      for(int d0=0;d0<2;++d0)stg[orow*64+d0*32+r32]=__float2bfloat16(o[d0][r]*rli[r]);}
    asm volatile("s_waitcnt lgkmcnt(0)":::"memory");
    #pragma unroll
    for(int i=0;i<4;++i){const int row=i*8+(lane>>3),ch=lane&7; const u32x4 v=*(const u32x4*)(stg+row*64+ch*8); ATTN_STORE16(Ow+(long)row*DM+ch*8,v);} }
  asm volatile("s_waitcnt lgkmcnt(0)\n\ts_barrier":::"memory");
  #undef DMA_K
  #undef TILE
  #undef DMA_V
  #undef CMASK
  #undef START
  #undef RESC
  #undef ROT
}
constexpr int ATTN_LDS_BYTES=LDS_BYTES;
struct AttnTensors { const bf16* Q; const bf16* K; const bf16* V; bf16* O; const float* cum; const unsigned* qkm; };
struct AttnUnit { int bh; int qb; };
struct StaticOrder {
  int vcu;
  __device__ __forceinline__ explicit StaticOrder(int grid,int block):vcu((block%8)*(grid/8)+block/8){}
  __device__ __forceinline__ bool next(int i,AttnUnit&u)const{ if(i>=4)return false; const int s=vcu&7; u.bh=vcu>>3; u.qb=(i==0)?s:(i==1)?15-s:(i==2)?16+s:31-s; return true; }
  __device__ __forceinline__ void a_ready(const AttnUnit&)const{}
  __device__ __forceinline__ void done(const AttnUnit&)const{}
};
template<class Sched,int THRL=8> __device__ __forceinline__ void attn_phase(char*lds,const AttnTensors&T,const Sched&S){
  AttnUnit u;
  for(int i=0;S.next(i,u);++i){ S.a_ready(u); attn_unit<THRL>(u.bh/NHEAD,u.bh%NHEAD,u.qb,T.Q,T.K,T.V,T.O,T.cum,T.qkm,lds); S.done(u); }
}
#undef SBAR
#undef WAIT_BAR
}

constexpr int NWAVES = 8, NTHR = 512;
constexpr int NB = 4, SEQ = 8192, DM = 1024, T = NB * SEQ;
constexpr int NEXP = 32, TOPK = 4, ECAP = 32768;
constexpr int NSLOT_ROWS = T * TOPK + NEXP * 256;
constexpr int INW = 6680, NPROJ = 6656;
constexpr float LN_EPS = 1e-5f, ALPHA = 1.18920711500272f, LOG2E = 1.4426950408889634f;
constexpr size_t MiB = 1u << 20;
constexpr size_t WS_CTL = 0;
constexpr size_t WS_MODP = 1 * MiB, WS_MODF = WS_MODP + 512 * 1024;
constexpr size_t WS_WSM = 2 * MiB, WS_WRT = WS_WSM + 256 * 1024;
constexpr size_t WS_FFL = 3 * MiB, WS_GLR = 4 * MiB, WS_CUM = 6 * MiB, WS_DLAST = 7 * MiB;
constexpr size_t WS_TSLOT = 8 * MiB, WS_TGATE = WS_TSLOT + 512 * 1024, WS_RTOK = 9 * MiB;
constexpr size_t WS_WIN = 16 * MiB, WS_WA = 29 * MiB, WS_WB = 30 * MiB, WS_WO = 32 * MiB, WS_WUP = 34 * MiB, WS_WDN = 162 * MiB;
constexpr size_t WS_U = 226 * MiB;
constexpr size_t WS_FQ = 290 * MiB, WS_FK = 322 * MiB, WS_FV = 354 * MiB, WS_GQ = 386 * MiB, WS_GK = 418 * MiB, WS_GV = 450 * MiB, WS_GR = 514 * MiB, WS_GA = 578 * MiB, WS_GB = 642 * MiB;
constexpr size_t WS_US = 706 * MiB;
constexpr size_t WS_U2 = 834 * MiB;
constexpr size_t WS_ACT = 290 * MiB, WS_MOE = 562 * MiB;
constexpr size_t WS_END = 898 * MiB;
static_assert(WS_ACT + (size_t)NSLOT_ROWS * 1024 * 2 <= WS_MOE && WS_MOE + (size_t)NSLOT_ROWS * 1024 * 2 <= WS_U2, "overlay map");

constexpr int LDS_BYTES = 160 * 1024;
constexpr int MISC_OFF = 131072;
constexpr int BARLDS_OFF = LDS_BYTES - 64;
constexpr int CW_BAR = 4096;
constexpr size_t CTL_ZERO_BYTES = 65536;

#define LAS __attribute__((address_space(3)))
typedef unsigned short bf16;
typedef unsigned v4u __attribute__((ext_vector_type(4)));
typedef unsigned v2u __attribute__((ext_vector_type(2)));
typedef float f32x4 __attribute__((ext_vector_type(4)));
typedef float f32x16 __attribute__((ext_vector_type(16)));
typedef short bf16x8 __attribute__((ext_vector_type(8)));
typedef short s16x4 __attribute__((ext_vector_type(4)));
#define LDS_WAIT() asm volatile("s_waitcnt lgkmcnt(0)" ::: "memory")
__device__ __forceinline__ unsigned f2bf(float f) { unsigned u = __builtin_bit_cast(unsigned, f); return (u + 0x7fffu + ((u >> 16) & 1u)) >> 16; }
__device__ __forceinline__ unsigned pk2(float lo, float hi) { return f2bf(lo) | (f2bf(hi) << 16); }
__device__ __forceinline__ float bfl(unsigned w) { return __uint_as_float(w << 16); }
__device__ __forceinline__ float bfh(unsigned w) { return __uint_as_float(w & 0xffff0000u); }
__device__ __forceinline__ float bf1(bf16 h) { return __uint_as_float((unsigned)h << 16); }
template <int CTRL, int RM, bool BC> __device__ __forceinline__ float dpp_mov(float old, float v) { return __builtin_bit_cast(float, __builtin_amdgcn_update_dpp(__builtin_bit_cast(int, old), __builtin_bit_cast(int, v), CTRL, RM, 0xf, BC)); }
__device__ __forceinline__ float wave_sum(float v) {
    v += dpp_mov<0xB1, 0xf, true>(0.f, v); v += dpp_mov<0x4E, 0xf, true>(0.f, v); v += dpp_mov<0x141, 0xf, true>(0.f, v); v += dpp_mov<0x140, 0xf, true>(0.f, v);
    v += dpp_mov<0x142, 0xa, false>(0.f, v); v += dpp_mov<0x143, 0xc, false>(0.f, v);
    return __builtin_bit_cast(float, __builtin_amdgcn_readlane(__builtin_bit_cast(int, v), 63));
}
__device__ __forceinline__ float wave_max(float v) {
    v = fmaxf(v, dpp_mov<0xB1, 0xf, true>(v, v)); v = fmaxf(v, dpp_mov<0x4E, 0xf, true>(v, v)); v = fmaxf(v, dpp_mov<0x141, 0xf, true>(v, v)); v = fmaxf(v, dpp_mov<0x140, 0xf, true>(v, v));
    v = fmaxf(v, dpp_mov<0x142, 0xa, false>(v, v)); v = fmaxf(v, dpp_mov<0x143, 0xc, false>(v, v));
    return __builtin_bit_cast(float, __builtin_amdgcn_readlane(__builtin_bit_cast(int, v), 63));
}
__device__ __forceinline__ float logsigmoidf(float x) { return fminf(x, 0.f) - __logf(1.0f + __expf(-fabsf(x))); }
__device__ __forceinline__ float sigmoidf_(float x) { return 1.0f / (1.0f + __expf(-x)); }
__device__ __forceinline__ float reduce32(const float (&v)[32], int lane) {
    float a[16], b[8], c[4], d[2], e;
#pragma unroll
    for (int i = 0; i < 16; ++i) { const auto r = __builtin_amdgcn_permlane32_swap(__float_as_uint(v[i]), __float_as_uint(v[16 + i]), false, false); a[i] = __uint_as_float(r[0]) + __uint_as_float(r[1]); }
#pragma unroll
    for (int i = 0; i < 8; ++i) { const auto r = __builtin_amdgcn_permlane16_swap(__float_as_uint(a[i]), __float_as_uint(a[8 + i]), false, false); b[i] = __uint_as_float(r[0]) + __uint_as_float(r[1]); }
    { const bool up = lane & 8;
#pragma unroll
      for (int i = 0; i < 4; ++i) { const float sx = b[i] + dpp_mov<0x128, 0xf, true>(0.f, b[i]), sy = b[4 + i] + dpp_mov<0x128, 0xf, true>(0.f, b[4 + i]); c[i] = up ? sy : sx; } }
    { const bool up = lane & 4;
#pragma unroll
      for (int i = 0; i < 2; ++i) { const float sx = c[i] + __builtin_bit_cast(float, __builtin_amdgcn_ds_swizzle(__builtin_bit_cast(int, c[i]), 0x101F)), sy = c[2 + i] + __builtin_bit_cast(float, __builtin_amdgcn_ds_swizzle(__builtin_bit_cast(int, c[2 + i]), 0x101F)); d[i] = up ? sy : sx; } }
    { const bool up = lane & 2; const float sx = d[0] + dpp_mov<0x4E, 0xf, true>(0.f, d[0]), sy = d[1] + dpp_mov<0x4E, 0xf, true>(0.f, d[1]); e = up ? sy : sx; }
    e += dpp_mov<0xB1, 0xf, true>(0.f, e);
    return e;
}

__device__ __forceinline__ bf16x8 frag_row(const LAS bf16* img, int stride, int row0, int k0, int lane) {
    return *(const LAS bf16x8*)(img + (row0 + (lane & 31)) * stride + k0 + 8 * (lane >> 5));
}
__device__ __forceinline__ bf16x8 frag_tr(const LAS bf16* img, int stride, int k0, int n0, int lane) {
    const int g = lane >> 4, q = (lane >> 2) & 3, p = lane & 3, h = g >> 1;
    const LAS bf16* a = img + (k0 + 8 * h + q) * stride + n0 + 16 * (g & 1) + 4 * p;
    const s16x4 lo = __builtin_bit_cast(s16x4, __builtin_amdgcn_ds_read_tr16_b64_v4i16((LAS s16x4*)a));
    const s16x4 hi = __builtin_bit_cast(s16x4, __builtin_amdgcn_ds_read_tr16_b64_v4i16((LAS s16x4*)(a + 4 * stride)));
    return (bf16x8){lo[0], lo[1], lo[2], lo[3], hi[0], hi[1], hi[2], hi[3]};
}
__device__ __forceinline__ int crow16(int r, int h) { return (r & 3) + 8 * (r >> 2) + 4 * h; }

typedef __attribute__((address_space(1))) unsigned gu32;
#define XB_TMO      128
#define XB_XCNT(j)  (256  + 64 * (j))
#define XB_XSUB(j)  (1280 + 64 * (j))
#define XB_XGEN(j)  (2304 + 64 * (j))
#define XB_TOP      3328
#define XB_TOPGEN   3392
#define XCD_BAR_WORDS 3456
#define XB_SPIN_CAP (1u << 18)

__device__ __forceinline__ unsigned xb_ld(unsigned* p)              { return __hip_atomic_load(p, __ATOMIC_RELAXED, __HIP_MEMORY_SCOPE_AGENT); }
__device__ __forceinline__ unsigned xb_add(unsigned* p, unsigned v) { return __hip_atomic_fetch_add(p, v, __ATOMIC_RELAXED, __HIP_MEMORY_SCOPE_AGENT); }
__device__ __forceinline__ unsigned xb_xcc_id() { return (unsigned)__builtin_amdgcn_s_getreg((3 << 11) | 20) & 0xFu; }
#define XB_SPIN(cond, bar) do { unsigned _sp = 0; while (cond) { __builtin_amdgcn_s_sleep(1); \
    if ((++_sp & 255u) == 0u) { if (xb_ld(&(bar)[XB_TMO])) break; if (_sp > XB_SPIN_CAP) { atomicAdd(&(bar)[XB_TMO], 1u); break; } } } } while (0)

struct XcdBarrier {
    unsigned* bar; unsigned x;
    volatile LAS unsigned* st;
};

__device__ __forceinline__ XcdBarrier xcd_barrier_post(unsigned* bar, volatile LAS unsigned* st) {
    XcdBarrier b; b.bar = bar; b.x = xb_xcc_id(); b.st = st;
    if (threadIdx.x == 0) (void)xb_add(&bar[XB_XCNT(b.x)], 1u);
    return b;
}
__device__ __forceinline__ void xcd_barrier_complete(unsigned* bar, unsigned x, unsigned& nloc, unsigned& nx) {
    const unsigned G = gridDim.x * gridDim.y * gridDim.z;
    unsigned sum, cnt, mine, sp = 0u;
    for (;;) {
        sum = 0u; cnt = 0u; mine = 0u;
#pragma unroll
        for (unsigned j = 0; j < 16; ++j) { const unsigned c = xb_ld(&bar[XB_XCNT(j)]); sum += c; cnt += (c > 0u) ? 1u : 0u; mine = (j == x) ? c : mine; }
        if (sum == G) break;
        __builtin_amdgcn_s_sleep(1);
        if ((++sp & 255u) == 0u) { if (xb_ld(&bar[XB_TMO])) break; if (sp > XB_SPIN_CAP) { atomicAdd(&bar[XB_TMO], 1u); break; } }
    }
    nloc = mine > 0u ? mine : 1u; nx = cnt > 0u ? cnt : 1u;
}

__device__ __forceinline__ void xcd_barrier(const XcdBarrier& b) {
    asm volatile("s_waitcnt vmcnt(0)" ::: "memory");
    __syncthreads();
    if (threadIdx.x == 0) {
        unsigned* bar = b.bar;
        __builtin_amdgcn_s_waitcnt(0);
        unsigned nloc = b.st[0], nx = b.st[1];
        if (nloc == 0u) { xcd_barrier_complete(bar, b.x, nloc, nx); b.st[0] = nloc; b.st[1] = nx; }
        const unsigned old = xb_add(&bar[XB_XSUB(b.x)], 1u);
        const unsigned gen = old / nloc;
        if (old + 1u == (gen + 1u) * nloc) {
            __builtin_amdgcn_fence(__ATOMIC_RELEASE, "agent");
            asm volatile("s_waitcnt vmcnt(0)" ::: "memory");
            const unsigned og = xb_add(&bar[XB_TOP], 1u);
            const unsigned tg = og / nx;
            if (og + 1u == (tg + 1u) * nx) xb_add(&bar[XB_TOPGEN], 1u);
            else XB_SPIN(xb_ld(&bar[XB_TOPGEN]) == tg, bar);
            __builtin_amdgcn_fence(__ATOMIC_ACQUIRE, "agent");
            xb_add(&bar[XB_XGEN(b.x)], 1u);
            asm volatile("s_waitcnt vmcnt(0)" ::: "memory");
        } else {
            XB_SPIN(xb_ld(&bar[XB_XGEN(b.x)]) == gen, bar);
            __builtin_amdgcn_fence(__ATOMIC_ACQUIRE, "agent");
            asm volatile("s_waitcnt vmcnt(0)" ::: "memory");
        }
    }
    __syncthreads();
}

__device__ __forceinline__ int tid_() { int t = threadIdx.x; asm volatile("" : "+v"(t)); return t; }
struct Frame {
    LAS unsigned char* lds;
    int wave, G, blk;
    float* out; unsigned char* ws;
};
#define WSP(type, off) ((type*)(F.ws + (off)))
constexpr size_t WS_PTRS = 2048;
#define GAS __attribute__((address_space(1)))
typedef const GAS float* gfptr_t;
typedef const GAS f32x4* gf4ptr_t;
#define PT(k) (((const gfptr_t*)(F.ws + WS_PTRS))[k])
struct Args { const float* in[22]; float* out; unsigned char* ws; int ph_lo, ph_hi; };

__device__ __forceinline__ void p0_transpose_item(const float* W, int ldw, int sc0, bf16* WT, int Kd, int drow0, int k0, LAS float* scr, int lane) {
#pragma unroll 8
    for (int i = 0; i < 32; ++i) { const int kk = 2 * i + (lane >> 5); scr[kk * 33 + (lane & 31)] = W[(size_t)(k0 + kk) * ldw + sc0 + (lane & 31)]; }
    LDS_WAIT(); asm volatile("" ::: "memory");
    const int c = lane & 7;
#pragma unroll
    for (int j = 0; j < 4; ++j) { const int n = (lane >> 3) + 8 * j; const LAS float* s = scr + (8 * c) * 33 + n;
        v4u o; o.x = pk2(s[0 * 33], s[1 * 33]); o.y = pk2(s[2 * 33], s[3 * 33]); o.z = pk2(s[4 * 33], s[5 * 33]); o.w = pk2(s[6 * 33], s[7 * 33]);
        *(v4u*)(WT + (size_t)(drow0 + n) * Kd + k0 + 8 * c) = o; }
    LDS_WAIT(); asm volatile("" ::: "memory");
}
__device__ __forceinline__ void phase0(Frame& F, const Args& A) {
    const int tid = tid_(), lane = tid & 63; (void)lane;
    const int gtid = F.blk * NTHR + tid, NT_ALL = F.G * NTHR;
    if (F.blk == 0 && tid < 64) WSP(unsigned, WS_CTL)[tid] = 0u;
    if (F.blk == 0 && tid < 22) ((const float**)(F.ws + WS_PTRS))[tid] = A.in[tid];
    { v4u* p = WSP(v4u, WS_RTOK); for (int i = gtid; i < NEXP * ECAP / 4; i += NT_ALL) p[i] = (v4u){0u, 0u, 0u, 0u}; }
    for (int i = gtid; i < 24 * 1024; i += NT_ALL) { const int o = i >> 10, k = i & 1023; const int col = o < 8 ? 1536 + o : 4616 + (o - 8); WSP(float, WS_WSM)[i] = A.in[4][(size_t)k * INW + col]; }
    for (int i = gtid; i < 32 * 1024; i += NT_ALL) { const int e = i >> 10, k = i & 1023; WSP(float, WS_WRT)[i] = A.in[14][k * 32 + e]; }
    if (F.blk < 48) {
        LAS float* sc = (LAS float*)F.lds;
        for (int i = tid; i < 4096; i += NTHR) { const float v = A.in[1][i]; sc[i] = v * sigmoidf_(v); }
        __syncthreads();
        const int ks = gtid / 6144, j = gtid % 6144; float a0 = 0.f, a1 = 0.f, a2 = 0.f, a3 = 0.f;
        const float* wp = A.in[2] + (size_t)(ks * 256) * 6144 + j; const LAS float* s = sc + ks * 256;
#pragma unroll 8
        for (int k = 0; k < 256; ++k) { const float w = wp[(size_t)k * 6144]; a0 += s[k] * w; a1 += s[1024 + k] * w; a2 += s[2048 + k] * w; a3 += s[3072 + k] * w; }
        const float bb = ks == 0 ? A.in[3][j] : 0.f; float* mp = WSP(float, WS_MODP) + (size_t)ks * 4 * 6144 + j;
        mp[0] = a0 + bb; mp[6144] = a1 + bb; mp[2 * 6144] = a2 + bb; mp[3 * 6144] = a3 + bb;
        __syncthreads();
    }
    LAS float* scr = (LAS float*)(F.lds + 16384 + F.wave * 16384);
    const int gw = F.blk * NWAVES + F.wave, NGW = F.G * NWAVES;
    constexpr int I_IN = 16 * (NPROJ / 32), I_A = 8 * 32, I_B = 16 * 32, I_O = 16 * 32, I_UP = 16 * 64, I_DN = 16 * 32;
    constexpr int NITEMS = I_IN + I_A + I_B + I_O + NEXP * (I_UP + I_DN);
    for (int it = gw; it < NITEMS; it += NGW) {
        int r = it;
        if (r < I_IN) { const int nblk = NPROJ / 32, kb = r / nblk, nb = r % nblk, n0 = 32 * nb; const int sc0 = n0 + (n0 < 1536 ? 0 : (n0 < 4608 ? 8 : 24));
            p0_transpose_item(A.in[4], INW, sc0, WSP(bf16, WS_WIN), 1024, n0, 64 * kb, scr, lane); continue; } r -= I_IN;
        if (r < I_A) { const int kb = r / 32, nb = r % 32; p0_transpose_item(A.in[9], 1024, 32 * nb, WSP(bf16, WS_WA), 512, 32 * nb, 64 * kb, scr, lane); continue; } r -= I_A;
        if (r < I_B) { const int kb = r / 32, nb = r % 32; p0_transpose_item(A.in[10], 1024, 32 * nb, WSP(bf16, WS_WB), 1024, 32 * nb, 64 * kb, scr, lane); continue; } r -= I_B;
        if (r < I_O) { const int kb = r / 32, nb = r % 32; p0_transpose_item(A.in[11], 1024, 32 * nb, WSP(bf16, WS_WO), 1024, 32 * nb, 64 * kb, scr, lane); continue; } r -= I_O;
        const int e = r / (I_UP + I_DN); r -= e * (I_UP + I_DN);
        if (r < I_UP) { const int kb = r / 64, nb = r % 64, n0 = 32 * nb, tile = n0 >> 8, w = n0 & 255; const int sc0 = w < 128 ? 128 * tile + w : 1024 + 128 * tile + (w - 128);
            p0_transpose_item(A.in[16] + (size_t)e * 1024 * 2048, 2048, sc0, WSP(bf16, WS_WUP) + (size_t)e * 2048 * 1024, 1024, n0, 64 * kb, scr, lane); continue; } r -= I_UP;
        { const int kb = r / 32, nb = r % 32; p0_transpose_item(A.in[18] + (size_t)e * 1024 * 1024, 1024, 32 * nb, WSP(bf16, WS_WDN) + (size_t)e * 1024 * 1024, 1024, 32 * nb, 64 * kb, scr, lane); }
    }
}

template <int R> __device__ __forceinline__ void ln_center(f32x4 (&v)[R][4], float (&rstd)[R]) {
    float s[R];
#pragma unroll
    for (int r = 0; r < R; ++r) { s[r] = 0.f;
#pragma unroll
        for (int j = 0; j < 4; ++j) s[r] += (v[r][j].x + v[r][j].y) + (v[r][j].z + v[r][j].w); }
#pragma unroll
    for (int r = 0; r < R; ++r) { const float mean = wave_sum(s[r]) * (1.f / DM); s[r] = 0.f;
#pragma unroll
        for (int j = 0; j < 4; ++j) { v[r][j] = v[r][j] - mean; s[r] += (v[r][j].x * v[r][j].x + v[r][j].y * v[r][j].y) + (v[r][j].z * v[r][j].z + v[r][j].w * v[r][j].w); } }
#pragma unroll
    for (int r = 0; r < R; ++r) rstd[r] = 1.f / sqrtf(wave_sum(s[r]) * (1.f / DM) + LN_EPS);
}
template <int NO> __device__ __forceinline__ void row_dots2(const f32x4 (&v)[2][4], const LAS float* w, int lane, float (&p0)[32], float (&p1)[32]) {
#pragma unroll
    for (int o = 0; o < NO; ++o) { float a0 = 0.f, a1 = 0.f;
#pragma unroll
        for (int j = 0; j < 4; ++j) { const f32x4 ww = *(const LAS f32x4*)(w + o * 1024 + 256 * j + 4 * lane);
            a0 += (v[0][j].x * ww.x + v[0][j].y * ww.y) + (v[0][j].z * ww.z + v[0][j].w * ww.w); a1 += (v[1][j].x * ww.x + v[1][j].y * ww.y) + (v[1][j].z * ww.z + v[1][j].w * ww.w); }
        p0[o] = a0; p1[o] = a1; if ((o & 3) == 3) asm volatile("" ::: "memory"); }
#pragma unroll
    for (int o = NO; o < 32; ++o) { p0[o] = 0.f; p1[o] = 0.f; }
}
__device__ __forceinline__ void phase1(Frame& F, const Args& A) {
    const int tid = tid_(), lane = tid & 63;
    LAS float* wsm = (LAS float*)F.lds;
    LAS float* mods = (LAS float*)(F.lds + 98304);
    const int b = F.blk / (F.G / NB);
    for (int i = tid; i < 24 * 1024 / 4; i += NTHR) ((LAS f32x4*)wsm)[i] = WSP(f32x4, WS_WSM)[i];
    for (int i = tid; i < 2048; i += NTHR) { const float* mp = WSP(float, WS_MODP) + (size_t)b * 6144 + i; mods[i] = (mp[0] + mp[4 * 6144]) + (mp[2 * 4 * 6144] + mp[3 * 4 * 6144]); }
    { const int gtid = F.blk * NTHR + tid; if (gtid < 4 * 6144) { const float* mp = WSP(float, WS_MODP) + gtid; WSP(float, WS_MODF)[gtid] = (mp[0] + mp[4 * 6144]) + (mp[2 * 4 * 6144] + mp[3 * 4 * 6144]); } }
    __syncthreads();
    const int rows_per_blk = T / F.G, rows_per_wave = rows_per_blk / NWAVES;
    const int row0 = F.blk * rows_per_blk + F.wave * rows_per_wave;
    const int oi = lane >> 1; const float fb = oi < 8 ? A.in[5][oi] : 0.f;
    f32x4 nx[2][4];
#pragma unroll
    for (int r = 0; r < 2; ++r)
#pragma unroll
        for (int j = 0; j < 4; ++j) nx[r][j] = ((const f32x4*)(A.in[0] + (size_t)(row0 + r) * DM) + lane)[64 * j];
    for (int rr = 0; rr < rows_per_wave; rr += 2) {
        const int row = row0 + rr;
        f32x4 v[2][4];
#pragma unroll
        for (int r = 0; r < 2; ++r)
#pragma unroll
            for (int j = 0; j < 4; ++j) v[r][j] = nx[r][j];
        if (rr + 2 < rows_per_wave) {
#pragma unroll
            for (int r = 0; r < 2; ++r)
#pragma unroll
                for (int j = 0; j < 4; ++j) nx[r][j] = ((const f32x4*)(A.in[0] + (size_t)(row + 2 + r) * DM) + lane)[64 * j]; }
        float rstd[2]; ln_center<2>(v, rstd);
#pragma unroll
        for (int r = 0; r < 2; ++r) { unsigned long long* o8 = (unsigned long long*)(WSP(bf16, WS_U) + (size_t)(row + r) * DM) + lane;
#pragma unroll
            for (int j = 0; j < 4; ++j) { const f32x4 sh = *(const LAS f32x4*)(mods + 256 * j + 4 * lane), scv = *(const LAS f32x4*)(mods + 1024 + 256 * j + 4 * lane);
                v[r][j] = v[r][j] * rstd[r] * (scv + 1.0f) + sh;
                o8[64 * j] = (unsigned long long)pk2(v[r][j].x, v[r][j].y) | ((unsigned long long)pk2(v[r][j].z, v[r][j].w) << 32); } }
        float p0[32], p1[32]; row_dots2<24>(v, wsm, lane, p0, p1);
        const float t0 = reduce32(p0, lane), t1 = reduce32(p1, lane);
        if ((lane & 1) == 0) {
            if (oi < 8) { WSP(float, WS_FFL)[(size_t)row * 8 + oi] = logsigmoidf(t0 + fb) * LOG2E; WSP(float, WS_FFL)[(size_t)(row + 1) * 8 + oi] = logsigmoidf(t1 + fb) * LOG2E; }
            else if (oi < 24) { WSP(float, WS_GLR)[(size_t)row * 16 + (oi - 8)] = t0; WSP(float, WS_GLR)[(size_t)(row + 1) * 16 + (oi - 8)] = t1; }
        }
    }
}

constexpr int GC = 64, GDK = 128, GDV = 256, GNCH = SEQ / GC, GITEMS = NB * 4 * GNCH;
constexpr int KST = 136, VST = 264, PST = 72;
__device__ __forceinline__ void fox_cumsum_item(Frame& F, int bh) {
    const int tid = tid_(), lane = tid & 63; (void)lane;
    const int b = bh >> 3, h = bh & 7; LAS float* wt = (LAS float*)(F.lds + MISC_OFF);
    const float* src = WSP(float, WS_FFL) + (size_t)b * SEQ * 8 + h; float v[16]; float run = 0.f;
#pragma unroll
    for (int i = 0; i < 16; ++i) { run += src[(size_t)(tid * 16 + i) * 8]; v[i] = run; }
    float incl = run;
#pragma unroll
    for (int o = 1; o < 64; o <<= 1) { const float n = __shfl_up(incl, o); if (lane >= o) incl += n; }
    if (lane == 63) wt[F.wave] = incl;
    __syncthreads();
    float base = incl - run;
    for (int w = 0; w < F.wave; ++w) base += wt[w];
    float* dst = WSP(float, WS_CUM) + (size_t)bh * SEQ + tid * 16;
#pragma unroll
    for (int i = 0; i < 16; i += 4) *(f32x4*)(dst + i) = (f32x4){v[i] + base, v[i + 1] + base, v[i + 2] + base, v[i + 3] + base};
    __syncthreads();
}
__device__ __forceinline__ float gla_decay(Frame& F, int h, const LAS float* glrS, LAS float* totS, float (&p)[16]) {
    const int tid = tid_(), lane = tid & 63; (void)lane;
    const int c = tid & 127, tg = tid >> 7; float wg[16];
#pragma unroll
    for (int r = 0; r < 16; ++r) wg[r] = PT(6)[r * 512 + h * GDK + c];
    const float bg = PT(7)[h * GDK + c]; float run = 0.f;
#pragma unroll
    for (int i = 0; i < 16; ++i) { const LAS float* gr = glrS + (tg * 16 + i) * 16; float z = bg;
#pragma unroll
        for (int r = 0; r < 16; ++r) z += gr[r] * wg[r];
        run += logsigmoidf(z) * (1.0f / 16.0f); p[i] = run; }
    totS[tg * GDK + c] = run;
    __syncthreads();
    float off = 0.f, tot = 0.f;
#pragma unroll
    for (int g = 0; g < 4; ++g) { const float tv = totS[g * GDK + c]; tot += tv; if (g < tg) off += tv; }
#pragma unroll
    for (int i = 0; i < 16; ++i) p[i] += off;
    return tot;
}
__device__ __forceinline__ void gla_state_phase(Frame& F) {
    const int tid = tid_(), lane = tid & 63;
    LAS bf16* KS = (LAS bf16*)F.lds;
    LAS bf16* VS = (LAS bf16*)(F.lds + 17408);
    LAS float* glrS = (LAS float*)(F.lds + 51200);
    LAS float* totS = (LAS float*)(F.lds + 55296);
    LAS bf16* US = (LAS bf16*)(F.lds + 57344);
    v4u pv[4], pk[2]; f32x4 pg = (f32x4){0.f, 0.f, 0.f, 0.f};
#define GLA_A_PREFETCH(it_) do { const int n_ = (it_) & (GNCH - 1), bh_ = (it_) >> 7, h_ = bh_ & 3, b_ = bh_ >> 2; const size_t r0_ = (size_t)b_ * SEQ + (size_t)n_ * GC; \
        _Pragma("unroll") for (int i = 0; i < 4; ++i) { const int pc = tid + i * NTHR, t = pc >> 5, ch = pc & 31; pv[i] = *(const v4u*)(WSP(bf16, WS_GV) + (r0_ + t) * 1024 + h_ * GDV + ch * 8); } \
        _Pragma("unroll") for (int i = 0; i < 2; ++i) { const int pc = tid + i * NTHR, t = pc >> 4, ch = pc & 15; pk[i] = *(const v4u*)(WSP(bf16, WS_GK) + (r0_ + t) * 512 + h_ * GDK + ch * 8); } \
        if (tid < 256) pg = ((const f32x4*)(WSP(float, WS_GLR) + r0_ * 16))[tid]; } while (0)
    int it = F.blk;
    if (it < GITEMS) GLA_A_PREFETCH(it);
    for (; it < GITEMS; it += F.G) {
        const int bh = it >> 7, h = bh & 3;
#pragma unroll
        for (int i = 0; i < 4; ++i) { const int pc = tid + i * NTHR, t = pc >> 5, ch = pc & 31; *(LAS v4u*)(VS + t * VST + ch * 8) = pv[i]; }
#pragma unroll
        for (int i = 0; i < 2; ++i) { const int pc = tid + i * NTHR, t = pc >> 4, ch = pc & 15; *(LAS v4u*)(KS + t * KST + ch * 8) = pk[i]; }
        if (tid < 256) ((LAS f32x4*)glrS)[tid] = pg;
        __syncthreads();
        if (it + F.G < GITEMS) GLA_A_PREFETCH(it + F.G);
        float p[16]; const float blast = gla_decay(F, h, glrS, totS, p);
        const int c = tid & 127, tg = tid >> 7;
#pragma unroll
        for (int i = 0; i < 16; ++i) { const int t = tg * 16 + i; KS[t * KST + c] = (bf16)f2bf(bf1(KS[t * KST + c]) * __expf(blast - p[i])); }
        if (tg == 0) WSP(float, WS_DLAST)[(size_t)it * GDK + c] = __expf(blast);
        __syncthreads();
        f32x16 acc[4];
#pragma unroll
        for (int cb = 0; cb < 4; ++cb) acc[cb] = (f32x16){};
#pragma unroll
        for (int ks = 0; ks < 4; ++ks) { const bf16x8 a = frag_tr(VS, VST, 16 * ks, 32 * F.wave, lane);
#pragma unroll
            for (int cb = 0; cb < 4; ++cb) { const bf16x8 bb = frag_tr(KS, KST, 16 * ks, 32 * cb, lane); acc[cb] = __builtin_amdgcn_mfma_f32_32x32x16_bf16(a, bb, acc[cb], 0, 0, 0); } }
        const int hh = lane >> 5;
#pragma unroll
        for (int cb = 0; cb < 4; ++cb) { const int cc = 32 * cb + (lane & 31);
#pragma unroll
            for (int g = 0; g < 4; ++g) { v2u w; w.x = pk2(acc[cb][4 * g], acc[cb][4 * g + 1]); w.y = pk2(acc[cb][4 * g + 2], acc[cb][4 * g + 3]);
                *(LAS v2u*)(US + cc * VST + 32 * F.wave + 8 * g + 4 * hh) = w; } }
        __syncthreads();
        bf16* us = WSP(bf16, WS_US) + (size_t)it * GDK * GDV;
#pragma unroll
        for (int i = 0; i < 8; ++i) { const int pc = tid + i * NTHR, cc = pc >> 5, ch = pc & 31; *(v4u*)(us + (size_t)cc * GDV + ch * 8) = *(const LAS v4u*)(US + cc * VST + ch * 8); }
    }
#undef GLA_A_PREFETCH
    __syncthreads();
}
constexpr int CW_QKM = 64;
__device__ __forceinline__ void fox_norm_item(Frame& F, int item) {
    const int tid = tid_(), lane = tid & 63; (void)lane;
    const int bh = item >> 4, sl = item & 15, b = bh >> 3, h = bh & 7; const size_t row = (size_t)b * SEQ + sl * 512 + tid;
    const v4u* qp = (const v4u*)(WSP(bf16, WS_FQ) + row * 512 + h * 64); const v4u* kp = (const v4u*)(WSP(bf16, WS_FK) + row * 512 + h * 64);
    float q2 = 0.f, k2 = 0.f;
#pragma unroll
    for (int i = 0; i < 8; ++i) { const v4u a = qp[i], c = kp[i];
        q2 += (bfl(a.x) * bfl(a.x) + bfh(a.x) * bfh(a.x)) + (bfl(a.y) * bfl(a.y) + bfh(a.y) * bfh(a.y)) + (bfl(a.z) * bfl(a.z) + bfh(a.z) * bfh(a.z)) + (bfl(a.w) * bfl(a.w) + bfh(a.w) * bfh(a.w));
        k2 += (bfl(c.x) * bfl(c.x) + bfh(c.x) * bfh(c.x)) + (bfl(c.y) * bfl(c.y) + bfh(c.y) * bfh(c.y)) + (bfl(c.z) * bfl(c.z) + bfh(c.z) * bfh(c.z)) + (bfl(c.w) * bfl(c.w) + bfh(c.w) * bfh(c.w)); }
    q2 = wave_max(q2) * 1.0001f; k2 = wave_max(k2) * 1.0001f;
    if (lane == 0) { atomicMax(WSP(unsigned, WS_CTL) + CW_QKM + bh, __float_as_uint(q2)); atomicMax(WSP(unsigned, WS_CTL) + CW_QKM + 32 + bh, __float_as_uint(k2)); }
}
__device__ __forceinline__ void phase3(Frame& F) {
    if (F.blk < 32) fox_cumsum_item(F, F.blk);
    for (int it = F.blk; it < 512; it += F.G) fox_norm_item(F, it);
    gla_state_phase(F);
}

__device__ __forceinline__ void gla_scan(Frame& F) {
    const int tid = tid_(), lane = tid & 63; (void)lane;
    const int NTOT = 16 * GDK * GDV / 4;
    for (int gt = F.blk * NTHR + tid; gt < NTOT; gt += F.G * NTHR) {
        const int bh = gt / (GDK * GDV / 4), e4 = gt % (GDK * GDV / 4), c = e4 >> 6;
        bf16* p = WSP(bf16, WS_US) + (size_t)bh * GNCH * GDK * GDV + (size_t)e4 * 4; const float* dl = WSP(float, WS_DLAST) + (size_t)bh * GNCH * GDK + c;
        float s0 = 0.f, s1 = 0.f, s2 = 0.f, s3 = 0.f;
        for (int n0 = 0; n0 < GNCH; n0 += 8) { v2u u[8]; float d[8];
#pragma unroll
            for (int j = 0; j < 8; ++j) { u[j] = *(const v2u*)(p + (size_t)(n0 + j) * GDK * GDV); d[j] = dl[(size_t)(n0 + j) * GDK]; }
#pragma unroll
            for (int j = 0; j < 8; ++j) { v2u o; o.x = pk2(s0, s1); o.y = pk2(s2, s3); *(v2u*)(p + (size_t)(n0 + j) * GDK * GDV) = o;
                s0 = d[j] * s0 + bfl(u[j].x); s1 = d[j] * s1 + bfh(u[j].x); s2 = d[j] * s2 + bfl(u[j].y); s3 = d[j] * s3 + bfh(u[j].y); } }
    }
}

__device__ __forceinline__ void gla_out_phase(Frame& F) {
    const int tid = tid_(), lane = tid & 63;
    LAS bf16* QhS = (LAS bf16*)F.lds;
    LAS bf16* KcS = (LAS bf16*)(F.lds + 17408);
    LAS bf16* PS = (LAS bf16*)(F.lds + 34816);
    LAS bf16* VS = (LAS bf16*)(F.lds + 44032);
    LAS bf16* SS = (LAS bf16*)(F.lds + 77824);
    LAS float* glrS = (LAS float*)(F.lds + 145408);
    LAS float* totS = glrS + 1024;
    LAS float* oS = (LAS float*)(F.lds + 44032);
    v4u ps[8], pv[4], pq[2], pk[2]; f32x4 pg = (f32x4){0.f, 0.f, 0.f, 0.f};
#define GLA_C_PREFETCH(it_) do { const int n_ = (it_) & (GNCH - 1), bh_ = (it_) >> 7, h_ = bh_ & 3, b_ = bh_ >> 2; const size_t r0_ = (size_t)b_ * SEQ + (size_t)n_ * GC; \
        const bf16* sp_ = WSP(bf16, WS_US) + (size_t)(it_) * GDK * GDV; \
        _Pragma("unroll") for (int i = 0; i < 8; ++i) { const int pc = tid + i * NTHR, cc = pc >> 5, ch = pc & 31; ps[i] = *(const v4u*)(sp_ + (size_t)cc * GDV + ch * 8); } \
        _Pragma("unroll") for (int i = 0; i < 4; ++i) { const int pc = tid + i * NTHR, t = pc >> 5, ch = pc & 31; pv[i] = *(const v4u*)(WSP(bf16, WS_GV) + (r0_ + t) * 1024 + h_ * GDV + ch * 8); } \
        _Pragma("unroll") for (int i = 0; i < 2; ++i) { const int pc = tid + i * NTHR, t = pc >> 4, ch = pc & 15; const size_t go = (r0_ + t) * 512 + h_ * GDK + ch * 8; \
            pq[i] = *(const v4u*)(WSP(bf16, WS_GQ) + go); pk[i] = *(const v4u*)(WSP(bf16, WS_GK) + go); } \
        if (tid < 256) pg = ((const f32x4*)(WSP(float, WS_GLR) + r0_ * 16))[tid]; } while (0)
    int it = F.blk;
    if (it < GITEMS) GLA_C_PREFETCH(it);
    for (; it < GITEMS; it += F.G) {
        const int n = it & (GNCH - 1), bh = it >> 7, h = bh & 3, b = bh >> 2; const size_t r0 = (size_t)b * SEQ + (size_t)n * GC;
#pragma unroll
        for (int i = 0; i < 8; ++i) { const int pc = tid + i * NTHR, cc = pc >> 5, ch = pc & 31; *(LAS v4u*)(SS + cc * VST + ch * 8) = ps[i]; }
#pragma unroll
        for (int i = 0; i < 4; ++i) { const int pc = tid + i * NTHR, t = pc >> 5, ch = pc & 31; *(LAS v4u*)(VS + t * VST + ch * 8) = pv[i]; }
#pragma unroll
        for (int i = 0; i < 2; ++i) { const int pc = tid + i * NTHR, t = pc >> 4, ch = pc & 15; *(LAS v4u*)(QhS + t * KST + ch * 8) = pq[i]; *(LAS v4u*)(KcS + t * KST + ch * 8) = pk[i]; }
        if (tid < 256) ((LAS f32x4*)glrS)[tid] = pg;
        __syncthreads();
        if (it + F.G < GITEMS) GLA_C_PREFETCH(it + F.G);
        float p[16]; (void)gla_decay(F, h, glrS, totS, p);
        { const int c = tid & 127, tg = tid >> 7;
#pragma unroll
          for (int i = 0; i < 16; ++i) { const int t = tg * 16 + i; const float e = __expf(p[i]);
              QhS[t * KST + c] = (bf16)f2bf(bf1(QhS[t * KST + c]) * e); KcS[t * KST + c] = (bf16)f2bf(bf1(KcS[t * KST + c]) * __builtin_amdgcn_rcpf(e)); } }
        __syncthreads();
        if (F.wave < 4) { const int tb = F.wave >> 1, sb = F.wave & 1; f32x16 pa = (f32x16){};
#pragma unroll
            for (int ks = 0; ks < 8; ++ks) pa = __builtin_amdgcn_mfma_f32_32x32x16_bf16(frag_row(KcS, KST, 32 * sb, 16 * ks, lane), frag_row(QhS, KST, 32 * tb, 16 * ks, lane), pa, 0, 0, 0);
            const int t = 32 * tb + (lane & 31), hh = lane >> 5;
#pragma unroll
            for (int g = 0; g < 4; ++g) { const int s0 = 32 * sb + 8 * g + 4 * hh; v2u w;
                w.x = pk2(s0 <= t ? pa[4 * g] : 0.f, s0 + 1 <= t ? pa[4 * g + 1] : 0.f); w.y = pk2(s0 + 2 <= t ? pa[4 * g + 2] : 0.f, s0 + 3 <= t ? pa[4 * g + 3] : 0.f);
                *(LAS v2u*)(PS + t * PST + s0) = w; } }
        __syncthreads();
        f32x16 acc[2]; acc[0] = (f32x16){}; acc[1] = (f32x16){};
#pragma unroll
        for (int ks = 0; ks < 8; ++ks) { const bf16x8 aa = frag_tr(SS, VST, 16 * ks, 32 * F.wave, lane);
#pragma unroll
            for (int tb = 0; tb < 2; ++tb) acc[tb] = __builtin_amdgcn_mfma_f32_32x32x16_bf16(aa, frag_row(QhS, KST, 32 * tb, 16 * ks, lane), acc[tb], 0, 0, 0); }
#pragma unroll
        for (int ks = 0; ks < 4; ++ks) { const bf16x8 aa = frag_tr(VS, VST, 16 * ks, 32 * F.wave, lane);
#pragma unroll
            for (int tb = 0; tb < 2; ++tb) acc[tb] = __builtin_amdgcn_mfma_f32_32x32x16_bf16(aa, frag_row(PS, PST, 32 * tb, 16 * ks, lane), acc[tb], 0, 0, 0); }
        __syncthreads();
        { const int hh = lane >> 5;
#pragma unroll
          for (int tb = 0; tb < 2; ++tb)
#pragma unroll
              for (int g = 0; g < 4; ++g) *(LAS f32x4*)(oS + (32 * tb + (lane & 31)) * 260 + 32 * F.wave + 8 * g + 4 * hh) = (f32x4){acc[tb][4 * g], acc[tb][4 * g + 1], acc[tb][4 * g + 2], acc[tb][4 * g + 3]}; }
        __syncthreads();
        { const f32x4 gn = *(gf4ptr_t)(PT(8) + h * GDV + 4 * lane); v2u gg[8];
#pragma unroll
          for (int i = 0; i < 8; ++i) gg[i] = *(const v2u*)(WSP(bf16, WS_GR) + (r0 + 8 * F.wave + i) * 1024 + h * GDV + 4 * lane);
#pragma unroll
          for (int i = 0; i < 8; ++i) { const int t = 8 * F.wave + i; const f32x4 o = *(const LAS f32x4*)(oS + t * 260 + 4 * lane);
              const float ss = wave_sum((o.x * o.x + o.y * o.y) + (o.z * o.z + o.w * o.w)); const float rs = 1.f / sqrtf(ss * (1.f / GDV) + LN_EPS);
              const float g0 = bfl(gg[i].x), g1 = bfh(gg[i].x), g2 = bfl(gg[i].y), g3 = bfh(gg[i].y);
              v2u w; w.x = pk2(o.x * rs * gn.x * (g0 * sigmoidf_(g0)), o.y * rs * gn.y * (g1 * sigmoidf_(g1))); w.y = pk2(o.z * rs * gn.z * (g2 * sigmoidf_(g2)), o.w * rs * gn.w * (g3 * sigmoidf_(g3)));
              *(v2u*)(WSP(bf16, WS_GV) + (r0 + t) * 1024 + h * GDV + 4 * lane) = w; } }
        __syncthreads();
    }
#undef GLA_C_PREFETCH
}

__device__ __forceinline__ void phase9(Frame& F) {
    const int tid = tid_(), lane = tid & 63;
    LAS float* wr = (LAS float*)F.lds;
    LAS int* lcnt = (LAS int*)(F.lds + MISC_OFF);
    LAS int* rec_e = lcnt + 64; LAS int* rec_i = rec_e + 512; LAS float* rec_g = (LAS float*)(rec_i + 512);
    const int rows_per_blk = T / F.G, rows_per_wave = rows_per_blk / NWAVES;
    const int b = F.blk / (F.G / NB);
    for (int i = tid; i < 32 * 1024 / 4; i += NTHR) ((LAS f32x4*)wr)[i] = WSP(f32x4, WS_WRT)[i];
    if (tid < 64) lcnt[tid] = 0;
    __syncthreads();
    const float* modf = WSP(float, WS_MODF) + (size_t)b * 6144;
    const gfptr_t ln1g = PT(12), ln1b = PT(13);
    const int ei = lane >> 1; const float rb = PT(15)[ei];
    const int rl0 = F.wave * rows_per_wave, rowb = F.blk * rows_per_blk + rl0;
    f32x4 nx[2][4];
#pragma unroll
    for (int r = 0; r < 2; ++r)
#pragma unroll
        for (int j = 0; j < 4; ++j) nx[r][j] = ((const f32x4*)(F.out + (size_t)(rowb + r) * DM) + lane)[64 * j];
    for (int rr = 0; rr < rows_per_wave; rr += 2) {
        const int row = rowb + rr;
        f32x4 v[2][4];
#pragma unroll
        for (int r = 0; r < 2; ++r)
#pragma unroll
            for (int j = 0; j < 4; ++j) v[r][j] = nx[r][j];
        if (rr + 2 < rows_per_wave) {
#pragma unroll
            for (int r = 0; r < 2; ++r)
#pragma unroll
                for (int j = 0; j < 4; ++j) nx[r][j] = ((const f32x4*)(F.out + (size_t)(row + 2 + r) * DM) + lane)[64 * j]; }
        float rstd[2]; ln_center<2>(v, rstd);
#pragma unroll
        for (int r = 0; r < 2; ++r) { f32x4* zr = (f32x4*)(F.out + (size_t)(row + r) * DM) + lane;
#pragma unroll
            for (int j = 0; j < 4; ++j) { const f32x4 g = *(gf4ptr_t)(ln1g + 256 * j + 4 * lane), bb = *(gf4ptr_t)(ln1b + 256 * j + 4 * lane); v[r][j] = v[r][j] * rstd[r] * g + bb; zr[64 * j] = v[r][j]; } }
        ln_center<2>(v, rstd);
#pragma unroll
        for (int r = 0; r < 2; ++r) { unsigned long long* o8 = (unsigned long long*)(WSP(bf16, WS_U2) + (size_t)(row + r) * DM) + lane;
#pragma unroll
            for (int j = 0; j < 4; ++j) { const f32x4 sh = *(const f32x4*)(modf + 3072 + 256 * j + 4 * lane), scv = *(const f32x4*)(modf + 4096 + 256 * j + 4 * lane);
                v[r][j] = v[r][j] * rstd[r] * (scv + 1.0f) + sh;
                o8[64 * j] = (unsigned long long)pk2(v[r][j].x, v[r][j].y) | ((unsigned long long)pk2(v[r][j].z, v[r][j].w) << 32); } }
        float p0[32], p1[32]; row_dots2<32>(v, wr, lane, p0, p1);
        float lgs[2]; lgs[0] = reduce32(p0, lane) + rb; lgs[1] = reduce32(p1, lane) + rb;
#pragma unroll
        for (int r = 0; r < 2; ++r) { float lg = lgs[r]; int ek[4]; float vk[4];
#pragma unroll
            for (int k = 0; k < 4; ++k) { const float m = wave_max(lg); const unsigned long long bal = __ballot(lg == m); const int src = __ffsll((long long)bal) - 1;
                ek[k] = src >> 1; vk[k] = m; if (ei == ek[k]) lg = -INFINITY; }
            const float w1 = __expf(vk[1] - vk[0]), w2 = __expf(vk[2] - vk[0]), w3 = __expf(vk[3] - vk[0]); const float inv = 1.f / (1.f + w1 + w2 + w3);
            if (lane < 4) { const int e = lane == 0 ? ek[0] : lane == 1 ? ek[1] : lane == 2 ? ek[2] : ek[3]; const float gk = (lane == 0 ? 1.f : lane == 1 ? w1 : lane == 2 ? w2 : w3) * inv;
                const int li = atomicAdd((int*)(lcnt + e), 1); const int rl = rl0 + rr + r;
                rec_e[rl * 4 + lane] = e; rec_i[rl * 4 + lane] = li; rec_g[rl * 4 + lane] = gk; } }
    }
    __syncthreads();
    if (tid < 32) lcnt[32 + tid] = (int)atomicAdd(WSP(unsigned, WS_CTL) + tid, (unsigned)lcnt[tid]);
    __syncthreads();
    for (int r = tid; r < rows_per_blk * 4; r += NTHR) { const int e = rec_e[r], idx = lcnt[32 + e] + rec_i[r], tok = F.blk * rows_per_blk + (r >> 2);
        WSP(int, WS_RTOK)[e * ECAP + idx] = tok; WSP(int, WS_TSLOT)[(size_t)tok * 4 + (r & 3)] = e * ECAP + idx; WSP(float, WS_TGATE)[(size_t)tok * 4 + (r & 3)] = rec_g[r]; }
    __syncthreads();
}
__device__ __forceinline__ void moe_tables(Frame& F, LAS int* tstart) {
    const int tid = tid_(), lane = tid & 63; (void)lane;
    if (tid == 0) { int run = 0; for (int e = 0; e < NEXP; ++e) { tstart[e] = run; run += (int)((WSP(unsigned, WS_CTL)[e] + 255u) >> 8); } tstart[NEXP] = run; }
    __syncthreads();
}
__device__ __forceinline__ void phase12(Frame& F) {
    const int tid = tid_(), lane = tid & 63; (void)lane;
    LAS int* tstart = (LAS int*)(F.lds + MISC_OFF);
    moe_tables(F, tstart);
    const int rows_per_blk = T / F.G, rows_per_wave = rows_per_blk / NWAVES; const int b = F.blk / (F.G / NB);
    const float* modf = WSP(float, WS_MODF) + (size_t)b * 6144;
    for (int rr = 0; rr < rows_per_wave; ++rr) {
        const int row = F.blk * rows_per_blk + F.wave * rows_per_wave + rr;
        f32x4* xr = (f32x4*)(F.out + (size_t)row * DM) + lane;
        f32x4 y[4];
#pragma unroll
        for (int j = 0; j < 4; ++j) y[j] = (f32x4){0.f, 0.f, 0.f, 0.f};
#pragma unroll
        for (int k = 0; k < 4; ++k) { const int sl = WSP(int, WS_TSLOT)[(size_t)row * 4 + k]; const float gk = WSP(float, WS_TGATE)[(size_t)row * 4 + k];
            const int e = sl >> 15, idx = sl & (ECAP - 1); const size_t srow = (size_t)tstart[e] * 256 + idx;
            const v2u* mp = (const v2u*)(WSP(bf16, WS_MOE) + srow * DM) + lane;
#pragma unroll
            for (int j = 0; j < 4; ++j) { const v2u w = mp[64 * j]; y[j].x += gk * bfl(w.x); y[j].y += gk * bfh(w.x); y[j].z += gk * bfl(w.y); y[j].w += gk * bfh(w.y); } }
        f32x4 v[4]; float s = 0.f;
#pragma unroll
        for (int j = 0; j < 4; ++j) { const f32x4 g2 = *(const f32x4*)(modf + 5120 + 256 * j + 4 * lane); v[j] = xr[64 * j] * ALPHA + (g2 + 1.0f) * y[j]; s += (v[j].x + v[j].y) + (v[j].z + v[j].w); }
        const float mean = wave_sum(s) * (1.f / DM); float s2 = 0.f;
#pragma unroll
        for (int j = 0; j < 4; ++j) { v[j] = v[j] - mean; s2 += (v[j].x * v[j].x + v[j].y * v[j].y) + (v[j].z * v[j].z + v[j].w * v[j].w); }
        const float rstd = 1.f / sqrtf(wave_sum(s2) * (1.f / DM) + LN_EPS);
#pragma unroll
        for (int j = 0; j < 4; ++j) { const f32x4 g = *(gf4ptr_t)(PT(20) + 256 * j + 4 * lane), bb = *(gf4ptr_t)(PT(21) + 256 * j + 4 * lane); xr[64 * j] = v[j] * rstd * g + bb; }
    }
}

constexpr int NPHASE = 13;
__global__ void __launch_bounds__(NTHR, 2) fwd_kernel(Args args) {
    extern __shared__ __attribute__((aligned(16))) unsigned char lds[];
    Frame F;
    F.lds = (LAS unsigned char*)lds; F.wave = __builtin_amdgcn_readfirstlane((int)threadIdx.x >> 6); F.G = gridDim.x; F.blk = blockIdx.x;
    F.out = args.out; F.ws = args.ws;
    const int lo = args.ph_lo, hi = args.ph_hi;
#ifndef PROBE_PH
#define PROBE_PH (-1)
#endif
    unsigned long long tp0 = 0, tp1 = 0;
#define STAMP0(k) do { if ((k) == PROBE_PH) tp0 = __builtin_amdgcn_s_memrealtime(); } while (0)
#define STAMP1(k) do { if ((k) == PROBE_PH) tp1 = __builtin_amdgcn_s_memrealtime(); } while (0)
#ifndef PH_MASK
#define PH_MASK 0xffff
#endif
#define IN(k) (((PH_MASK >> (k)) & 1) && lo <= (k) && (k) < hi)
#if MK_N_LAUNCHES == 1
    if (threadIdx.x < 2) ((LAS unsigned*)(F.lds + BARLDS_OFF))[threadIdx.x] = 0u;
    __syncthreads();
    const XcdBarrier bar = xcd_barrier_post(WSP(unsigned, WS_CTL) + CW_BAR, (volatile LAS unsigned*)(F.lds + BARLDS_OFF));
#define SEAM(k) do { if (IN(k) && IN((k) + 1)) { if ((k) == 0) cg::this_grid().sync(); else xcd_barrier(bar); } } while (0)
#else
#define SEAM(k) do { } while (0)
#endif
    typedef pg8::bf16_t pbf;
    STAMP0(0); if (IN(0)) { phase0(F, args); } SEAM(0); STAMP1(0);
    STAMP0(1); if (IN(1)) { phase1(F, args); } SEAM(1); STAMP1(1);
    STAMP0(2); if (IN(2)) {
        pg8::Gemm g{WSP(pbf, WS_U), WSP(pbf, WS_WIN), 1024, nullptr}; pg8::DenseOrder S{T / 256, NPROJ / 256, F.G, F.blk};
        pg8::EpiInProj E{WSP(pbf, WS_FQ), WSP(pbf, WS_FK), WSP(pbf, WS_FV), WSP(pbf, WS_GQ), WSP(pbf, WS_GK), WSP(pbf, WS_GV), WSP(pbf, WS_GR), WSP(pbf, WS_GA), WSP(pbf, WS_GB), 0.125f * LOG2E, 0.08838834764831845f};
        pg8::gemm_phase<pg8::EpiInProj, pg8::DenseOrder, false, true>(F.lds, g, S, E);
    } SEAM(2); STAMP1(2);
    STAMP0(3); if (IN(3)) { phase3(F); } SEAM(3); STAMP1(3);
    STAMP0(4); if (IN(4)) {
        gla_scan(F);
        __syncthreads();
        const attn_body::AttnTensors AT{(const attn_body::bf16*)WSP(pbf, WS_FQ), (const attn_body::bf16*)WSP(pbf, WS_FK), (const attn_body::bf16*)WSP(pbf, WS_FV), (attn_body::bf16*)WSP(pbf, WS_FQ), WSP(float, WS_CUM), WSP(unsigned, WS_CTL) + CW_QKM};
        const attn_body::StaticOrder S((int)F.G, (int)F.blk);
        attn_body::attn_phase<attn_body::StaticOrder>((char*)lds, AT, S);
    } SEAM(4); STAMP1(4);
    STAMP0(5); if (IN(5)) { gla_out_phase(F); } SEAM(5); STAMP1(5);
    STAMP0(6); if (IN(6)) {
        pg8::Gemm g{WSP(pbf, WS_FQ), WSP(pbf, WS_WA), 512, nullptr}; pg8::DenseOrder S{T / 256, 4, F.G, F.blk};
        pg8::EpiGate<false> E{WSP(pbf, WS_U), WSP(pbf, WS_GA)};
        pg8::gemm_phase<pg8::EpiGate<false>, pg8::DenseOrder, false, true>(F.lds, g, S, E);
    }
    if (IN(6) && IN(7)) { __syncthreads(); } STAMP1(6);
    STAMP0(7); if (IN(7)) {
        pg8::Gemm g{WSP(pbf, WS_GV), WSP(pbf, WS_WB), 1024, nullptr}; pg8::DenseOrder S{T / 256, 4, F.G, F.blk};
        pg8::EpiGate<true> E{WSP(pbf, WS_U), WSP(pbf, WS_GB)};
        pg8::gemm_phase<pg8::EpiGate<true>, pg8::DenseOrder, false, true>(F.lds, g, S, E);
    } SEAM(7); STAMP1(7);
    STAMP0(8); if (IN(8)) {
        pg8::Gemm g{WSP(pbf, WS_U), WSP(pbf, WS_WO), 1024, nullptr}; pg8::DenseOrder S{T / 256, 4, F.G, F.blk};
        pg8::EpiResid E{PT(0), F.out, WSP(float, WS_MODF) + 2048, 6144, SEQ, ALPHA};
        pg8::gemm_phase<pg8::EpiResid, pg8::DenseOrder, false, true>(F.lds, g, S, E);
    } SEAM(8); STAMP1(8);
    STAMP0(9); if (IN(9)) { phase9(F); } SEAM(9); STAMP1(9);
    STAMP0(10); if (IN(10)) {
        LAS int* tstart = (LAS int*)(F.lds + MISC_OFF); moe_tables(F, tstart);
        pg8::Gemm g{WSP(pbf, WS_U2), WSP(pbf, WS_WUP), 1024, WSP(int, WS_RTOK)}; pg8::MoeOrder S{tstart[NEXP], 8, F.G, F.blk, tstart};
        pg8::EpiSwiglu E{WSP(pbf, WS_ACT), PT(17), 8};
        pg8::gemm_phase<pg8::EpiSwiglu, pg8::MoeOrder, true, true>(F.lds, g, S, E);
    } SEAM(10); STAMP1(10);
    STAMP0(11); if (IN(11)) {
        LAS int* tstart = (LAS int*)(F.lds + MISC_OFF); moe_tables(F, tstart);
        pg8::Gemm g{WSP(pbf, WS_ACT), WSP(pbf, WS_WDN), 1024, nullptr}; pg8::MoeOrder S{tstart[NEXP], 4, F.G, F.blk, tstart};
        pg8::EpiDown E{WSP(pbf, WS_MOE), PT(19), 4};
        pg8::gemm_phase<pg8::EpiDown, pg8::MoeOrder, false, true>(F.lds, g, S, E);
    } SEAM(11); STAMP1(11);
    STAMP0(12); if (IN(12)) { phase12(F); } STAMP1(12);
    if (PROBE_PH >= 0 && F.blk == 0) { const unsigned long long te = __builtin_amdgcn_s_memrealtime(), dd = 9ull * (tp1 - tp0); while (__builtin_amdgcn_s_memrealtime() - te < dd) __builtin_amdgcn_s_sleep(32); }
#undef IN
#undef SEAM
}

extern "C" void kernel_launch(void* const* d_in, const int* in_sizes, int n_in, void* d_out, int out_size, void* d_ws, size_t ws_size, hipStream_t stream) {
    static int grid = 0;
    if (grid == 0) {
        if (n_in != 22 || in_sizes[0] != T * DM || out_size != T * DM || ws_size < WS_END) { fprintf(stderr, "kernel_launch: unexpected shapes (n_in %d, x %d, out %d, ws %zu < %zu); nothing launched\n", n_in, n_in > 0 ? in_sizes[0] : -1, out_size, ws_size, (size_t)WS_END); grid = -1; return; }
        int dev = 0, cus = 0, per_cu = 0;
        if (hipGetDevice(&dev) != hipSuccess || hipDeviceGetAttribute(&cus, hipDeviceAttributeMultiprocessorCount, dev) != hipSuccess) { grid = -1; return; }
        if (hipFuncSetAttribute((const void*)fwd_kernel, hipFuncAttributeMaxDynamicSharedMemorySize, LDS_BYTES) != hipSuccess) { fprintf(stderr, "kernel_launch: hipFuncSetAttribute failed\n"); grid = -1; return; }
        if (hipOccupancyMaxActiveBlocksPerMultiprocessor(&per_cu, (const void*)fwd_kernel, NTHR, LDS_BYTES) != hipSuccess || per_cu < 1) { fprintf(stderr, "kernel_launch: occupancy query says %d blocks per CU\n", per_cu); (void)hipGetLastError(); grid = -1; return; }
        grid = cus;
        if (grid != 256) { fprintf(stderr, "kernel_launch: built for a 256-CU device, found %d CUs; nothing launched\n", cus); grid = -1; return; }
    }
    if (grid < 0) return;
    if (hipMemsetAsync((char*)d_ws + WS_CTL, 0, CTL_ZERO_BYTES, stream) != hipSuccess) { fprintf(stderr, "kernel_launch: hipMemsetAsync failed\n"); return; }
    Args a{};
    for (int i = 0; i < 22; ++i) a.in[i] = (const float*)d_in[i];
    a.out = (float*)d_out; a.ws = (unsigned char*)d_ws;
#if MK_N_LAUNCHES == 1
    a.ph_lo = 0; a.ph_hi = NPHASE;
    void* kargs[] = {&a};
    hipError_t e = hipLaunchCooperativeKernel((const void*)fwd_kernel, dim3(grid), dim3(NTHR), kargs, LDS_BYTES, stream);
    if (e != hipSuccess) fprintf(stderr, "kernel_launch: cooperative launch failed: %s\n", hipGetErrorString(e));
#else
    for (int p = 0; p < NPHASE; ++p) {
        if (p == 7) continue;
        a.ph_lo = p; a.ph_hi = (p == 6) ? 8 : p + 1;
        hipLaunchKernelGGL(fwd_kernel, dim3(grid), dim3(NTHR), LDS_BYTES, stream, a);
    }
#endif
}
```

```cpp
#include <hip/hip_runtime.h>
#include <hip/hip_bf16.h>
#include <hip/hip_cooperative_groups.h>
#include <cstdio>
#include <cstdint>
#include <cmath>
namespace cg = cooperative_groups;

#ifndef MK_N_LAUNCHES
#define MK_N_LAUNCHES 1
#endif

namespace pg8 {
#define PG8_LAS __attribute__((address_space(3)))
#define PG8_GAS __attribute__((address_space(1)))
typedef unsigned short bf16_t;
typedef short bf16x8 __attribute__((ext_vector_type(8)));
typedef float f32x4 __attribute__((ext_vector_type(4)));
typedef float f32x2 __attribute__((ext_vector_type(2)));
typedef unsigned u32x4 __attribute__((ext_vector_type(4)));
constexpr int BM = 256, BK = 64, HALF = 128, HTB = HALF * BK * 2, STAGE_BYTES = 8 * HTB, NXCD = 8, WGM = 8;

__host__ __device__ __forceinline__ int lds_byte(int r, int c) { const int st = (r >> 4) * 2 + (c >> 5), rr = r & 15, cc = c & 31, ob = rr * 64 + cc * 2; return st * 1024 + (ob ^ (((ob >> 9) & 1) << 5)); }
__host__ __device__ __forceinline__ void stage_rc(int b, int& R, int& C) { const int st = b / 1024, sb = b % 1024, swz = sb ^ (((sb >> 9) & 1) << 5); R = (st >> 1) * 16 + swz / 64; C = (st & 1) * 32 + (swz % 64) / 2; }
__host__ __device__ __forceinline__ int perm32(int rho) { const int n = rho >> 4, i = rho & 15; return 8 * (i >> 2) + 4 * n + (i & 3); }

struct Unit { int pm, pn, e, rl; };
struct Gemm { const bf16_t* A; const bf16_t* Bt; int K; const int* rows; int sclA, sclB; };
typedef int v8i_t __attribute__((ext_vector_type(8)));

__device__ __forceinline__ bool tile_of(long L, int nM, int nN, int& pm, int& pn) {
    const int nwg = nM * nN; if (L >= nwg) return false;
    int wgid = (int)L; { const int q = nwg / NXCD, r = nwg % NXCD, xcd = wgid % NXCD, off = wgid / NXCD; wgid = (xcd < r ? xcd * (q + 1) : r * (q + 1) + (xcd - r) * q) + off; }
    const int nig = WGM * nN, gid = wgid / nig, fm = gid * WGM, gsz = (nM - fm) < WGM ? (nM - fm) : WGM;
    pm = fm + ((wgid % nig) % gsz); pn = (wgid % nig) / gsz; return true;
}
struct DenseOrder {
    int nM, nN, G, c;
    __device__ __forceinline__ bool next(int i, Unit& u) const { u.e = 0; u.rl = 0; return tile_of((long)i * G + c, nM, nN, u.pm, u.pn); }
};
struct MoeOrder {
    int nM, nN, G, c; const PG8_LAS int* tstart;
    __device__ __forceinline__ bool next(int i, Unit& u) const {
        int rt, pnl; if (!tile_of((long)i * G + c, nM, nN, rt, pnl)) return false;
        int e = 0;
#pragma unroll 1
        for (int j = 1; j < 32; ++j) if (tstart[j] <= rt) e = j;
        u.pm = rt; u.e = e; u.pn = e * nN + pnl; u.rl = e * 32768 + (rt - tstart[e]) * 256; return true;
    }
};

__device__ __forceinline__ unsigned cvt_pk_bf16(float lo, float hi) { unsigned r; asm volatile("v_cvt_pk_bf16_f32 %0, %1, %2" : "=v"(r) : "v"(lo), "v"(hi)); return r; }
__device__ __forceinline__ float bf_lo(unsigned w) { return __uint_as_float(w << 16); }
__device__ __forceinline__ float bf_hi(unsigned w) { return __uint_as_float(w & 0xffff0000u); }
__device__ __forceinline__ float sigm(float x) { return 1.0f / (1.0f + __expf(-x)); }


struct EpiInProj {
    static constexpr bool PERM = true;
    bf16_t *fq, *fk, *fv, *gq, *gk, *gv, *gr, *ga, *gb; float qscale, gqscale;
    __device__ __forceinline__ void operator()(const f32x4 (&acc)[2][2][4][2], const Unit& u, int wr, int wc, int fr, int fq_) const {
        const int pn = u.pn; bf16_t* base; int ldc, ct; float sc = 1.f; bool sg = false;
        if (pn < 2) { base = fq; ldc = 512; ct = pn; sc = qscale; } else if (pn < 4) { base = fk; ldc = 512; ct = pn - 2; } else if (pn < 6) { base = fv; ldc = 512; ct = pn - 4; }
        else if (pn < 8) { base = gq; ldc = 512; ct = pn - 6; sc = gqscale; } else if (pn < 10) { base = gk; ldc = 512; ct = pn - 8; }
        else if (pn < 14) { base = gv; ldc = 1024; ct = pn - 10; } else if (pn < 18) { base = gr; ldc = 1024; ct = pn - 14; }
        else if (pn < 22) { base = ga; ldc = 1024; ct = pn - 18; sg = true; } else { base = gb; ldc = 1024; ct = pn - 22; sg = true; }
        const int row0 = u.pm * BM + wr * 64 + fr, col0 = ct * BM + wc * 32 + 8 * fq_;
#pragma unroll
        for (int ai = 0; ai < 2; ++ai)
#pragma unroll
            for (int m = 0; m < 4; ++m) { bf16_t* rowp = base + (size_t)(row0 + ai * HALF + m * 16) * ldc + col0;
#pragma unroll
                for (int bj = 0; bj < 2; ++bj) { f32x4 v0 = acc[ai][bj][m][0], v1 = acc[ai][bj][m][1];
                    if (sg) {
#pragma unroll
                        for (int i = 0; i < 4; ++i) { v0[i] = sigm(v0[i]); v1[i] = sigm(v1[i]); } }
                    else { v0 = v0 * sc; v1 = v1 * sc; }
                    u32x4 w; w.x = cvt_pk_bf16(v0[0], v0[1]); w.y = cvt_pk_bf16(v0[2], v0[3]); w.z = cvt_pk_bf16(v1[0], v1[1]); w.w = cvt_pk_bf16(v1[2], v1[3]);
                    *(u32x4*)(rowp + bj * HALF) = w; } }
    }
};
template <bool ADD> struct EpiGate {
    static constexpr bool PERM = true;
    bf16_t* O; const bf16_t* gate;
    __device__ __forceinline__ void operator()(const f32x4 (&acc)[2][2][4][2], const Unit& u, int wr, int wc, int fr, int fq_) const {
        const int row0 = u.pm * BM + wr * 64 + fr, col0 = u.pn * BM + wc * 32 + 8 * fq_;
#pragma unroll
        for (int ai = 0; ai < 2; ++ai)
#pragma unroll
            for (int m = 0; m < 4; ++m) { const size_t off = (size_t)(row0 + ai * HALF + m * 16) * 1024 + col0;
#pragma unroll
                for (int bj = 0; bj < 2; ++bj) { const f32x4 a0 = acc[ai][bj][m][0], a1 = acc[ai][bj][m][1];
                    const u32x4 g = *(const u32x4*)(gate + off + bj * HALF);
                    float r[8] = { a0[0] * bf_lo(g.x), a0[1] * bf_hi(g.x), a0[2] * bf_lo(g.y), a0[3] * bf_hi(g.y), a1[0] * bf_lo(g.z), a1[1] * bf_hi(g.z), a1[2] * bf_lo(g.w), a1[3] * bf_hi(g.w) };
                    if (ADD) { const u32x4 o = *(const u32x4*)(O + off + bj * HALF);
                        r[0] += bf_lo(o.x); r[1] += bf_hi(o.x); r[2] += bf_lo(o.y); r[3] += bf_hi(o.y); r[4] += bf_lo(o.z); r[5] += bf_hi(o.z); r[6] += bf_lo(o.w); r[7] += bf_hi(o.w); }
                    u32x4 w; w.x = cvt_pk_bf16(r[0], r[1]); w.y = cvt_pk_bf16(r[2], r[3]); w.z = cvt_pk_bf16(r[4], r[5]); w.w = cvt_pk_bf16(r[6], r[7]);
                    *(u32x4*)(O + off + bj * HALF) = w; } }
    }
};
struct EpiResid {
    static constexpr bool PERM = false;
    const PG8_GAS float* x; float* z; const float* g1; int g1_bstride; int rows_per_batch; float alpha;
    __device__ __forceinline__ void operator()(const f32x4 (&acc)[2][2][4][2], const Unit& u, int wr, int wc, int fr, int fq_) const {
        const int row0 = u.pm * BM + wr * 64 + fr, col0 = u.pn * BM + wc * 32 + 4 * fq_;
        const float* gp = g1 + (size_t)((u.pm * BM) / rows_per_batch) * g1_bstride + col0;
        f32x4 gv[2][2];
#pragma unroll
        for (int bj = 0; bj < 2; ++bj)
#pragma unroll
            for (int n = 0; n < 2; ++n) gv[bj][n] = *(const f32x4*)(gp + bj * HALF + n * 16) + 1.0f;
#pragma unroll
        for (int ai = 0; ai < 2; ++ai)
#pragma unroll
            for (int m = 0; m < 4; ++m) { const size_t off = (size_t)(row0 + ai * HALF + m * 16) * 1024 + col0;
#pragma unroll
                for (int bj = 0; bj < 2; ++bj)
#pragma unroll
                    for (int n = 0; n < 2; ++n) { const f32x4 xv = *(const PG8_GAS f32x4*)(x + off + bj * HALF + n * 16);
                        *(f32x4*)(z + off + bj * HALF + n * 16) = xv * alpha + gv[bj][n] * acc[ai][bj][m][n]; } }
    }
};
template <bool OUT8> struct EpiSwiglu {
    static constexpr bool PERM = true;
    bf16_t* act; const PG8_GAS float* b_up; int nNe;
    __device__ __forceinline__ void operator()(const f32x4 (&acc)[2][2][4][2], const Unit& u, int wr, int wc, int fr, int fq_) const {
        const int pnl = u.pn - u.e * nNe; const int row0 = u.pm * BM + wr * 64 + fr, cl = pnl * HALF + wc * 32 + 8 * fq_;
        const PG8_GAS float* bp = b_up + (size_t)u.e * 2048 + cl;
        const f32x4 bg0 = *(const PG8_GAS f32x4*)(bp), bg1 = *(const PG8_GAS f32x4*)(bp + 4), bl0 = *(const PG8_GAS f32x4*)(bp + 1024), bl1 = *(const PG8_GAS f32x4*)(bp + 1028);
#pragma unroll
        for (int ai = 0; ai < 2; ++ai)
#pragma unroll
            for (int m = 0; m < 4; ++m) {
                f32x4 g0 = acc[ai][0][m][0] + bg0, g1 = acc[ai][0][m][1] + bg1, l0 = acc[ai][1][m][0] + bl0, l1 = acc[ai][1][m][1] + bl1; float r[8];
#pragma unroll
                for (int i = 0; i < 4; ++i) { float g = fminf(g0[i], 7.0f), l = fminf(fmaxf(l0[i], -7.0f), 7.0f); r[i] = g * sigm(1.702f * g) * (l + 1.0f);
                    g = fminf(g1[i], 7.0f); l = fminf(fmaxf(l1[i], -7.0f), 7.0f); r[4 + i] = g * sigm(1.702f * g) * (l + 1.0f); }
                if constexpr (OUT8) { int w0 = 0, w1 = 0; w0 = __builtin_amdgcn_cvt_pk_fp8_f32(r[0], r[1], w0, false); w0 = __builtin_amdgcn_cvt_pk_fp8_f32(r[2], r[3], w0, true);
                    w1 = __builtin_amdgcn_cvt_pk_fp8_f32(r[4], r[5], w1, false); w1 = __builtin_amdgcn_cvt_pk_fp8_f32(r[6], r[7], w1, true);
                    typedef int v2i_t __attribute__((ext_vector_type(2)));
                    *(v2i_t*)((unsigned char*)act + (size_t)(row0 + ai * HALF + m * 16) * 1024 + cl) = (v2i_t){w0, w1}; }
                else { u32x4 w; w.x = cvt_pk_bf16(r[0], r[1]); w.y = cvt_pk_bf16(r[2], r[3]); w.z = cvt_pk_bf16(r[4], r[5]); w.w = cvt_pk_bf16(r[6], r[7]);
                    *(u32x4*)(act + (size_t)(row0 + ai * HALF + m * 16) * 1024 + cl) = w; } }
    }
};
struct EpiDown {
    static constexpr bool PERM = true;
    bf16_t* O; const PG8_GAS float* b_down; int nNe;
    __device__ __forceinline__ void operator()(const f32x4 (&acc)[2][2][4][2], const Unit& u, int wr, int wc, int fr, int fq_) const {
        const int pnl = u.pn - u.e * nNe; const int row0 = u.pm * BM + wr * 64 + fr, col0 = pnl * BM + wc * 32 + 8 * fq_;
        const PG8_GAS float* bp = b_down + (size_t)u.e * 1024 + col0;
        f32x4 bv[2][2];
#pragma unroll
        for (int bj = 0; bj < 2; ++bj)
#pragma unroll
            for (int n = 0; n < 2; ++n) bv[bj][n] = *(const PG8_GAS f32x4*)(bp + bj * HALF + 4 * n);
#pragma unroll
        for (int ai = 0; ai < 2; ++ai)
#pragma unroll
            for (int m = 0; m < 4; ++m) { bf16_t* rowp = O + (size_t)(row0 + ai * HALF + m * 16) * 1024 + col0;
#pragma unroll
                for (int bj = 0; bj < 2; ++bj) { const f32x4 v0 = acc[ai][bj][m][0] + bv[bj][0], v1 = acc[ai][bj][m][1] + bv[bj][1];
                    u32x4 w; w.x = cvt_pk_bf16(v0[0], v0[1]); w.y = cvt_pk_bf16(v0[2], v0[3]); w.z = cvt_pk_bf16(v1[0], v1[1]); w.w = cvt_pk_bf16(v1[2], v1[3]);
                    *(u32x4*)(rowp + bj * HALF) = w; } }
    }
};

template <class Epi, class Sched, bool GATHER, bool ALIGN_EPI, bool FP8 = false>
__device__ __forceinline__ void gemm_phase(PG8_LAS unsigned char* lds, const Gemm g, const Sched& S, const Epi& E) {
    int tid_l = threadIdx.x; asm volatile("" : "+v"(tid_l));
    const int tid = tid_l, wid = __builtin_amdgcn_readfirstlane(tid >> 6), lane = tid & 63, wr = wid >> 2, wc = wid & 3, fr = lane & 15, fq = lane >> 4;
    const int K = g.K, nt = K / BK;
    unsigned voffB[2], vA0[2], vA1[2], nA0[2], nA1[2];
#pragma unroll
    for (int i = 0; i < 2; ++i) { int R, C; stage_rc(tid * 16 + i * 8192, R, C); const int Rb = Epi::PERM ? ((R & ~31) + perm32(R & 31)) : R;
        voffB[i] = (unsigned)(Rb * K + C) * 2u; vA0[i] = vA1[i] = nA0[i] = nA1[i] = (unsigned)(R * K + C) * 2u; }
    const size_t kstep = (size_t)(BK * 2);
    const size_t hstep = (size_t)HALF * K * 2;
    const size_t tstep = 2 * hstep;
    const size_t hsA = GATHER ? 0 : hstep;
    const unsigned ldsw = (unsigned)wid * 1024u;
    const int aoff = lds_byte(wr * 64 + fr, fq * 8), boff = lds_byte(wc * 32 + fr, fq * 8);
#define PG8_SA(b, h) (((b) * 2 + (h)) * HTB)
#define PG8_SB(b, h) ((4 + (b) * 2 + (h)) * HTB)
#define PG8_STAGE(bufoff, gbase, voff) do { _Pragma("unroll") for (int _i = 0; _i < 2; ++_i) \
        __builtin_amdgcn_global_load_lds((const unsigned*)((const char*)(gbase) + (voff)[_i]), (PG8_LAS unsigned*)(lds + (bufoff) + ldsw + _i * 8192), 16, 0, 0); } while (0)
#define PG8_LD8(dst8, addr) do { const u32x4 lo_ = *(const PG8_LAS u32x4*)(addr), hi_ = *(const PG8_LAS u32x4*)((addr) + 1024); \
        dst8 = (v8i_t){(int)lo_[0], (int)lo_[1], (int)lo_[2], (int)lo_[3], (int)hi_[0], (int)hi_[1], (int)hi_[2], (int)hi_[3]}; } while (0)
#define PG8_LDA(dst, b, h) do { if constexpr (FP8) { _Pragma("unroll") for (int m = 0; m < 4; ++m) PG8_LD8(dst##8[m], lds + PG8_SA(b, h) + aoff + m * 2048); } \
        else { _Pragma("unroll") for (int m = 0; m < 4; ++m) _Pragma("unroll") for (int k = 0; k < 2; ++k) dst[m][k] = *(const PG8_LAS bf16x8*)(lds + PG8_SA(b, h) + aoff + m * 2048 + k * 1024); } } while (0)
#define PG8_LDB(dst, b, h) do { if constexpr (FP8) { _Pragma("unroll") for (int n = 0; n < 2; ++n) PG8_LD8(dst##8[n], lds + PG8_SB(b, h) + boff + n * 2048); } \
        else { _Pragma("unroll") for (int n = 0; n < 2; ++n) _Pragma("unroll") for (int k = 0; k < 2; ++k) dst[n][k] = *(const PG8_LAS bf16x8*)(lds + PG8_SB(b, h) + boff + n * 2048 + k * 1024); } } while (0)
#define PG8_MMA(ai, bj, At, Bt) do { __builtin_amdgcn_s_setprio(1); \
        if constexpr (FP8) { _Pragma("unroll") for (int m = 0; m < 4; ++m) { _Pragma("unroll") for (int n = 0; n < 2; ++n) \
              \
            asm volatile("v_mfma_scale_f32_16x16x128_f8f6f4 %0, %1, %2, %0, %3, %4 op_sel_hi:[0,0,0]" : "+v"(acc[ai][bj][m][n]) : "v"(Bt##8[n]), "v"(At##8[m]), "v"(sclB_v), "v"(sclA_v)); } } \
        else { _Pragma("unroll") for (int m = 0; m < 4; ++m) _Pragma("unroll") for (int n = 0; n < 2; ++n) _Pragma("unroll") for (int k = 0; k < 2; ++k) \
            acc[ai][bj][m][n] = __builtin_amdgcn_mfma_f32_16x16x32_bf16(Bt[n][k], At[m][k], acc[ai][bj][m][n], 0, 0, 0); } \
        __builtin_amdgcn_s_setprio(0); } while (0)
#define PG8_WAIT_V(n) asm volatile("s_waitcnt vmcnt(" #n ")" ::: "memory")
#define PG8_WAIT_L(n) asm volatile("s_waitcnt lgkmcnt(" #n ")" ::: "memory")
#define PG8_BAR __builtin_amdgcn_s_barrier()
#define PG8_SCHED __builtin_amdgcn_sched_barrier(0)
#define PG8_GOFFS(u, o0, o1) do { if constexpr (GATHER) { _Pragma("unroll") for (int _i = 0; _i < 2; ++_i) { int R_, C_; stage_rc(tid * 16 + _i * 8192, R_, C_); \
        const int t0_ = g.rows[(u).rl + R_], t1_ = g.rows[(u).rl + HALF + R_]; \
        o0[_i] = (unsigned)(t0_ * K + C_) * 2u; o1[_i] = (unsigned)(t1_ * K + C_) * 2u; } } } while (0)
    Unit cur, nxt; int ui = 0;
    if (!S.next(0, cur)) return;
    f32x4 acc[2][2][4][2];
#pragma unroll
    for (int a = 0; a < 2; ++a)
#pragma unroll
        for (int b = 0; b < 2; ++b)
#pragma unroll
            for (int m = 0; m < 4; ++m)
#pragma unroll
                for (int n = 0; n < 2; ++n) acc[a][b][m][n] = (f32x4){0.f, 0.f, 0.f, 0.f};
    bf16x8 At[4][2], B0[2][2], B1[2][2]; v8i_t At8[4], B08[2], B18[2]; const int sclA_v = g.sclA, sclB_v = g.sclB; (void)sclA_v; (void)sclB_v;
    const char* cA = (const char*)g.A + (GATHER ? (size_t)0 : (size_t)cur.pm * tstep); const char* cB = (const char*)g.Bt + (size_t)cur.pn * tstep;
    PG8_GOFFS(cur, vA0, vA1);
    PG8_STAGE(PG8_SB(0, 0), cB, voffB); PG8_STAGE(PG8_SB(0, 1), cB + hstep, voffB); PG8_STAGE(PG8_SA(0, 0), cA, vA0); PG8_STAGE(PG8_SA(0, 1), cA + hsA, vA1);
    if (wr == 1) PG8_BAR;
    PG8_WAIT_V(2); PG8_BAR;
    PG8_STAGE(PG8_SB(1, 0), cB + kstep, voffB); PG8_STAGE(PG8_SA(1, 0), cA + kstep, vA0); PG8_STAGE(PG8_SB(1, 1), cB + hstep + kstep, voffB);
    PG8_WAIT_V(6); PG8_BAR;
    for (;;) {
        const bool has_next = S.next(ui + 1, nxt);
        const char* nA = has_next ? (const char*)g.A + (GATHER ? (size_t)0 : (size_t)nxt.pm * tstep) : cA; const char* nB = has_next ? (const char*)g.Bt + (size_t)nxt.pn * tstep : cB;
        if constexpr (GATHER) { if (has_next) { PG8_GOFFS(nxt, nA0, nA1); } else {
#pragma unroll
            for (int i = 0; i < 2; ++i) { nA0[i] = vA0[i]; nA1[i] = vA1[i]; } } }
        for (int t = 0; t < nt; t += 2) {
            const bool last = (t == nt - 2);
            const char* a1 = cA + (size_t)(t + 1) * kstep;
            const char* a2 = last ? nA : cA + (size_t)(t + 2) * kstep; const char* b2 = last ? nB : cB + (size_t)(t + 2) * kstep;
            const char* a3 = a2 + kstep; const char* b3 = b2 + kstep;
            unsigned s0[2], s1[2];
#pragma unroll
            for (int i = 0; i < 2; ++i) { s0[i] = (GATHER && last) ? nA0[i] : vA0[i]; s1[i] = (GATHER && last) ? nA1[i] : vA1[i]; }
            PG8_LDB(B0, 0, 0); PG8_LDB(B1, 0, 1); PG8_SCHED; PG8_LDA(At, 0, 0); PG8_STAGE(PG8_SA(1, 1), a1 + hsA, vA1);
            PG8_WAIT_V(8); PG8_WAIT_L(0); PG8_BAR; PG8_MMA(0, 0, At, B0); PG8_MMA(0, 1, At, B1); PG8_BAR; PG8_SCHED;
            PG8_LDA(At, 0, 1); PG8_STAGE(PG8_SB(0, 0), b2, voffB); PG8_STAGE(PG8_SB(0, 1), b2 + hstep, voffB); PG8_STAGE(PG8_SA(0, 0), a2, s0);
            PG8_WAIT_V(8); PG8_WAIT_L(0); PG8_BAR; PG8_MMA(1, 0, At, B0); PG8_MMA(1, 1, At, B1); PG8_BAR; PG8_SCHED;
            PG8_LDB(B0, 1, 0); PG8_LDB(B1, 1, 1); PG8_SCHED; PG8_LDA(At, 1, 0); PG8_STAGE(PG8_SA(0, 1), a2 + hsA, s1);
            PG8_WAIT_V(8); PG8_WAIT_L(0); PG8_BAR; PG8_MMA(0, 0, At, B0); PG8_MMA(0, 1, At, B1); PG8_BAR; PG8_SCHED;
            PG8_LDA(At, 1, 1); PG8_STAGE(PG8_SB(1, 0), b3, voffB); PG8_STAGE(PG8_SB(1, 1), b3 + hstep, voffB); PG8_STAGE(PG8_SA(1, 0), a3, s0);
            PG8_WAIT_V(8); PG8_WAIT_L(0); PG8_BAR; PG8_MMA(1, 0, At, B0); PG8_MMA(1, 1, At, B1); PG8_BAR; PG8_SCHED;
        }
        if constexpr (ALIGN_EPI) { if (wr == 0) PG8_BAR; }
        if constexpr (FP8) {
#pragma unroll
            for (int a = 0; a < 2; ++a)
#pragma unroll
                for (int b = 0; b < 2; ++b) asm volatile("s_nop 15\n\ts_nop 7" : "+v"(acc[a][b][0][0]), "+v"(acc[a][b][0][1]), "+v"(acc[a][b][1][0]), "+v"(acc[a][b][1][1]), "+v"(acc[a][b][2][0]), "+v"(acc[a][b][2][1]), "+v"(acc[a][b][3][0]), "+v"(acc[a][b][3][1])); }
        E(acc, cur, wr, wc, fr, fq);
        if (!has_next) break;
#pragma unroll
        for (int a = 0; a < 2; ++a)
#pragma unroll
            for (int b = 0; b < 2; ++b)
#pragma unroll
                for (int m = 0; m < 4; ++m)
#pragma unroll
                    for (int n = 0; n < 2; ++n) acc[a][b][m][n] = (f32x4){0.f, 0.f, 0.f, 0.f};
        cur = nxt; cA = nA; cB = nB; ++ui;
        if constexpr (GATHER) {
#pragma unroll
            for (int i = 0; i < 2; ++i) { vA0[i] = nA0[i]; vA1[i] = nA1[i]; } }
        if constexpr (ALIGN_EPI) { if (wr == 1) PG8_BAR; }
    }
    PG8_WAIT_V(0);
    if constexpr (!ALIGN_EPI) { if (wr == 0) PG8_BAR; }
    PG8_BAR;
#undef PG8_SA
#undef PG8_SB
#undef PG8_STAGE
#undef PG8_LDA
#undef PG8_LDB
#undef PG8_MMA
#undef PG8_LD8
#undef PG8_WAIT_V
#undef PG8_WAIT_L
#undef PG8_BAR
#undef PG8_SCHED
#undef PG8_GOFFS
}
}
#include <hip/hip_bf16.h>
#include <cmath>
namespace attn_body {
using bf16=__hip_bfloat16;
using bf16x8=__attribute__((ext_vector_type(8)))short;
using s16x4=__attribute__((ext_vector_type(4)))short;
using f32x16=__attribute__((ext_vector_type(16)))float;
using u32x4=__attribute__((ext_vector_type(4)))unsigned;
constexpr int BATCH=4,NHEAD=8,SEQ=8192,D=64,DM=NHEAD*D;
constexpr int NW=8,QBLK=32,QB=QBLK*NW,KVBLK=64,NQB=SEQ/QB;
constexpr int ATTN_PITCH=DM, ATTN_UNIT_ROWS=QB;
__device__ __forceinline__ int crow(int r,int hi){return (r&3)+8*(r>>2)+4*hi;}
#define SBAR() __builtin_amdgcn_sched_barrier(0)
__device__ __forceinline__ void cmask(f32x16&p0,f32x16&p1,int jb,int qrel,int hi){
  const float NEG=-INFINITY; int kb=64*jb+4*hi;
  #pragma unroll
  for(int r=0;r<16;++r){int kv=kb+(r&3)+8*(r>>2); if(kv>qrel)p0[r]=NEG; if(kv+32>qrel)p1[r]=NEG;}
}

constexpr int NSLOT=3, SLOTB=8192;
constexpr int LDS_K=0, LDS_V=NSLOT*SLOTB, LDS_WS=2*NSLOT*SLOTB, LDS_OST=LDS_WS+NW*64*4, LDS_CUM=LDS_OST+NW*4096, LDS_BYTES=LDS_CUM+SEQ*4;
constexpr float C2=0.125f*1.4426950408889634f;
__device__ __forceinline__ void glds16(const void*gsrc,unsigned lds_dst){unsigned keep;
  asm volatile("s_mov_b32 %0, m0\n\ts_mov_b32 m0, %2\n\ts_nop 0\n\tglobal_load_lds_dwordx4 %1, off\n\ts_mov_b32 m0, %0":"=&s"(keep):"v"(gsrc),"s"(lds_dst):"memory");}
__device__ __forceinline__ float max3f(float a,float b,float c){float r;asm("v_max3_f32 %0, %1, %2, %3":"=v"(r):"v"(a),"v"(b),"v"(c));return r;}
__device__ __forceinline__ float max2f(float a,float b){float r;asm("v_max_f32_e32 %0, %1, %2":"=v"(r):"v"(a),"v"(b));return r;}
__device__ __forceinline__ float fadd_s(float a,float b){float r;asm("v_add_f32_e32 %0, %1, %2":"=v"(r):"v"(a),"v"(b));return r;}
__device__ __forceinline__ float fsub_s(float a,float b){float r;asm("v_sub_f32_e32 %0, %1, %2":"=v"(r):"v"(a),"v"(b));return r;}
typedef float f32x2_t __attribute__((ext_vector_type(2))); typedef __bf16 bf16x2_t __attribute__((ext_vector_type(2)));
__device__ __forceinline__ unsigned cvtpk_s(float lo,float hi){f32x2_t v={lo,hi};bf16x2_t b=__builtin_convertvector(v,bf16x2_t);return __builtin_bit_cast(unsigned,b);}
#define WAIT_BAR(N) asm volatile("s_waitcnt vmcnt(" #N ") lgkmcnt(0)\n\ts_barrier":::"memory")

typedef __attribute__((address_space(3))) const float* lds_fptr;
typedef float f32x4a __attribute__((ext_vector_type(4)));
__device__ __forceinline__ void ckinit(f32x16&c0,f32x16&c1,lds_fptr ck,float nm,int hi){
  #pragma unroll
  for(int g=0;g<4;++g){
    const f32x4a a=*(const __attribute__((address_space(3))) f32x4a*)(ck+8*g+4*hi);
    const f32x4a b=*(const __attribute__((address_space(3))) f32x4a*)(ck+32+8*g+4*hi);
    c0[4*g+0]=nm-a[0];c0[4*g+1]=nm-a[1];c0[4*g+2]=nm-a[2];c0[4*g+3]=nm-a[3];
    c1[4*g+0]=nm-b[0];c1[4*g+1]=nm-b[1];c1[4*g+2]=nm-b[2];c1[4*g+3]=nm-b[3];}
}
__device__ __forceinline__ void qkt(f32x16&p0,f32x16&p1,const char*Kslot,const bf16x8*qr,lds_fptr ck,float nm,int r32,int hi){
  const char*kb=Kslot+hi*1024+r32*16;
  ckinit(p0,p1,ck,nm,hi);
  #pragma unroll
  for(int d0=0;d0<4;++d0){
    const bf16x8 b0=*reinterpret_cast<const bf16x8*>(kb+d0*2048);
    const bf16x8 b1=*reinterpret_cast<const bf16x8*>(kb+d0*2048+512);
    p0=__builtin_amdgcn_mfma_f32_32x32x16_bf16(b0,qr[d0],p0,0,0,0);p1=__builtin_amdgcn_mfma_f32_32x32x16_bf16(b1,qr[d0],p1,0,0,0);}
}
typedef __attribute__((address_space(3))) const char* lds_cptr;
typedef short v4i16_t __attribute__((ext_vector_type(4)));
__device__ __forceinline__ void kload8(bf16x8*kf,lds_cptr kp){
  kf[0]=*(const __attribute__((address_space(3))) bf16x8*)(kp);      kf[1]=*(const __attribute__((address_space(3))) bf16x8*)(kp+512);
  kf[2]=*(const __attribute__((address_space(3))) bf16x8*)(kp+2048); kf[3]=*(const __attribute__((address_space(3))) bf16x8*)(kp+2560);
  kf[4]=*(const __attribute__((address_space(3))) bf16x8*)(kp+4096); kf[5]=*(const __attribute__((address_space(3))) bf16x8*)(kp+4608);
  kf[6]=*(const __attribute__((address_space(3))) bf16x8*)(kp+6144); kf[7]=*(const __attribute__((address_space(3))) bf16x8*)(kp+6656);
}
__device__ __forceinline__ void kload2(bf16x8*kf,lds_cptr kp,int j){ kf[2*j]=*(const __attribute__((address_space(3))) bf16x8*)(kp+j*2048); kf[2*j+1]=*(const __attribute__((address_space(3))) bf16x8*)(kp+j*2048+512); }
__device__ __forceinline__ s16x4 vtr(lds_cptr p){ return __builtin_bit_cast(s16x4,__builtin_amdgcn_ds_read_tr16_b64_v4i16((__attribute__((address_space(3))) v4i16_t*)p)); }
__device__ __forceinline__ float rowmax(const f32x16&p0,const f32x16&p1){
  float a=max3f(p0[0],p0[1],p1[0]),b=max3f(p0[2],p0[3],p1[1]);a=max3f(a,p1[2],p1[3]);
  #pragma unroll
  for(int r=4;r<16;r+=4){a=max3f(a,p0[r],p0[r+1]);b=max3f(b,p0[r+2],p0[r+3]);a=max3f(a,p1[r],p1[r+1]);b=max3f(b,p1[r+2],p1[r+3]);}
  const float m=max2f(a,b);
  auto rr=__builtin_amdgcn_permlane32_swap(__float_as_uint(m),__float_as_uint(m),false,false);
  return max2f(__uint_as_float(rr[0]),__uint_as_float(rr[1]));
}
__device__ __forceinline__ void pv(f32x16*o,int vb,bf16x8 pa0,bf16x8 pa1,bf16x8 pa2,bf16x8 pa3){
  #pragma unroll
  for(int d0=0;d0<2;++d0){s16x4 lo[4],hi[4];
    #pragma unroll
    for(int ks=0;ks<4;++ks){
      asm volatile("ds_read_b64_tr_b16 %0,%1 offset:%c2":"=&v"(lo[ks]):"v"(vb),"i"(d0*4096+ks*1024):"memory");
      asm volatile("ds_read_b64_tr_b16 %0,%1 offset:%c2":"=&v"(hi[ks]):"v"(vb),"i"(d0*4096+ks*1024+512):"memory");}
    asm volatile("s_waitcnt lgkmcnt(0)":::"memory");SBAR();
    #define PK(k) (bf16x8){lo[k][0],lo[k][1],lo[k][2],lo[k][3],hi[k][0],hi[k][1],hi[k][2],hi[k][3]}
    o[d0]=__builtin_amdgcn_mfma_f32_32x32x16_bf16(pa0,PK(0),o[d0],0,0,0);
    o[d0]=__builtin_amdgcn_mfma_f32_32x32x16_bf16(pa1,PK(1),o[d0],0,0,0);
    o[d0]=__builtin_amdgcn_mfma_f32_32x32x16_bf16(pa2,PK(2),o[d0],0,0,0);
    o[d0]=__builtin_amdgcn_mfma_f32_32x32x16_bf16(pa3,PK(3),o[d0],0,0,0);
    #undef PK
  }
}

#ifndef ATTN_STORE16
#define ATTN_STORE16(p,v) (*(u32x4*)(p)=(v))
#endif
template<int THRL> __device__ __forceinline__ void attn_unit(int b,int h,int qb,const bf16*Q,const bf16*__restrict__ K,const bf16*__restrict__ V,bf16*O,const float*__restrict__ cum,const unsigned*__restrict__ qkm,char*shm){
  int tid_l=threadIdx.x; asm volatile("":"+v"(tid_l));
  const int tid=tid_l,lane=tid&63,r32=lane&31,hi=lane>>5; const int wid=__builtin_amdgcn_readfirstlane(tid>>6);
  const long rowbase=(long)b*SEQ; const int q0=qb*QB;
  const bf16*Qw=Q+(rowbase+q0+wid*QBLK)*DM+h*D;
  const bf16*Kh=K+rowbase*DM+h*D,*Vh=V+rowbase*DM+h*D;
  const unsigned lds0=(unsigned)(uintptr_t)shm;
  float*wsf=(float*)(shm+LDS_WS)+wid*64;
  const bf16*ksrc=Kh+(long)lane*DM+wid*8;
  const bf16*vsrc=Vh+(long)(16*(wid&3)+(lane>>2))*DM+(wid>>2)*32+(lane&3)*8;
  const unsigned kdst=lds0+LDS_K+wid*1024, vdst=lds0+LDS_V+wid*1024;
  #define DMA_K(t,slot) glds16(ksrc+(long)TILE(t)*KVBLK*DM,(unsigned)__builtin_amdgcn_readfirstlane(kdst+(slot)))
  #define DMA_V(t,slot) glds16(vsrc+(long)TILE(t)*KVBLK*DM,(unsigned)__builtin_amdgcn_readfirstlane(vdst+(slot)))
  const int vb0=(int)(lds0+LDS_V)+((lane>>4)&1)*32+(lane&3)*8+(4*hi+((lane&15)>>2))*64;
  const char*Kbase=shm+LDS_K; bf16x8 kf[8];
  const lds_cptr shm3=(lds_cptr)shm; const lds_cptr kp0=shm3+LDS_K+hi*1024+r32*16; const lds_cptr vp0=shm3+LDS_V+((lane>>4)&1)*32+(lane&3)*8+(4*hi+((lane&15)>>2))*64;
  const int NT=(q0+QB)/KVBLK;
  const lds_fptr cumS=(lds_fptr)(shm3+LDS_CUM);
  const float* cgp=cum+(long)(b*NHEAD+h)*SEQ;
  int tmin;
  { const float qk=sqrtf(__uint_as_float(qkm[b*NHEAD+h])*__uint_as_float(qkm[32+b*NHEAD+h]));
    const float thr=cgp[q0]+2.0f*qk+40.0f;
    const bool c0=(lane<NT-4)&&(cgp[64*lane+63]>=thr), c1=(lane+64<NT-4)&&(cgp[64*(lane+64)+63]>=thr);
    tmin=(__popcll(__ballot(c0))+__popcll(__ballot(c1)))&~1; }
  const int NTp=NT-tmin;
  #define TILE(j) (((j)<4)?(NT-4+(j)):(NT-1-(j)))
  { const f32x4a* cg4=(const f32x4a*)cgp; __attribute__((address_space(3))) f32x4a* cs4=(__attribute__((address_space(3))) f32x4a*)(shm3+LDS_CUM);
    for(int i=16*tmin+tid;i<(q0+QB)/4;i+=NW*64)cs4[i]=cg4[i]; }
  DMA_K(0,0);DMA_V(0,0);DMA_K(1,SLOTB);
  bf16x8 qr[4];
  #pragma unroll
  for(int d0=0;d0<4;++d0)qr[d0]=*reinterpret_cast<const bf16x8*>(&Qw[(long)r32*DM+d0*16+hi*8]);
  float mhat=0.f,l_reg=0.f;f32x16 o[2];o[0]=f32x16{};o[1]=f32x16{};float cq=0.f,nm=0.f;
  const int qrel=wid*QBLK+r32;
  #define CMASK(P0,P1,t) do{ if((t)<4)cmask(P0,P1,(t),qrel,hi);}while(0)
  bool resc=false;
  #define START(P0,P1) do{ const float rm=rowmax(P0,P1); resc=false; \
    { const float dl=rm; mhat=fadd_s(mhat,dl); \
      _Pragma("unroll") for(int r=0;r<16;++r){P0[r]=fsub_s(P0[r],dl);P1[r]=fsub_s(P1[r],dl);} \
      nm=cq-mhat; } \
    _Pragma("unroll") for(int r=0;r<16;++r)P0[r]=__builtin_amdgcn_exp2f(P0[r]); }while(0)
  #define RESC() do{ if(resc){ asm volatile("s_waitcnt lgkmcnt(0)":::"memory"); \
      _Pragma("unroll") for(int d_=0;d_<2;++d_) _Pragma("unroll") for(int r=0;r<16;++r)o[d_][r]*=wsf[crow(r,hi)]; } }while(0)
  f32x16 pA0,pA1,pB0,pB1;
  int sl_prev=0,sl_cur=0,sl_next=SLOTB;
  #define ROT() do{sl_prev=sl_cur;sl_cur=sl_next;sl_next=(sl_next==(NSLOT-1)*SLOTB)?0:sl_next+SLOTB;}while(0)
  DMA_K(2,2*SLOTB);
  WAIT_BAR(3);
  cq=cumS[q0+qrel]; nm=cq;
  qkt(pA0,pA1,Kbase,qr,cumS+64*TILE(0),nm,r32,hi);asm volatile("s_nop 15\n\ts_nop 7":"+v"(pA0),"+v"(pA1));CMASK(pA0,pA1,0);
  START(pA0,pA1);
  _Pragma("unroll") for(int r=0;r<16;++r)pA1[r]=__builtin_amdgcn_exp2f(pA1[r]);
  WAIT_BAR(0);
  DMA_K(3,0);DMA_V(1,SLOTB);
  ROT();
  kload8(kf,kp0+sl_cur);
  WAIT_BAR(2);
  s16x4 vlo[8],vhi[8]; u32x4 pw0,pw1,pw2,pw3;
  #define PKW(P,B) cvtpk_s(P[B],P[B+1])
  #define PAF(k) __builtin_bit_cast(bf16x8,pw##k)
  #define VFR(i) (bf16x8){vlo[i][0],vlo[i][1],vlo[i][2],vlo[i][3],vhi[i][0],vhi[i][1],vhi[i][2],vhi[i][3]}
  #define PIN(x) asm volatile("":"+v"(x))
  #define MX3(a,b,c) __builtin_fmaxf(__builtin_fmaxf((a),(b)),(c))
  #define GAPA(MF,A0,A1,A2,A3,W0,W1,PW) do{ MF; sacc+=A0; sacc+=A1; sacc+=A2; sacc+=A3; PIN(sacc); W0; W1; PIN(PW); SBAR(); }while(0)
  #define EX(v) __builtin_amdgcn_exp2f(v)
  #define GAPB(MF,X,B) do{ MF; X[B]=EX(X[B]); X[B+1]=EX(X[B+1]); X[B+2]=EX(X[B+2]); X[B+3]=EX(X[B+3]); PIN(X); SBAR(); }while(0)
  #define VRD(i) do{ vlo[i]=vtr(vp_+(((i)>>2)*4096+((i)&3)*1024)); vhi[i]=vtr(vp_+(((i)>>2)*4096+((i)&3)*1024+512)); }while(0)
  #define KRD(G,j) do{ if(G){ kload2(kf,kp0+sl_next,j); SBAR(); } }while(0)
  #define STEP(C0,C1,P0,P1,t,GK,GV,GL) do{ SBAR(); \
    ckinit(C0,C1,cumS+64*TILE(t),nm,hi); SBAR(); \
    const lds_cptr vp_=vp0+sl_prev; \
    VRD(0); SBAR(); float sacc=(P0[0]+P0[1]); \
    GAPA(C0=__builtin_amdgcn_mfma_f32_32x32x16_bf16(kf[0],qr[0],C0,0,0,0), P0[2],P0[3],P0[4],P0[5],     pw0[0]=PKW(P0,0), pw0[1]=PKW(P0,2), pw0); \
    VRD(4); SBAR(); GAPA(C1=__builtin_amdgcn_mfma_f32_32x32x16_bf16(kf[1],qr[0],C1,0,0,0), P0[6],P0[7],P0[8],P0[9],     pw0[2]=PKW(P0,4), pw0[3]=PKW(P0,6), pw0); \
    VRD(1); SBAR(); GAPA(C0=__builtin_amdgcn_mfma_f32_32x32x16_bf16(kf[2],qr[1],C0,0,0,0),   P0[10],P0[11],P0[12],P0[13], pw1[0]=PKW(P0,8), pw1[1]=PKW(P0,10), pw1); \
    VRD(5); SBAR(); GAPA(C1=__builtin_amdgcn_mfma_f32_32x32x16_bf16(kf[3],qr[1],C1,0,0,0),   P0[14],P0[15],P1[0],P1[1],   pw1[2]=PKW(P0,12),pw1[3]=PKW(P0,14), pw1); \
    VRD(2); SBAR(); GAPA(C0=__builtin_amdgcn_mfma_f32_32x32x16_bf16(kf[4],qr[2],C0,0,0,0),   P1[2],P1[3],P1[4],P1[5],     pw2[0]=PKW(P1,0), pw2[1]=PKW(P1,2), pw2); \
    VRD(6); SBAR(); GAPA(C1=__builtin_amdgcn_mfma_f32_32x32x16_bf16(kf[5],qr[2],C1,0,0,0),   P1[6],P1[7],P1[8],P1[9],     pw2[2]=PKW(P1,4), pw2[3]=PKW(P1,6), pw2); \
    VRD(3); SBAR(); GAPA(C0=__builtin_amdgcn_mfma_f32_32x32x16_bf16(kf[6],qr[3],C0,0,0,0),   P1[10],P1[11],P1[12],P1[13], pw3[0]=PKW(P1,8), pw3[1]=PKW(P1,10), pw3); \
    VRD(7); SBAR(); GAPA(C1=__builtin_amdgcn_mfma_f32_32x32x16_bf16(kf[7],qr[3],C1,0,0,0),   P1[14],P1[15],0.f,0.f,       pw3[2]=PKW(P1,12),pw3[3]=PKW(P1,14), pw3); \
    l_reg+=sacc; \
    if(GK){DMA_K((t)+3,sl_cur);} if(GV){DMA_V((t)+1,sl_next);} \
    CMASK(C0,C1,t); \
    { float a=MX3(C0[0],C0[1],C1[0]),b=MX3(C0[2],C0[3],C1[1]); a=MX3(a,C1[2],C1[3]); \
      _Pragma("unroll") for(int r=4;r<16;r+=4){a=MX3(a,C0[r],C0[r+1]);b=MX3(b,C0[r+2],C0[r+3]);a=MX3(a,C1[r],C1[r+1]);b=MX3(b,C1[r+2],C1[r+3]);} \
      float rm=__builtin_fmaxf(a,b); { auto rr=__builtin_amdgcn_permlane32_swap(__float_as_uint(rm),__float_as_uint(rm),false,false); rm=__builtin_fmaxf(__uint_as_float(rr[0]),__uint_as_float(rr[1])); } \
      resc=false; \
      if(__builtin_expect(__any(rm>(float)THRL),0)){ const float dl=__builtin_fmaxf(rm,0.f); mhat+=dl; \
        _Pragma("unroll") for(int r=0;r<16;++r){C0[r]-=dl;C1[r]-=dl;} \
        nm=cq-mhat; \
        const float f=__builtin_amdgcn_exp2f(-dl); l_reg*=f; if(hi==0)wsf[r32]=f; resc=true; } } \
    SBAR(); \
    GAPB(o[0]=__builtin_amdgcn_mfma_f32_32x32x16_bf16(PAF(0),VFR(0),o[0],0,0,0), C0,0); \
    GAPB(o[1]=__builtin_amdgcn_mfma_f32_32x32x16_bf16(PAF(0),VFR(4),o[1],0,0,0), C0,4); \
    KRD(GL,0); GAPB(o[0]=__builtin_amdgcn_mfma_f32_32x32x16_bf16(PAF(1),VFR(1),o[0],0,0,0), C0,8); \
    KRD(GL,1); GAPB(o[1]=__builtin_amdgcn_mfma_f32_32x32x16_bf16(PAF(1),VFR(5),o[1],0,0,0), C0,12); \
    KRD(GL,2); GAPB(o[0]=__builtin_amdgcn_mfma_f32_32x32x16_bf16(PAF(2),VFR(2),o[0],0,0,0), C1,0); \
    KRD(GL,3); GAPB(o[1]=__builtin_amdgcn_mfma_f32_32x32x16_bf16(PAF(2),VFR(6),o[1],0,0,0), C1,4); \
    GAPB(o[0]=__builtin_amdgcn_mfma_f32_32x32x16_bf16(PAF(3),VFR(3),o[0],0,0,0), C1,8); \
    GAPB(o[1]=__builtin_amdgcn_mfma_f32_32x32x16_bf16(PAF(3),VFR(7),o[1],0,0,0), C1,12); \
    }while(0)
  int t=1;
  for(;t+5<NTp;t+=2){
    STEP(pB0,pB1,pA0,pA1,t,true,true,true);     WAIT_BAR(2); RESC(); ROT();
    STEP(pA0,pA1,pB0,pB1,t+1,true,true,true);   WAIT_BAR(2); RESC(); ROT();
  }
  #define ENDW(tt) do{ if((tt)+3<NTp){WAIT_BAR(2);} else if((tt)+2<NTp){WAIT_BAR(1);} else {WAIT_BAR(0);} }while(0)
  for(;t+1<NTp;t+=2){
    STEP(pB0,pB1,pA0,pA1,t,(t+3<NTp),(t+1<NTp),(t+1<NTp));       ENDW(t);   RESC(); ROT();
    STEP(pA0,pA1,pB0,pB1,t+1,(t+4<NTp),(t+2<NTp),(t+2<NTp));     ENDW(t+1); RESC(); ROT();
  }
  STEP(pB0,pB1,pA0,pA1,NTp-1,false,false,false); RESC();
  { float sacc=pB0[0]+pB0[1]; _Pragma("unroll") for(int r=2;r<16;++r)sacc+=pB0[r]; _Pragma("unroll") for(int r=0;r<16;++r)sacc+=pB1[r]; l_reg+=sacc;
    pw0=(u32x4){PKW(pB0,0),PKW(pB0,2),PKW(pB0,4),PKW(pB0,6)};pw1=(u32x4){PKW(pB0,8),PKW(pB0,10),PKW(pB0,12),PKW(pB0,14)};pw2=(u32x4){PKW(pB1,0),PKW(pB1,2),PKW(pB1,4),PKW(pB1,6)};pw3=(u32x4){PKW(pB1,8),PKW(pB1,10),PKW(pB1,12),PKW(pB1,14)};
    SBAR(); pv(o,vb0+sl_cur,PAF(0),PAF(1),PAF(2),PAF(3)); }
  #undef PKW
  #undef PAF
  #undef VFR
  #undef PIN
  #undef MX3
  #undef GAPA
  #undef GAPB
  #undef EX
  #undef VRD
  #undef KRD
  #undef STEP
  #undef ENDW
  {auto rr=__builtin_amdgcn_permlane32_swap(__float_as_uint(l_reg),__float_as_uint(l_reg),false,false);l_reg=__uint_as_float(rr[0])+__uint_as_float(rr[1]);}
  if(hi==0)wsf[32+r32]=l_reg;asm volatile("s_waitcnt lgkmcnt(0)":::"memory");
  float rli[16];
  #pragma unroll
  for(int r=0;r<16;++r)rli[r]=__builtin_amdgcn_rcpf(wsf[32+crow(r,hi)]);
  bf16*Ow=O+(rowbase+q0+wid*QBLK)*DM+h*D;
  { bf16*stg=(bf16*)(shm+LDS_OST)+wid*2048;
    #pragma unroll
    for(int r=0;r<16;++r){const int orow=crow(r,hi);
      #pragma unroll
      for(int d0=0;d0<2;++d0)stg[orow*64+d0*32+r32]=__float2bfloat16(o[d0][r]*rli[r]);}
    asm volatile("s_waitcnt lgkmcnt(0)":::"memory");
    #pragma unroll
    for(int i=0;i<4;++i){const int row=i*8+(lane>>3),ch=lane&7; const u32x4 v=*(const u32x4*)(stg+row*64+ch*8); ATTN_STORE16(Ow+(long)row*DM+ch*8,v);} }
  asm volatile("s_waitcnt lgkmcnt(0)\n\ts_barrier":::"memory");
  #undef DMA_K
  #undef TILE
  #undef DMA_V
  #undef CMASK
  #undef START
  #undef RESC
  #undef ROT
}
constexpr int ATTN_LDS_BYTES=LDS_BYTES;
struct AttnTensors { const bf16* Q; const bf16* K; const bf16* V; bf16* O; const float* cum; const unsigned* qkm; };
struct AttnUnit { int bh; int qb; };
struct StaticOrder {
  int vcu;
  __device__ __forceinline__ explicit StaticOrder(int grid,int block):vcu((block%8)*(grid/8)+block/8){}
  __device__ __forceinline__ bool next(int i,AttnUnit&u)const{ if(i>=4)return false; const int s=vcu&7; u.bh=vcu>>3; u.qb=(i==0)?s:(i==1)?15-s:(i==2)?16+s:31-s; return true; }
  __device__ __forceinline__ void a_ready(const AttnUnit&)const{}
  __device__ __forceinline__ void done(const AttnUnit&)const{}
};
template<class Sched,int THRL=8> __device__ __forceinline__ void attn_phase(char*lds,const AttnTensors&T,const Sched&S){
  AttnUnit u;
  for(int i=0;S.next(i,u);++i){ S.a_ready(u); attn_unit<THRL>(u.bh/NHEAD,u.bh%NHEAD,u.qb,T.Q,T.K,T.V,T.O,T.cum,T.qkm,lds); S.done(u); }
}
#undef SBAR
#undef WAIT_BAR
}

constexpr int NWAVES = 8, NTHR = 512;
constexpr int NB = 4, SEQ = 8192, DM = 1024, T = NB * SEQ;
constexpr int NEXP = 32, TOPK = 4, ECAP = 32768;
constexpr int NSLOT_ROWS = T * TOPK + NEXP * 256;
constexpr int INW = 6680, NPROJ = 6656;
constexpr float LN_EPS = 1e-5f, ALPHA = 1.18920711500272f, LOG2E = 1.4426950408889634f;
constexpr size_t MiB = 1u << 20;
constexpr size_t WS_CTL = 0;
constexpr size_t WS_MODP = 13 * MiB, WS_MODF = 1 * MiB;
constexpr int MOD_KS = 16;
constexpr size_t WS_WSM = 2 * MiB, WS_WRT = WS_WSM + 256 * 1024;
constexpr size_t WS_FFL = 3 * MiB, WS_GLR = 4 * MiB, WS_CUM = 6 * MiB, WS_DLAST = 7 * MiB;
constexpr size_t WS_TSLOT = 8 * MiB, WS_TGATE = WS_TSLOT + 512 * 1024, WS_RTOK = 9 * MiB;
constexpr size_t WS_WIN = 16 * MiB, WS_WA = 29 * MiB, WS_WB = 30 * MiB, WS_WO = 32 * MiB, WS_WUP = 34 * MiB, WS_WDN = 162 * MiB;
constexpr size_t WS_U = 226 * MiB;
constexpr size_t WS_FQ = 290 * MiB, WS_FK = 322 * MiB, WS_FV = 354 * MiB, WS_GQ = 386 * MiB, WS_GK = 418 * MiB, WS_GV = 450 * MiB, WS_GR = 514 * MiB, WS_GA = 578 * MiB, WS_GB = 642 * MiB;
constexpr size_t WS_US = 706 * MiB;
constexpr size_t WS_U2 = 834 * MiB;
constexpr size_t WS_ACT = 290 * MiB, WS_MOE = 562 * MiB;
constexpr size_t WS_END = 898 * MiB;
static_assert(WS_ACT + (size_t)NSLOT_ROWS * 1024 * 2 <= WS_MOE && WS_MOE + (size_t)NSLOT_ROWS * 1024 * 2 <= WS_U2, "overlay map");

constexpr int LDS_BYTES = 160 * 1024;
constexpr int MISC_OFF = 131072;
constexpr int BARLDS_OFF = LDS_BYTES - 64;
constexpr int CW_BAR = 4096;
constexpr size_t CTL_ZERO_BYTES = 65536;

#define LAS __attribute__((address_space(3)))
typedef unsigned short bf16;
typedef unsigned v4u __attribute__((ext_vector_type(4)));
typedef unsigned v2u __attribute__((ext_vector_type(2)));
typedef float f32x4 __attribute__((ext_vector_type(4)));
typedef float f32x16 __attribute__((ext_vector_type(16)));
typedef short bf16x8 __attribute__((ext_vector_type(8)));
typedef short s16x4 __attribute__((ext_vector_type(4)));
#define LDS_WAIT() asm volatile("s_waitcnt lgkmcnt(0)" ::: "memory")
__device__ __forceinline__ unsigned f2bf(float f) { unsigned u = __builtin_bit_cast(unsigned, f); return (u + 0x7fffu + ((u >> 16) & 1u)) >> 16; }
__device__ __forceinline__ unsigned pk2(float lo, float hi) { return f2bf(lo) | (f2bf(hi) << 16); }
__device__ __forceinline__ float bfl(unsigned w) { return __uint_as_float(w << 16); }
__device__ __forceinline__ float bfh(unsigned w) { return __uint_as_float(w & 0xffff0000u); }
__device__ __forceinline__ float bf1(bf16 h) { return __uint_as_float((unsigned)h << 16); }
template <int CTRL, int RM, bool BC> __device__ __forceinline__ float dpp_mov(float old, float v) { return __builtin_bit_cast(float, __builtin_amdgcn_update_dpp(__builtin_bit_cast(int, old), __builtin_bit_cast(int, v), CTRL, RM, 0xf, BC)); }
__device__ __forceinline__ float wave_sum(float v) {
    v += dpp_mov<0xB1, 0xf, true>(0.f, v); v += dpp_mov<0x4E, 0xf, true>(0.f, v); v += dpp_mov<0x141, 0xf, true>(0.f, v); v += dpp_mov<0x140, 0xf, true>(0.f, v);
    v += dpp_mov<0x142, 0xa, false>(0.f, v); v += dpp_mov<0x143, 0xc, false>(0.f, v);
    return __builtin_bit_cast(float, __builtin_amdgcn_readlane(__builtin_bit_cast(int, v), 63));
}
__device__ __forceinline__ float wave_max(float v) {
    v = fmaxf(v, dpp_mov<0xB1, 0xf, true>(v, v)); v = fmaxf(v, dpp_mov<0x4E, 0xf, true>(v, v)); v = fmaxf(v, dpp_mov<0x141, 0xf, true>(v, v)); v = fmaxf(v, dpp_mov<0x140, 0xf, true>(v, v));
    v = fmaxf(v, dpp_mov<0x142, 0xa, false>(v, v)); v = fmaxf(v, dpp_mov<0x143, 0xc, false>(v, v));
    return __builtin_bit_cast(float, __builtin_amdgcn_readlane(__builtin_bit_cast(int, v), 63));
}
__device__ __forceinline__ float logsigmoidf(float x) { return fminf(x, 0.f) - __logf(1.0f + __expf(-fabsf(x))); }
__device__ __forceinline__ float sigmoidf_(float x) { return 1.0f / (1.0f + __expf(-x)); }
__device__ __forceinline__ float reduce32(const float (&v)[32], int lane) {
    float a[16], b[8], c[4], d[2], e;
#pragma unroll
    for (int i = 0; i < 16; ++i) { const auto r = __builtin_amdgcn_permlane32_swap(__float_as_uint(v[i]), __float_as_uint(v[16 + i]), false, false); a[i] = __uint_as_float(r[0]) + __uint_as_float(r[1]); }
#pragma unroll
    for (int i = 0; i < 8; ++i) { const auto r = __builtin_amdgcn_permlane16_swap(__float_as_uint(a[i]), __float_as_uint(a[8 + i]), false, false); b[i] = __uint_as_float(r[0]) + __uint_as_float(r[1]); }
    { const bool up = lane & 8;
#pragma unroll
      for (int i = 0; i < 4; ++i) { const float sx = b[i] + dpp_mov<0x128, 0xf, true>(0.f, b[i]), sy = b[4 + i] + dpp_mov<0x128, 0xf, true>(0.f, b[4 + i]); c[i] = up ? sy : sx; } }
    { const bool up = lane & 4;
#pragma unroll
      for (int i = 0; i < 2; ++i) { const float sx = c[i] + __builtin_bit_cast(float, __builtin_amdgcn_ds_swizzle(__builtin_bit_cast(int, c[i]), 0x101F)), sy = c[2 + i] + __builtin_bit_cast(float, __builtin_amdgcn_ds_swizzle(__builtin_bit_cast(int, c[2 + i]), 0x101F)); d[i] = up ? sy : sx; } }
    { const bool up = lane & 2; const float sx = d[0] + dpp_mov<0x4E, 0xf, true>(0.f, d[0]), sy = d[1] + dpp_mov<0x4E, 0xf, true>(0.f, d[1]); e = up ? sy : sx; }
    e += dpp_mov<0xB1, 0xf, true>(0.f, e);
    return e;
}

__device__ __forceinline__ bf16x8 frag_row(const LAS bf16* img, int stride, int row0, int k0, int lane) {
    return *(const LAS bf16x8*)(img + (row0 + (lane & 31)) * stride + k0 + 8 * (lane >> 5));
}
__device__ __forceinline__ bf16x8 frag_tr(const LAS bf16* img, int stride, int k0, int n0, int lane) {
    const int g = lane >> 4, q = (lane >> 2) & 3, p = lane & 3, h = g >> 1;
    const LAS bf16* a = img + (k0 + 8 * h + q) * stride + n0 + 16 * (g & 1) + 4 * p;
    const s16x4 lo = __builtin_bit_cast(s16x4, __builtin_amdgcn_ds_read_tr16_b64_v4i16((LAS s16x4*)a));
    const s16x4 hi = __builtin_bit_cast(s16x4, __builtin_amdgcn_ds_read_tr16_b64_v4i16((LAS s16x4*)(a + 4 * stride)));
    return (bf16x8){lo[0], lo[1], lo[2], lo[3], hi[0], hi[1], hi[2], hi[3]};
}
__device__ __forceinline__ int crow16(int r, int h) { return (r & 3) + 8 * (r >> 2) + 4 * h; }

typedef __attribute__((address_space(1))) unsigned gu32;
#define XB_TMO      128
#define XB_XCNT(j)  (256  + 64 * (j))
#define XB_XSUB(j)  (1280 + 64 * (j))
#define XB_XGEN(j)  (2304 + 64 * (j))
#define XB_TOP      3328
#define XB_TOPGEN   3392
#define XCD_BAR_WORDS 3456
#define XB_SPIN_CAP (1u << 18)

__device__ __forceinline__ unsigned xb_ld(unsigned* p)              { return __hip_atomic_load(p, __ATOMIC_RELAXED, __HIP_MEMORY_SCOPE_AGENT); }
__device__ __forceinline__ unsigned xb_add(unsigned* p, unsigned v) { return __hip_atomic_fetch_add(p, v, __ATOMIC_RELAXED, __HIP_MEMORY_SCOPE_AGENT); }
__device__ __forceinline__ unsigned xb_xcc_id() { return (unsigned)__builtin_amdgcn_s_getreg((3 << 11) | 20) & 0xFu; }
#define XB_SPIN(cond, bar) do { unsigned _sp = 0; while (cond) { __builtin_amdgcn_s_sleep(1); \
    if ((++_sp & 255u) == 0u) { if (xb_ld(&(bar)[XB_TMO])) break; if (_sp > XB_SPIN_CAP) { atomicAdd(&(bar)[XB_TMO], 1u); break; } } } } while (0)

struct XcdBarrier {
    unsigned* bar; unsigned x;
    volatile LAS unsigned* st;
};

__device__ __forceinline__ XcdBarrier xcd_barrier_post(unsigned* bar, volatile LAS unsigned* st) {
    XcdBarrier b; b.bar = bar; b.x = xb_xcc_id(); b.st = st;
    if (threadIdx.x == 0) (void)xb_add(&bar[XB_XCNT(b.x)], 1u);
    return b;
}
__device__ __forceinline__ void xcd_barrier_complete(unsigned* bar, unsigned x, unsigned& nloc, unsigned& nx) {
    const unsigned G = gridDim.x * gridDim.y * gridDim.z;
    unsigned sum, cnt, mine, sp = 0u;
    for (;;) {
        sum = 0u; cnt = 0u; mine = 0u;
#pragma unroll
        for (unsigned j = 0; j < 16; ++j) { const unsigned c = xb_ld(&bar[XB_XCNT(j)]); sum += c; cnt += (c > 0u) ? 1u : 0u; mine = (j == x) ? c : mine; }
        if (sum == G) break;
        __builtin_amdgcn_s_sleep(1);
        if ((++sp & 255u) == 0u) { if (xb_ld(&bar[XB_TMO])) break; if (sp > XB_SPIN_CAP) { atomicAdd(&bar[XB_TMO], 1u); break; } }
    }
    nloc = mine > 0u ? mine : 1u; nx = cnt > 0u ? cnt : 1u;
}

__device__ __forceinline__ void xcd_barrier(const XcdBarrier& b) {
    asm volatile("s_waitcnt vmcnt(0)" ::: "memory");
    __syncthreads();
    if (threadIdx.x == 0) {
        unsigned* bar = b.bar;
        __builtin_amdgcn_s_waitcnt(0);
        unsigned nloc = b.st[0], nx = b.st[1];
        if (nloc == 0u) { xcd_barrier_complete(bar, b.x, nloc, nx); b.st[0] = nloc; b.st[1] = nx; }
        const unsigned old = xb_add(&bar[XB_XSUB(b.x)], 1u);
        const unsigned gen = old / nloc;
        if (old + 1u == (gen + 1u) * nloc) {
            __builtin_amdgcn_fence(__ATOMIC_RELEASE, "agent");
            asm volatile("s_waitcnt vmcnt(0)" ::: "memory");
            const unsigned og = xb_add(&bar[XB_TOP], 1u);
            const unsigned tg = og / nx;
            if (og + 1u == (tg + 1u) * nx) xb_add(&bar[XB_TOPGEN], 1u);
            else XB_SPIN(xb_ld(&bar[XB_TOPGEN]) == tg, bar);
            __builtin_amdgcn_fence(__ATOMIC_ACQUIRE, "agent");
            xb_add(&bar[XB_XGEN(b.x)], 1u);
            asm volatile("s_waitcnt vmcnt(0)" ::: "memory");
        } else {
            XB_SPIN(xb_ld(&bar[XB_XGEN(b.x)]) == gen, bar);
            __builtin_amdgcn_fence(__ATOMIC_ACQUIRE, "agent");
            asm volatile("s_waitcnt vmcnt(0)" ::: "memory");
        }
    }
    __syncthreads();
}

__device__ __forceinline__ int tid_() { int t = threadIdx.x; asm volatile("" : "+v"(t)); return t; }
struct Frame {
    LAS unsigned char* lds;
    int wave, G, blk;
    float* out; unsigned char* ws;
};
#define WSP(type, off) ((type*)(F.ws + (off)))
constexpr size_t WS_PTRS = 2048;
#define GAS __attribute__((address_space(1)))
typedef const GAS float* gfptr_t;
typedef const GAS f32x4* gf4ptr_t;
#define PT(k) (((const gfptr_t*)(F.ws + WS_PTRS))[k])
struct Args { const float* in[22]; float* out; unsigned char* ws; int ph_lo, ph_hi; };

struct WItem { const float* src; bf16* dst; int ldw, Kd; float scl; };
__device__ __forceinline__ bool p0_item(const Args& A, unsigned char* ws, int it, WItem& w) {
    constexpr int I_IN = 16 * (NPROJ / 64), I_A = 8 * 16, I_B = 16 * 16, I_O = 16 * 16, I_UP = 16 * 32, I_DN = 16 * 16;
    constexpr int NITEMS = I_IN + I_A + I_B + I_O + NEXP * (I_UP + I_DN);
    if (it >= NITEMS) return false;
    int r = it;
    if (r < I_IN) { const int nblk = NPROJ / 64, kb = r / nblk, nb = r % nblk, n0 = 64 * nb; const int sc0 = n0 + (n0 < 1536 ? 0 : (n0 < 4608 ? 8 : 24));
        w.src = A.in[4] + (size_t)(64 * kb) * INW + sc0; w.ldw = INW; w.dst = (bf16*)(ws + WS_WIN) + (size_t)n0 * 1024 + 64 * kb; w.Kd = 1024; w.scl = 0.f; return true; } r -= I_IN;
    if (r < I_A) { const int kb = r / 16, nb = r % 16; w.src = A.in[9] + (size_t)(64 * kb) * 1024 + 64 * nb; w.ldw = 1024; w.dst = (bf16*)(ws + WS_WA) + (size_t)(64 * nb) * 512 + 64 * kb; w.Kd = 512; w.scl = 0.f; return true; } r -= I_A;
    if (r < I_B) { const int kb = r / 16, nb = r % 16; w.src = A.in[10] + (size_t)(64 * kb) * 1024 + 64 * nb; w.ldw = 1024; w.dst = (bf16*)(ws + WS_WB) + (size_t)(64 * nb) * 1024 + 64 * kb; w.Kd = 1024; w.scl = 0.f; return true; } r -= I_B;
    if (r < I_O) { const int kb = r / 16, nb = r % 16; w.src = A.in[11] + (size_t)(64 * kb) * 1024 + 64 * nb; w.ldw = 1024; w.dst = (bf16*)(ws + WS_WO) + (size_t)(64 * nb) * 1024 + 64 * kb; w.Kd = 1024; w.scl = 0.f; return true; } r -= I_O;
    const int e = r / (I_UP + I_DN); r -= e * (I_UP + I_DN);
    if (r < I_UP) { const int kb = r / 32, nb = r % 32, n0 = 64 * nb, tile = n0 >> 8, wv = n0 & 255; const int sc0 = wv < 128 ? 128 * tile + wv : 1024 + 128 * tile + (wv - 128);
        w.src = A.in[16] + (size_t)e * 1024 * 2048 + (size_t)(64 * kb) * 2048 + sc0; w.ldw = 2048; w.dst = (bf16*)(ws + WS_WUP + (size_t)e * 2048 * 1024 + (size_t)n0 * 1024 + 64 * kb); w.Kd = 1024; w.scl = 32.f; return true; } r -= I_UP;
    { const int kb = r / 16, nb = r % 16; w.src = A.in[18] + (size_t)e * 1024 * 1024 + (size_t)(64 * kb) * 1024 + 64 * nb; w.ldw = 1024; w.dst = (bf16*)(ws + WS_WDN + (size_t)e * 1024 * 1024 + (size_t)(64 * nb) * 1024 + 64 * kb); w.Kd = 1024; w.scl = 64.f; return true; }
}
__device__ __forceinline__ void phase0(Frame& F, const Args& A) {
    const int tid = tid_(), lane = tid & 63;
    const int gtid = F.blk * NTHR + tid, NT_ALL = F.G * NTHR;
    if (F.blk == 0 && tid < 22) ((const float**)(F.ws + WS_PTRS))[tid] = A.in[tid];
    { v4u* p = WSP(v4u, WS_RTOK); for (int i = gtid; i < NEXP * ECAP / 4; i += NT_ALL) p[i] = (v4u){0u, 0u, 0u, 0u}; }
    for (int i = gtid; i < 24 * 1024; i += NT_ALL) { const int o = i >> 10, k = i & 1023; const int col = o < 8 ? 1536 + o : 4616 + (o - 8); WSP(float, WS_WSM)[i] = A.in[4][(size_t)k * INW + col]; }
    for (int i = gtid; i < 32 * 1024; i += NT_ALL) { const int e = i >> 10, k = i & 1023; WSP(float, WS_WRT)[i] = A.in[14][k * 32 + e]; }
    {
        LAS float* sc = (LAS float*)(F.lds + 140 * 1024);
        for (int i = tid; i < 4096; i += NTHR) { const float v = A.in[1][i]; sc[i] = v * sigmoidf_(v); }
        __syncthreads();
        const int task = F.blk * 384 + tid;
        if (tid < 384 && task < MOD_KS * 6144) {
            const int ks = task / 6144, j = task % 6144; float a0 = 0.f, a1 = 0.f, a2 = 0.f, a3 = 0.f;
            const float* wp = A.in[2] + (size_t)(ks * 64) * 6144 + j; const LAS float* sv = sc + ks * 64;
#pragma unroll 16
            for (int k = 0; k < 64; ++k) { const float w = wp[(size_t)k * 6144]; a0 += sv[k] * w; a1 += sv[1024 + k] * w; a2 += sv[2048 + k] * w; a3 += sv[3072 + k] * w; }
            const float bb = ks == 0 ? A.in[3][j] : 0.f; float* mp = WSP(float, WS_MODP) + (size_t)ks * 4 * 6144 + j;
            mp[0] = a0 + bb; mp[6144] = a1 + bb; mp[2 * 6144] = a2 + bb; mp[3 * 6144] = a3 + bb;
        }
    }
    LAS float* scr = (LAS float*)(F.lds + F.wave * 16640);
    const int gw = F.blk * NWAVES + F.wave, NGW = F.G * NWAVES;
    WItem cur, nxt; f32x4 ld[16], ln[16];
    bool has = p0_item(A, F.ws, gw, cur);
    if (has) {
#pragma unroll
        for (int i = 0; i < 16; ++i) ld[i] = *(const f32x4*)(cur.src + (size_t)((lane >> 4) + 4 * i) * cur.ldw + 4 * (lane & 15)); }
    for (int it = gw; has; it += NGW) {
        const bool hn = p0_item(A, F.ws, it + NGW, nxt);
        if (hn) {
#pragma unroll
            for (int i = 0; i < 16; ++i) ln[i] = *(const f32x4*)(nxt.src + (size_t)((lane >> 4) + 4 * i) * nxt.ldw + 4 * (lane & 15)); }
#pragma unroll
        for (int i = 0; i < 16; ++i) { LAS float* d = scr + ((lane >> 4) + 4 * i) * 65 + 4 * (lane & 15); d[0] = ld[i].x; d[1] = ld[i].y; d[2] = ld[i].z; d[3] = ld[i].w; }
        LDS_WAIT(); asm volatile("" ::: "memory");
        if (cur.scl == 0.f) { const int c = lane & 7;
#pragma unroll
            for (int j = 0; j < 8; ++j) { const int n = (lane >> 3) + 8 * j; const LAS float* sp = scr + (8 * c) * 65 + n;
                v4u o; o.x = pk2(sp[0 * 65], sp[1 * 65]); o.y = pk2(sp[2 * 65], sp[3 * 65]); o.z = pk2(sp[4 * 65], sp[5 * 65]); o.w = pk2(sp[6 * 65], sp[7 * 65]);
                *(v4u*)(cur.dst + (size_t)n * cur.Kd + 8 * c) = o; } }
        else { const int c = lane & 3; const float sc = cur.scl;
#pragma unroll
            for (int j = 0; j < 4; ++j) { const int n = (lane >> 2) + 16 * j; const LAS float* sp = scr + (16 * c) * 65 + n; int o[4];
#pragma unroll
                for (int q = 0; q < 4; ++q) { int w = 0; w = __builtin_amdgcn_cvt_pk_fp8_f32(sp[(4 * q) * 65] * sc, sp[(4 * q + 1) * 65] * sc, w, false); w = __builtin_amdgcn_cvt_pk_fp8_f32(sp[(4 * q + 2) * 65] * sc, sp[(4 * q + 3) * 65] * sc, w, true); o[q] = w; }
                *(v4u*)((unsigned char*)cur.dst + (size_t)n * cur.Kd + 16 * c) = (v4u){(unsigned)o[0], (unsigned)o[1], (unsigned)o[2], (unsigned)o[3]}; } }
        LDS_WAIT(); asm volatile("" ::: "memory");
        has = hn; cur = nxt;
#pragma unroll
        for (int i = 0; i < 16; ++i) ld[i] = ln[i];
    }
}

template <int R> __device__ __forceinline__ void ln_center(f32x4 (&v)[R][4], float (&rstd)[R]) {
    float s[R];
#pragma unroll
    for (int r = 0; r < R; ++r) { s[r] = 0.f;
#pragma unroll
        for (int j = 0; j < 4; ++j) s[r] += (v[r][j].x + v[r][j].y) + (v[r][j].z + v[r][j].w); }
#pragma unroll
    for (int r = 0; r < R; ++r) { const float mean = wave_sum(s[r]) * (1.f / DM); s[r] = 0.f;
#pragma unroll
        for (int j = 0; j < 4; ++j) { v[r][j] = v[r][j] - mean; s[r] += (v[r][j].x * v[r][j].x + v[r][j].y * v[r][j].y) + (v[r][j].z * v[r][j].z + v[r][j].w * v[r][j].w); } }
#pragma unroll
    for (int r = 0; r < R; ++r) rstd[r] = 1.f / sqrtf(wave_sum(s[r]) * (1.f / DM) + LN_EPS);
}
template <int NO> __device__ __forceinline__ void row_dots2(const f32x4 (&v)[2][4], const LAS float* w, int lane, float (&p0)[32], float (&p1)[32]) {
#pragma unroll
    for (int o = 0; o < NO; ++o) { float a0 = 0.f, a1 = 0.f;
#pragma unroll
        for (int j = 0; j < 4; ++j) { const f32x4 ww = *(const LAS f32x4*)(w + o * 1024 + 256 * j + 4 * lane);
            a0 += (v[0][j].x * ww.x + v[0][j].y * ww.y) + (v[0][j].z * ww.z + v[0][j].w * ww.w); a1 += (v[1][j].x * ww.x + v[1][j].y * ww.y) + (v[1][j].z * ww.z + v[1][j].w * ww.w); }
        p0[o] = a0; p1[o] = a1; if ((o & 3) == 3) asm volatile("" ::: "memory"); }
#pragma unroll
    for (int o = NO; o < 32; ++o) { p0[o] = 0.f; p1[o] = 0.f; }
}
__device__ __forceinline__ void phase1(Frame& F, const Args& A) {
    const int tid = tid_(), lane = tid & 63;
    LAS float* wsm = (LAS float*)F.lds;
    LAS float* mods = (LAS float*)(F.lds + 98304);
    const int b = F.blk / (F.G / NB);
    for (int i = tid; i < 24 * 1024 / 4; i += NTHR) ((LAS f32x4*)wsm)[i] = WSP(f32x4, WS_WSM)[i];
    for (int i = tid; i < 2048; i += NTHR) { const float* mp = WSP(float, WS_MODP) + (size_t)b * 6144 + i; float a = 0.f;
#pragma unroll
        for (int k = 0; k < MOD_KS; ++k) a += mp[(size_t)k * 4 * 6144];
        mods[i] = a; }
    { const int gtid = F.blk * NTHR + tid; if (gtid < 4 * 6144) { const float* mp = WSP(float, WS_MODP) + gtid; float a = 0.f;
#pragma unroll
        for (int k = 0; k < MOD_KS; ++k) a += mp[(size_t)k * 4 * 6144];
        WSP(float, WS_MODF)[gtid] = a; } }
    __syncthreads();
    const int rows_per_blk = T / F.G, rows_per_wave = rows_per_blk / NWAVES;
    const int row0 = F.blk * rows_per_blk + F.wave * rows_per_wave;
    const int oi = lane >> 1; const float fb = oi < 8 ? A.in[5][oi] : 0.f;
    f32x4 nx[2][4];
#pragma unroll
    for (int r = 0; r < 2; ++r)
#pragma unroll
        for (int j = 0; j < 4; ++j) nx[r][j] = ((const f32x4*)(A.in[0] + (size_t)(row0 + r) * DM) + lane)[64 * j];
    for (int rr = 0; rr < rows_per_wave; rr += 2) {
        const int row = row0 + rr;
        f32x4 v[2][4];
#pragma unroll
        for (int r = 0; r < 2; ++r)
#pragma unroll
            for (int j = 0; j < 4; ++j) v[r][j] = nx[r][j];
        if (rr + 2 < rows_per_wave) {
#pragma unroll
            for (int r = 0; r < 2; ++r)
#pragma unroll
                for (int j = 0; j < 4; ++j) nx[r][j] = ((const f32x4*)(A.in[0] + (size_t)(row + 2 + r) * DM) + lane)[64 * j]; }
        float rstd[2]; ln_center<2>(v, rstd);
#pragma unroll
        for (int r = 0; r < 2; ++r) { unsigned long long* o8 = (unsigned long long*)(WSP(bf16, WS_U) + (size_t)(row + r) * DM) + lane;
#pragma unroll
            for (int j = 0; j < 4; ++j) { const f32x4 sh = *(const LAS f32x4*)(mods + 256 * j + 4 * lane), scv = *(const LAS f32x4*)(mods + 1024 + 256 * j + 4 * lane);
                v[r][j] = v[r][j] * rstd[r] * (scv + 1.0f) + sh;
                o8[64 * j] = (unsigned long long)pk2(v[r][j].x, v[r][j].y) | ((unsigned long long)pk2(v[r][j].z, v[r][j].w) << 32); } }
        float p0[32], p1[32]; row_dots2<24>(v, wsm, lane, p0, p1);
        const float t0 = reduce32(p0, lane), t1 = reduce32(p1, lane);
        if ((lane & 1) == 0) {
            if (oi < 8) { WSP(float, WS_FFL)[(size_t)row * 8 + oi] = logsigmoidf(t0 + fb) * LOG2E; WSP(float, WS_FFL)[(size_t)(row + 1) * 8 + oi] = logsigmoidf(t1 + fb) * LOG2E; }
            else if (oi < 24) { WSP(float, WS_GLR)[(size_t)row * 16 + (oi - 8)] = t0; WSP(float, WS_GLR)[(size_t)(row + 1) * 16 + (oi - 8)] = t1; }
        }
    }
}

constexpr int GC = 64, GDK = 128, GDV = 256, GNCH = SEQ / GC, GITEMS = NB * 4 * GNCH;
constexpr int KST = 136, VST = 264, PST = 72;
__device__ __forceinline__ void fox_cumsum_item(Frame& F, int bh) {
    const int tid = tid_(), lane = tid & 63; (void)lane;
    const int b = bh >> 3, h = bh & 7; LAS float* wt = (LAS float*)(F.lds + MISC_OFF);
    const float* src = WSP(float, WS_FFL) + (size_t)b * SEQ * 8 + h; float v[16]; float run = 0.f;
#pragma unroll
    for (int i = 0; i < 16; ++i) { run += src[(size_t)(tid * 16 + i) * 8]; v[i] = run; }
    float incl = run;
#pragma unroll
    for (int o = 1; o < 64; o <<= 1) { const float n = __shfl_up(incl, o); if (lane >= o) incl += n; }
    if (lane == 63) wt[F.wave] = incl;
    __syncthreads();
    float base = incl - run;
    for (int w = 0; w < F.wave; ++w) base += wt[w];
    float* dst = WSP(float, WS_CUM) + (size_t)bh * SEQ + tid * 16;
#pragma unroll
    for (int i = 0; i < 16; i += 4) *(f32x4*)(dst + i) = (f32x4){v[i] + base, v[i + 1] + base, v[i + 2] + base, v[i + 3] + base};
    __syncthreads();
}
__device__ __forceinline__ float gla_decay(int tid, const float (&wg)[17], const LAS float* glrS, LAS float* totS, float (&p)[16]) {
    const int c = tid & 127, tg = tid >> 7;
    const float bg = wg[16]; float run = 0.f;
#pragma unroll
    for (int i = 0; i < 16; ++i) { const LAS float* gr = glrS + (tg * 16 + i) * 16; float z = bg;
#pragma unroll
        for (int r = 0; r < 16; ++r) z += gr[r] * wg[r];
        run += logsigmoidf(z) * (1.0f / 16.0f); p[i] = run; }
    totS[tg * GDK + c] = run;
    __syncthreads();
    float off = 0.f, tot = 0.f;
#pragma unroll
    for (int g = 0; g < 4; ++g) { const float tv = totS[g * GDK + c]; tot += tv; if (g < tg) off += tv; }
#pragma unroll
    for (int i = 0; i < 16; ++i) p[i] += off;
    return tot;
}
__device__ __forceinline__ void gla_state_phase(Frame& F) {
    const int tid = tid_(), lane = tid & 63;
    LAS bf16* KS = (LAS bf16*)F.lds;
    LAS bf16* VS = (LAS bf16*)(F.lds + 17408);
    LAS float* glrS = (LAS float*)(F.lds + 51200);
    LAS float* totS = (LAS float*)(F.lds + 55296);
    LAS bf16* US = (LAS bf16*)(F.lds + 57344);
    v4u pv[4], pk[2]; f32x4 pg = (f32x4){0.f, 0.f, 0.f, 0.f}; float wgn[17], wg[17];
    const gfptr_t wgate = PT(6), bgate = PT(7);
#define GLA_A_PREFETCH(it_) do { const int h_ = (it_) & 3, n_ = ((it_) >> 2) & (GNCH - 1), b_ = (it_) >> 9; const size_t r0_ = (size_t)b_ * SEQ + (size_t)n_ * GC; \
        _Pragma("unroll") for (int r = 0; r < 16; ++r) wgn[r] = wgate[r * 512 + h_ * GDK + (tid & 127)]; wgn[16] = bgate[h_ * GDK + (tid & 127)]; \
        _Pragma("unroll") for (int i = 0; i < 4; ++i) { const int pc = tid + i * NTHR, t = pc >> 5, ch = pc & 31; pv[i] = *(const v4u*)(WSP(bf16, WS_GV) + (r0_ + t) * 1024 + h_ * GDV + ch * 8); } \
        _Pragma("unroll") for (int i = 0; i < 2; ++i) { const int pc = tid + i * NTHR, t = pc >> 4, ch = pc & 15; pk[i] = *(const v4u*)(WSP(bf16, WS_GK) + (r0_ + t) * 512 + h_ * GDK + ch * 8); } \
        if (tid < 256) pg = ((const f32x4*)(WSP(float, WS_GLR) + r0_ * 16))[tid]; } while (0)
    int it = F.blk;
    if (it < GITEMS) GLA_A_PREFETCH(it);
    for (; it < GITEMS; it += F.G) {
#pragma unroll
        for (int i = 0; i < 4; ++i) { const int pc = tid + i * NTHR, t = pc >> 5, ch = pc & 31; *(LAS v4u*)(VS + t * VST + ch * 8) = pv[i]; }
#pragma unroll
        for (int i = 0; i < 2; ++i) { const int pc = tid + i * NTHR, t = pc >> 4, ch = pc & 15; *(LAS v4u*)(KS + t * KST + ch * 8) = pk[i]; }
        if (tid < 256) ((LAS f32x4*)glrS)[tid] = pg;
#pragma unroll
        for (int r = 0; r < 17; ++r) wg[r] = wgn[r];
        __syncthreads();
        if (it + F.G < GITEMS) GLA_A_PREFETCH(it + F.G);
        float p[16]; const float blast = gla_decay(tid, wg, glrS, totS, p);
        const int c = tid & 127, tg = tid >> 7;
#pragma unroll
        for (int i = 0; i < 16; ++i) { const int t = tg * 16 + i; KS[t * KST + c] = (bf16)f2bf(bf1(KS[t * KST + c]) * __expf(blast - p[i])); }
        if (tg == 0) WSP(float, WS_DLAST)[(size_t)it * GDK + c] = __expf(blast);
        __syncthreads();
        f32x16 acc[4];
#pragma unroll
        for (int cb = 0; cb < 4; ++cb) acc[cb] = (f32x16){};
#pragma unroll
        for (int ks = 0; ks < 4; ++ks) { const bf16x8 a = frag_tr(VS, VST, 16 * ks, 32 * F.wave, lane);
#pragma unroll
            for (int cb = 0; cb < 4; ++cb) { const bf16x8 bb = frag_tr(KS, KST, 16 * ks, 32 * cb, lane); acc[cb] = __builtin_amdgcn_mfma_f32_32x32x16_bf16(a, bb, acc[cb], 0, 0, 0); } }
        const int hh = lane >> 5;
#pragma unroll
        for (int cb = 0; cb < 4; ++cb) { const int cc = 32 * cb + (lane & 31);
#pragma unroll
            for (int g = 0; g < 4; ++g) { v2u w; w.x = pk2(acc[cb][4 * g], acc[cb][4 * g + 1]); w.y = pk2(acc[cb][4 * g + 2], acc[cb][4 * g + 3]);
                *(LAS v2u*)(US + cc * VST + 32 * F.wave + 8 * g + 4 * hh) = w; } }
        __syncthreads();
        bf16* us = WSP(bf16, WS_US) + (size_t)it * GDK * GDV;
#pragma unroll
        for (int i = 0; i < 8; ++i) { const int pc = tid + i * NTHR, cc = pc >> 5, ch = pc & 31; *(v4u*)(us + (size_t)cc * GDV + ch * 8) = *(const LAS v4u*)(US + cc * VST + ch * 8); }
    }
#undef GLA_A_PREFETCH
    __syncthreads();
}
constexpr int CW_QKM = 64;
__device__ __forceinline__ void fox_norm_item(Frame& F, int item) {
    const int tid = tid_(), lane = tid & 63; (void)lane;
    const int bh = item >> 4, sl = item & 15, b = bh >> 3, h = bh & 7; const size_t row = (size_t)b * SEQ + sl * 512 + tid;
    const v4u* qp = (const v4u*)(WSP(bf16, WS_FQ) + row * 512 + h * 64); const v4u* kp = (const v4u*)(WSP(bf16, WS_FK) + row * 512 + h * 64);
    float q2 = 0.f, k2 = 0.f;
#pragma unroll
    for (int i = 0; i < 8; ++i) { const v4u a = qp[i], c = kp[i];
        q2 += (bfl(a.x) * bfl(a.x) + bfh(a.x) * bfh(a.x)) + (bfl(a.y) * bfl(a.y) + bfh(a.y) * bfh(a.y)) + (bfl(a.z) * bfl(a.z) + bfh(a.z) * bfh(a.z)) + (bfl(a.w) * bfl(a.w) + bfh(a.w) * bfh(a.w));
        k2 += (bfl(c.x) * bfl(c.x) + bfh(c.x) * bfh(c.x)) + (bfl(c.y) * bfl(c.y) + bfh(c.y) * bfh(c.y)) + (bfl(c.z) * bfl(c.z) + bfh(c.z) * bfh(c.z)) + (bfl(c.w) * bfl(c.w) + bfh(c.w) * bfh(c.w)); }
    q2 = wave_max(q2) * 1.0001f; k2 = wave_max(k2) * 1.0001f;
    if (lane == 0) { atomicMax(WSP(unsigned, WS_CTL) + CW_QKM + bh, __float_as_uint(q2)); atomicMax(WSP(unsigned, WS_CTL) + CW_QKM + 32 + bh, __float_as_uint(k2)); }
}
__device__ __forceinline__ void phase3(Frame& F) {
    if (F.blk < 32) fox_cumsum_item(F, F.blk);
    for (int it = F.blk; it < 512; it += F.G) fox_norm_item(F, it);
    gla_state_phase(F);
}

__device__ __forceinline__ void gla_scan(Frame& F) {
    const int tid = tid_(), lane = tid & 63; (void)lane;
    const int NTOT = 16 * GDK * GDV / 4;
    for (int gt = F.blk * NTHR + tid; gt < NTOT; gt += F.G * NTHR) {
        const int bh = gt / (GDK * GDV / 4), e4 = gt % (GDK * GDV / 4), c = e4 >> 6; const size_t it0 = (size_t)(bh >> 2) * GNCH * 4 + (bh & 3);
        bf16* p = WSP(bf16, WS_US) + it0 * GDK * GDV + (size_t)e4 * 4; const float* dl = WSP(float, WS_DLAST) + it0 * GDK + c;
        float s0 = 0.f, s1 = 0.f, s2 = 0.f, s3 = 0.f;
        for (int n0 = 0; n0 < GNCH; n0 += 8) { v2u u[8]; float d[8];
#pragma unroll
            for (int j = 0; j < 8; ++j) { u[j] = *(const v2u*)(p + (size_t)(n0 + j) * 4 * GDK * GDV); d[j] = dl[(size_t)(n0 + j) * 4 * GDK]; }
#pragma unroll
            for (int j = 0; j < 8; ++j) { v2u o; o.x = pk2(s0, s1); o.y = pk2(s2, s3); *(v2u*)(p + (size_t)(n0 + j) * 4 * GDK * GDV) = o;
                s0 = d[j] * s0 + bfl(u[j].x); s1 = d[j] * s1 + bfh(u[j].x); s2 = d[j] * s2 + bfl(u[j].y); s3 = d[j] * s3 + bfh(u[j].y); } }
    }
}

__device__ __forceinline__ void gla_out_phase(Frame& F) {
    const int tid = tid_(), lane = tid & 63;
    LAS bf16* QhS = (LAS bf16*)F.lds;
    LAS bf16* KcS = (LAS bf16*)(F.lds + 17408);
    LAS bf16* PS = (LAS bf16*)(F.lds + 34816);
    LAS bf16* VS = (LAS bf16*)(F.lds + 44032);
    LAS bf16* SS = (LAS bf16*)(F.lds + 77824);
    LAS float* glrS = (LAS float*)(F.lds + 145408);
    LAS float* totS = glrS + 1024;
    LAS float* oS = (LAS float*)(F.lds + 44032);
    v4u ps[8], pv[4], pq[2], pk[2]; f32x4 pg = (f32x4){0.f, 0.f, 0.f, 0.f}; float wgn[17], wg[17]; v2u ggn[8], gg[8]; f32x4 gnn, gn;
    const gfptr_t wgate = PT(6), bgate = PT(7), gnorm = PT(8);
#define GLA_C_PREFETCH(it_) do { const int h_ = (it_) & 3, n_ = ((it_) >> 2) & (GNCH - 1), b_ = (it_) >> 9; const size_t r0_ = (size_t)b_ * SEQ + (size_t)n_ * GC; \
        _Pragma("unroll") for (int r = 0; r < 16; ++r) wgn[r] = wgate[r * 512 + h_ * GDK + (tid & 127)]; wgn[16] = bgate[h_ * GDK + (tid & 127)]; \
        gnn = *(gf4ptr_t)(gnorm + h_ * GDV + 4 * lane); \
        _Pragma("unroll") for (int i = 0; i < 8; ++i) ggn[i] = *(const v2u*)(WSP(bf16, WS_GR) + (r0_ + 8 * F.wave + i) * 1024 + h_ * GDV + 4 * lane); \
        const bf16* sp_ = WSP(bf16, WS_US) + (size_t)(it_) * GDK * GDV; \
        _Pragma("unroll") for (int i = 0; i < 8; ++i) { const int pc = tid + i * NTHR, cc = pc >> 5, ch = pc & 31; ps[i] = *(const v4u*)(sp_ + (size_t)cc * GDV + ch * 8); } \
        _Pragma("unroll") for (int i = 0; i < 4; ++i) { const int pc = tid + i * NTHR, t = pc >> 5, ch = pc & 31; pv[i] = *(const v4u*)(WSP(bf16, WS_GV) + (r0_ + t) * 1024 + h_ * GDV + ch * 8); } \
        _Pragma("unroll") for (int i = 0; i < 2; ++i) { const int pc = tid + i * NTHR, t = pc >> 4, ch = pc & 15; const size_t go = (r0_ + t) * 512 + h_ * GDK + ch * 8; \
            pq[i] = *(const v4u*)(WSP(bf16, WS_GQ) + go); pk[i] = *(const v4u*)(WSP(bf16, WS_GK) + go); } \
        if (tid < 256) pg = ((const f32x4*)(WSP(float, WS_GLR) + r0_ * 16))[tid]; } while (0)
    int it = F.blk;
    if (it < GITEMS) GLA_C_PREFETCH(it);
    for (; it < GITEMS; it += F.G) {
        const int h = it & 3, n = (it >> 2) & (GNCH - 1), b = it >> 9; const size_t r0 = (size_t)b * SEQ + (size_t)n * GC;
#pragma unroll
        for (int i = 0; i < 8; ++i) { const int pc = tid + i * NTHR, cc = pc >> 5, ch = pc & 31; *(LAS v4u*)(SS + cc * VST + ch * 8) = ps[i]; }
#pragma unroll
        for (int i = 0; i < 4; ++i) { const int pc = tid + i * NTHR, t = pc >> 5, ch = pc & 31; *(LAS v4u*)(VS + t * VST + ch * 8) = pv[i]; }
#pragma unroll
        for (int i = 0; i < 2; ++i) { const int pc = tid + i * NTHR, t = pc >> 4, ch = pc & 15; *(LAS v4u*)(QhS + t * KST + ch * 8) = pq[i]; *(LAS v4u*)(KcS + t * KST + ch * 8) = pk[i]; }
        if (tid < 256) ((LAS f32x4*)glrS)[tid] = pg;
#pragma unroll
        for (int r = 0; r < 17; ++r) wg[r] = wgn[r];
#pragma unroll
        for (int i = 0; i < 8; ++i) gg[i] = ggn[i];
        gn = gnn;
        __syncthreads();
        if (it + F.G < GITEMS) GLA_C_PREFETCH(it + F.G);
        float p[16]; (void)gla_decay(tid, wg, glrS, totS, p);
        { const int c = tid & 127, tg = tid >> 7;
#pragma unroll
          for (int i = 0; i < 16; ++i) { const int t = tg * 16 + i; const float e = __expf(p[i]);
              QhS[t * KST + c] = (bf16)f2bf(bf1(QhS[t * KST + c]) * e); KcS[t * KST + c] = (bf16)f2bf(bf1(KcS[t * KST + c]) * __builtin_amdgcn_rcpf(e)); } }
        __syncthreads();
        if (F.wave < 4) { const int tb = F.wave >> 1, sb = F.wave & 1; f32x16 pa = (f32x16){};
#pragma unroll
            for (int ks = 0; ks < 8; ++ks) pa = __builtin_amdgcn_mfma_f32_32x32x16_bf16(frag_row(KcS, KST, 32 * sb, 16 * ks, lane), frag_row(QhS, KST, 32 * tb, 16 * ks, lane), pa, 0, 0, 0);
            const int t = 32 * tb + (lane & 31), hh = lane >> 5;
#pragma unroll
            for (int g = 0; g < 4; ++g) { const int s0 = 32 * sb + 8 * g + 4 * hh; v2u w;
                w.x = pk2(s0 <= t ? pa[4 * g] : 0.f, s0 + 1 <= t ? pa[4 * g + 1] : 0.f); w.y = pk2(s0 + 2 <= t ? pa[4 * g + 2] : 0.f, s0 + 3 <= t ? pa[4 * g + 3] : 0.f);
                *(LAS v2u*)(PS + t * PST + s0) = w; } }
        __syncthreads();
        f32x16 acc[2]; acc[0] = (f32x16){}; acc[1] = (f32x16){};
#pragma unroll
        for (int ks = 0; ks < 8; ++ks) { const bf16x8 aa = frag_tr(SS, VST, 16 * ks, 32 * F.wave, lane);
#pragma unroll
            for (int tb = 0; tb < 2; ++tb) acc[tb] = __builtin_amdgcn_mfma_f32_32x32x16_bf16(aa, frag_row(QhS, KST, 32 * tb, 16 * ks, lane), acc[tb], 0, 0, 0); }
#pragma unroll
        for (int ks = 0; ks < 4; ++ks) { const bf16x8 aa = frag_tr(VS, VST, 16 * ks, 32 * F.wave, lane);
#pragma unroll
            for (int tb = 0; tb < 2; ++tb) acc[tb] = __builtin_amdgcn_mfma_f32_32x32x16_bf16(aa, frag_row(PS, PST, 32 * tb, 16 * ks, lane), acc[tb], 0, 0, 0); }
        __syncthreads();
        { const int hh = lane >> 5;
#pragma unroll
          for (int tb = 0; tb < 2; ++tb)
#pragma unroll
              for (int g = 0; g < 4; ++g) *(LAS f32x4*)(oS + (32 * tb + (lane & 31)) * 260 + 32 * F.wave + 8 * g + 4 * hh) = (f32x4){acc[tb][4 * g], acc[tb][4 * g + 1], acc[tb][4 * g + 2], acc[tb][4 * g + 3]}; }
        __syncthreads();
        {
#pragma unroll
          for (int i = 0; i < 8; ++i) { const int t = 8 * F.wave + i; const f32x4 o = *(const LAS f32x4*)(oS + t * 260 + 4 * lane);
              const float ss = wave_sum((o.x * o.x + o.y * o.y) + (o.z * o.z + o.w * o.w)); const float rs = 1.f / sqrtf(ss * (1.f / GDV) + LN_EPS);
              const float g0 = bfl(gg[i].x), g1 = bfh(gg[i].x), g2 = bfl(gg[i].y), g3 = bfh(gg[i].y);
              v2u w; w.x = pk2(o.x * rs * gn.x * (g0 * sigmoidf_(g0)), o.y * rs * gn.y * (g1 * sigmoidf_(g1))); w.y = pk2(o.z * rs * gn.z * (g2 * sigmoidf_(g2)), o.w * rs * gn.w * (g3 * sigmoidf_(g3)));
              *(v2u*)(WSP(bf16, WS_GV) + (r0 + t) * 1024 + h * GDV + 4 * lane) = w; } }
        __syncthreads();
    }
#undef GLA_C_PREFETCH
}

__device__ __forceinline__ void phase9(Frame& F) {
    const int tid = tid_(), lane = tid & 63;
    LAS float* wr = (LAS float*)F.lds;
    LAS int* lcnt = (LAS int*)(F.lds + MISC_OFF);
    LAS int* rec_e = lcnt + 64; LAS int* rec_i = rec_e + 512; LAS float* rec_g = (LAS float*)(rec_i + 512);
    const int rows_per_blk = T / F.G, rows_per_wave = rows_per_blk / NWAVES;
    const int b = F.blk / (F.G / NB);
    for (int i = tid; i < 32 * 1024 / 4; i += NTHR) ((LAS f32x4*)wr)[i] = WSP(f32x4, WS_WRT)[i];
    if (tid < 64) lcnt[tid] = 0;
    __syncthreads();
    const float* modf = WSP(float, WS_MODF) + (size_t)b * 6144;
    const gfptr_t ln1g = PT(12), ln1b = PT(13);
    const int ei = lane >> 1; const float rb = PT(15)[ei];
    const int rl0 = F.wave * rows_per_wave, rowb = F.blk * rows_per_blk + rl0;
    f32x4 nx[2][4];
#pragma unroll
    for (int r = 0; r < 2; ++r)
#pragma unroll
        for (int j = 0; j < 4; ++j) nx[r][j] = ((const f32x4*)(F.out + (size_t)(rowb + r) * DM) + lane)[64 * j];
    for (int rr = 0; rr < rows_per_wave; rr += 2) {
        const int row = rowb + rr;
        f32x4 v[2][4];
#pragma unroll
        for (int r = 0; r < 2; ++r)
#pragma unroll
            for (int j = 0; j < 4; ++j) v[r][j] = nx[r][j];
        if (rr + 2 < rows_per_wave) {
#pragma unroll
            for (int r = 0; r < 2; ++r)
#pragma unroll
                for (int j = 0; j < 4; ++j) nx[r][j] = ((const f32x4*)(F.out + (size_t)(row + 2 + r) * DM) + lane)[64 * j]; }
        float rstd[2]; ln_center<2>(v, rstd);
#pragma unroll
        for (int r = 0; r < 2; ++r) { f32x4* zr = (f32x4*)(F.out + (size_t)(row + r) * DM) + lane;
#pragma unroll
            for (int j = 0; j < 4; ++j) { const f32x4 g = *(gf4ptr_t)(ln1g + 256 * j + 4 * lane), bb = *(gf4ptr_t)(ln1b + 256 * j + 4 * lane); v[r][j] = v[r][j] * rstd[r] * g + bb; zr[64 * j] = v[r][j]; } }
        ln_center<2>(v, rstd);
#pragma unroll
        for (int r = 0; r < 2; ++r) { int* o4 = (int*)(F.ws + WS_U2 + (size_t)(row + r) * DM) + lane;
#pragma unroll
            for (int j = 0; j < 4; ++j) { const f32x4 sh = *(const f32x4*)(modf + 3072 + 256 * j + 4 * lane), scv = *(const f32x4*)(modf + 4096 + 256 * j + 4 * lane);
                v[r][j] = v[r][j] * rstd[r] * (scv + 1.0f) + sh;
                int w = 0; w = __builtin_amdgcn_cvt_pk_fp8_f32(v[r][j].x, v[r][j].y, w, false); w = __builtin_amdgcn_cvt_pk_fp8_f32(v[r][j].z, v[r][j].w, w, true); o4[64 * j] = w; } }
        float p0[32], p1[32]; row_dots2<32>(v, wr, lane, p0, p1);
        float lgs[2]; lgs[0] = reduce32(p0, lane) + rb; lgs[1] = reduce32(p1, lane) + rb;
#pragma unroll
        for (int r = 0; r < 2; ++r) { float lg = lgs[r]; int ek[4]; float vk[4];
#pragma unroll
            for (int k = 0; k < 4; ++k) { const float m = wave_max(lg); const unsigned long long bal = __ballot(lg == m); const int src = __ffsll((long long)bal) - 1;
                ek[k] = src >> 1; vk[k] = m; if (ei == ek[k]) lg = -INFINITY; }
            const float w1 = __expf(vk[1] - vk[0]), w2 = __expf(vk[2] - vk[0]), w3 = __expf(vk[3] - vk[0]); const float inv = 1.f / (1.f + w1 + w2 + w3);
            if (lane < 4) { const int e = lane == 0 ? ek[0] : lane == 1 ? ek[1] : lane == 2 ? ek[2] : ek[3]; const float gk = (lane == 0 ? 1.f : lane == 1 ? w1 : lane == 2 ? w2 : w3) * inv;
                const int li = atomicAdd((int*)(lcnt + e), 1); const int rl = rl0 + rr + r;
                rec_e[rl * 4 + lane] = e; rec_i[rl * 4 + lane] = li; rec_g[rl * 4 + lane] = gk; } }
    }
    __syncthreads();
    if (tid < 32) lcnt[32 + tid] = (int)atomicAdd(WSP(unsigned, WS_CTL) + tid, (unsigned)lcnt[tid]);
    __syncthreads();
    for (int r = tid; r < rows_per_blk * 4; r += NTHR) { const int e = rec_e[r], idx = lcnt[32 + e] + rec_i[r], tok = F.blk * rows_per_blk + (r >> 2);
        WSP(int, WS_RTOK)[e * ECAP + idx] = tok; WSP(int, WS_TSLOT)[(size_t)tok * 4 + (r & 3)] = e * ECAP + idx; WSP(float, WS_TGATE)[(size_t)tok * 4 + (r & 3)] = rec_g[r]; }
    __syncthreads();
}
__device__ __forceinline__ void moe_tables(Frame& F, LAS int* tstart) {
    const int tid = tid_(), lane = tid & 63; (void)lane;
    if (tid == 0) { int run = 0; for (int e = 0; e < NEXP; ++e) { tstart[e] = run; run += (int)((WSP(unsigned, WS_CTL)[e] + 255u) >> 8); } tstart[NEXP] = run; }
    __syncthreads();
}
__device__ __forceinline__ void phase12(Frame& F) {
    const int tid = tid_(), lane = tid & 63; (void)lane;
    LAS int* tstart = (LAS int*)(F.lds + MISC_OFF);
    moe_tables(F, tstart);
    const int rows_per_blk = T / F.G, rows_per_wave = rows_per_blk / NWAVES; const int b = F.blk / (F.G / NB);
    const float* modf = WSP(float, WS_MODF) + (size_t)b * 6144;
    for (int rr = 0; rr < rows_per_wave; ++rr) {
        const int row = F.blk * rows_per_blk + F.wave * rows_per_wave + rr;
        f32x4* xr = (f32x4*)(F.out + (size_t)row * DM) + lane;
        f32x4 y[4];
#pragma unroll
        for (int j = 0; j < 4; ++j) y[j] = (f32x4){0.f, 0.f, 0.f, 0.f};
#pragma unroll
        for (int k = 0; k < 4; ++k) { const int sl = WSP(int, WS_TSLOT)[(size_t)row * 4 + k]; const float gk = WSP(float, WS_TGATE)[(size_t)row * 4 + k];
            const int e = sl >> 15, idx = sl & (ECAP - 1); const size_t srow = (size_t)tstart[e] * 256 + idx;
            const v2u* mp = (const v2u*)(WSP(bf16, WS_MOE) + srow * DM) + lane;
#pragma unroll
            for (int j = 0; j < 4; ++j) { const v2u w = mp[64 * j]; y[j].x += gk * bfl(w.x); y[j].y += gk * bfh(w.x); y[j].z += gk * bfl(w.y); y[j].w += gk * bfh(w.y); } }
        f32x4 v[4]; float s = 0.f;
#pragma unroll
        for (int j = 0; j < 4; ++j) { const f32x4 g2 = *(const f32x4*)(modf + 5120 + 256 * j + 4 * lane); v[j] = xr[64 * j] * ALPHA + (g2 + 1.0f) * y[j]; s += (v[j].x + v[j].y) + (v[j].z + v[j].w); }
        const float mean = wave_sum(s) * (1.f / DM); float s2 = 0.f;
#pragma unroll
        for (int j = 0; j < 4; ++j) { v[j] = v[j] - mean; s2 += (v[j].x * v[j].x + v[j].y * v[j].y) + (v[j].z * v[j].z + v[j].w * v[j].w); }
        const float rstd = 1.f / sqrtf(wave_sum(s2) * (1.f / DM) + LN_EPS);
#pragma unroll
        for (int j = 0; j < 4; ++j) { const f32x4 g = *(gf4ptr_t)(PT(20) + 256 * j + 4 * lane), bb = *(gf4ptr_t)(PT(21) + 256 * j + 4 * lane); xr[64 * j] = v[j] * rstd * g + bb; }
    }
}

constexpr int NPHASE = 13;
__global__ void __launch_bounds__(NTHR, 2) fwd_kernel(Args args) {
    extern __shared__ __attribute__((aligned(16))) unsigned char lds[];
    Frame F;
    F.lds = (LAS unsigned char*)lds; F.wave = __builtin_amdgcn_readfirstlane((int)threadIdx.x >> 6); F.G = gridDim.x; F.blk = blockIdx.x;
    F.out = args.out; F.ws = args.ws;
    const int lo = args.ph_lo, hi = args.ph_hi;
#ifndef PROBE_PH
#define PROBE_PH (-1)
#endif
    unsigned long long tp0 = 0, tp1 = 0;
#define STAMP0(k) do { if ((k) == PROBE_PH) tp0 = __builtin_amdgcn_s_memrealtime(); } while (0)
#define STAMP1(k) do { if ((k) == PROBE_PH) tp1 = __builtin_amdgcn_s_memrealtime(); } while (0)
#ifndef PH_MASK
#define PH_MASK 0xffff
#endif
#define IN(k) (((PH_MASK >> (k)) & 1) && lo <= (k) && (k) < hi)
#if MK_N_LAUNCHES == 1
    if (threadIdx.x < 2) ((LAS unsigned*)(F.lds + BARLDS_OFF))[threadIdx.x] = 0u;
    __syncthreads();
    const XcdBarrier bar = xcd_barrier_post(WSP(unsigned, WS_CTL) + CW_BAR, (volatile LAS unsigned*)(F.lds + BARLDS_OFF));
#define SEAM(k) do { if (IN(k) && IN((k) + 1)) { if ((k) == 0) cg::this_grid().sync(); else xcd_barrier(bar); } } while (0)
#else
#define SEAM(k) do { } while (0)
#endif
    typedef pg8::bf16_t pbf;
    STAMP0(0); if (IN(0)) { phase0(F, args); } SEAM(0); STAMP1(0);
    STAMP0(1); if (IN(1)) { phase1(F, args); } SEAM(1); STAMP1(1);
    STAMP0(2); if (IN(2)) {
        pg8::Gemm g{WSP(pbf, WS_U), WSP(pbf, WS_WIN), 1024, nullptr, 0, 0}; pg8::DenseOrder S{T / 256, NPROJ / 256, F.G, F.blk};
        pg8::EpiInProj E{WSP(pbf, WS_FQ), WSP(pbf, WS_FK), WSP(pbf, WS_FV), WSP(pbf, WS_GQ), WSP(pbf, WS_GK), WSP(pbf, WS_GV), WSP(pbf, WS_GR), WSP(pbf, WS_GA), WSP(pbf, WS_GB), 0.125f * LOG2E, 0.08838834764831845f};
        pg8::gemm_phase<pg8::EpiInProj, pg8::DenseOrder, false, true>(F.lds, g, S, E);
    } SEAM(2); STAMP1(2);
    STAMP0(3); if (IN(3)) { phase3(F); } SEAM(3); STAMP1(3);
    STAMP0(4); if (IN(4)) {
        gla_scan(F);
        __syncthreads();
        const attn_body::AttnTensors AT{(const attn_body::bf16*)WSP(pbf, WS_FQ), (const attn_body::bf16*)WSP(pbf, WS_FK), (const attn_body::bf16*)WSP(pbf, WS_FV), (attn_body::bf16*)WSP(pbf, WS_FQ), WSP(float, WS_CUM), WSP(unsigned, WS_CTL) + CW_QKM};
        const attn_body::StaticOrder S((int)F.G, (int)F.blk);
        attn_body::attn_phase<attn_body::StaticOrder>((char*)lds, AT, S);
    } SEAM(4); STAMP1(4);
    STAMP0(5); if (IN(5)) { gla_out_phase(F); } SEAM(5); STAMP1(5);
    STAMP0(6); if (IN(6)) {
        pg8::Gemm g{WSP(pbf, WS_FQ), WSP(pbf, WS_WA), 512, nullptr, 0, 0}; pg8::DenseOrder S{T / 256, 4, F.G, F.blk};
        pg8::EpiGate<false> E{WSP(pbf, WS_U), WSP(pbf, WS_GA)};
        pg8::gemm_phase<pg8::EpiGate<false>, pg8::DenseOrder, false, true>(F.lds, g, S, E);
    }
    if (IN(6) && IN(7)) { __syncthreads(); } STAMP1(6);
    STAMP0(7); if (IN(7)) {
        pg8::Gemm g{WSP(pbf, WS_GV), WSP(pbf, WS_WB), 1024, nullptr, 0, 0}; pg8::DenseOrder S{T / 256, 4, F.G, F.blk};
        pg8::EpiGate<true> E{WSP(pbf, WS_U), WSP(pbf, WS_GB)};
        pg8::gemm_phase<pg8::EpiGate<true>, pg8::DenseOrder, false, true>(F.lds, g, S, E);
    } SEAM(7); STAMP1(7);
    STAMP0(8); if (IN(8)) {
        pg8::Gemm g{WSP(pbf, WS_U), WSP(pbf, WS_WO), 1024, nullptr, 0, 0}; pg8::DenseOrder S{T / 256, 4, F.G, F.blk};
        pg8::EpiResid E{PT(0), F.out, WSP(float, WS_MODF) + 2048, 6144, SEQ, ALPHA};
        pg8::gemm_phase<pg8::EpiResid, pg8::DenseOrder, false, true>(F.lds, g, S, E);
    } SEAM(8); STAMP1(8);
    STAMP0(9); if (IN(9)) { phase9(F); } SEAM(9); STAMP1(9);
    STAMP0(10); if (IN(10)) {
        LAS int* tstart = (LAS int*)(F.lds + MISC_OFF); moe_tables(F, tstart);
        pg8::Gemm g{WSP(pbf, WS_U2), WSP(pbf, WS_WUP), 512, WSP(int, WS_RTOK), 0x7f7f7f7f, 0x7a7a7a7a}; pg8::MoeOrder S{tstart[NEXP], 8, F.G, F.blk, tstart};
        pg8::EpiSwiglu<true> E{WSP(pbf, WS_ACT), PT(17), 8};
        pg8::gemm_phase<pg8::EpiSwiglu<true>, pg8::MoeOrder, true, true, true>(F.lds, g, S, E);
    } SEAM(10); STAMP1(10);
    STAMP0(11); if (IN(11)) {
        LAS int* tstart = (LAS int*)(F.lds + MISC_OFF); moe_tables(F, tstart);
        pg8::Gemm g{WSP(pbf, WS_ACT), WSP(pbf, WS_WDN), 512, nullptr, 0x7f7f7f7f, 0x79797979}; pg8::MoeOrder S{tstart[NEXP], 4, F.G, F.blk, tstart};
        pg8::EpiDown E{WSP(pbf, WS_MOE), PT(19), 4};
        pg8::gemm_phase<pg8::EpiDown, pg8::MoeOrder, false, true, true>(F.lds, g, S, E);
    } SEAM(11); STAMP1(11);
    STAMP0(12); if (IN(12)) { phase12(F); } STAMP1(12);
    if (PROBE_PH >= 0 && F.blk == 0) { const unsigned long long te = __builtin_amdgcn_s_memrealtime(), dd = 9ull * (tp1 - tp0); while (__builtin_amdgcn_s_memrealtime() - te < dd) __builtin_amdgcn_s_sleep(32); }
#undef IN
#undef SEAM
}

extern "C" void kernel_launch(void* const* d_in, const int* in_sizes, int n_in, void* d_out, int out_size, void* d_ws, size_t ws_size, hipStream_t stream) {
    static int grid = 0;
    if (grid == 0) {
        if (n_in != 22 || in_sizes[0] != T * DM || out_size != T * DM || ws_size < WS_END) { fprintf(stderr, "kernel_launch: unexpected shapes (n_in %d, x %d, out %d, ws %zu < %zu); nothing launched\n", n_in, n_in > 0 ? in_sizes[0] : -1, out_size, ws_size, (size_t)WS_END); grid = -1; return; }
        int dev = 0, cus = 0, per_cu = 0;
        if (hipGetDevice(&dev) != hipSuccess || hipDeviceGetAttribute(&cus, hipDeviceAttributeMultiprocessorCount, dev) != hipSuccess) { grid = -1; return; }
        if (hipFuncSetAttribute((const void*)fwd_kernel, hipFuncAttributeMaxDynamicSharedMemorySize, LDS_BYTES) != hipSuccess) { fprintf(stderr, "kernel_launch: hipFuncSetAttribute failed\n"); grid = -1; return; }
        if (hipOccupancyMaxActiveBlocksPerMultiprocessor(&per_cu, (const void*)fwd_kernel, NTHR, LDS_BYTES) != hipSuccess || per_cu < 1) { fprintf(stderr, "kernel_launch: occupancy query says %d blocks per CU\n", per_cu); (void)hipGetLastError(); grid = -1; return; }
        grid = cus;
        if (grid != 256) { fprintf(stderr, "kernel_launch: built for a 256-CU device, found %d CUs; nothing launched\n", cus); grid = -1; return; }
    }
    if (grid < 0) return;
    if (hipMemsetAsync((char*)d_ws + WS_CTL, 0, CTL_ZERO_BYTES, stream) != hipSuccess) { fprintf(stderr, "kernel_launch: hipMemsetAsync failed\n"); return; }
    Args a{};
    for (int i = 0; i < 22; ++i) a.in[i] = (const float*)d_in[i];
    a.out = (float*)d_out; a.ws = (unsigned char*)d_ws;
#if MK_N_LAUNCHES == 1
    a.ph_lo = 0; a.ph_hi = NPHASE;
    void* kargs[] = {&a};
    hipError_t e = hipLaunchCooperativeKernel((const void*)fwd_kernel, dim3(grid), dim3(NTHR), kargs, LDS_BYTES, stream);
    if (e != hipSuccess) fprintf(stderr, "kernel_launch: cooperative launch failed: %s\n", hipGetErrorString(e));
#else
    for (int p = 0; p < NPHASE; ++p) {
        if (p == 7) continue;
        a.ph_lo = p; a.ph_hi = (p == 6) ? 8 : p + 1;
        hipLaunchKernelGGL(fwd_kernel, dim3(grid), dim3(NTHR), LDS_BYTES, stream, a);
    }
#endif
}
```

```cpp
#include <hip/hip_runtime.h>
#include <hip/hip_bf16.h>
#include <hip/hip_cooperative_groups.h>
#include <cstdio>
#include <cstdint>
#include <cmath>
namespace cg = cooperative_groups;

#ifndef MK_N_LAUNCHES
#define MK_N_LAUNCHES 1
#endif

namespace pg8 {
#define PG8_LAS __attribute__((address_space(3)))
#define PG8_GAS __attribute__((address_space(1)))
typedef unsigned short bf16_t;
typedef short bf16x8 __attribute__((ext_vector_type(8)));
typedef float f32x4 __attribute__((ext_vector_type(4)));
typedef float f32x2 __attribute__((ext_vector_type(2)));
typedef unsigned u32x4 __attribute__((ext_vector_type(4)));
constexpr int BM = 256, BK = 64, HALF = 128, HTB = HALF * BK * 2, STAGE_BYTES = 8 * HTB, NXCD = 8, WGM = 8;

__host__ __device__ __forceinline__ int lds_byte(int r, int c) { const int st = (r >> 4) * 2 + (c >> 5), rr = r & 15, cc = c & 31, ob = rr * 64 + cc * 2; return st * 1024 + (ob ^ (((ob >> 9) & 1) << 5)); }
__host__ __device__ __forceinline__ void stage_rc(int b, int& R, int& C) { const int st = b / 1024, sb = b % 1024, swz = sb ^ (((sb >> 9) & 1) << 5); R = (st >> 1) * 16 + swz / 64; C = (st & 1) * 32 + (swz % 64) / 2; }
__host__ __device__ __forceinline__ int perm32(int rho) { const int n = rho >> 4, i = rho & 15; return 8 * (i >> 2) + 4 * n + (i & 3); }

struct Unit { int pm, pn, e, rl; };
struct Gemm { const bf16_t* A; const bf16_t* Bt; int K; const int* rows; int sclA, sclB; };
typedef int v8i_t __attribute__((ext_vector_type(8)));

__device__ __forceinline__ bool tile_of(long L, int nM, int nN, int& pm, int& pn) {
    const int nwg = nM * nN; if (L >= nwg) return false;
    int wgid = (int)L; { const int q = nwg / NXCD, r = nwg % NXCD, xcd = wgid % NXCD, off = wgid / NXCD; wgid = (xcd < r ? xcd * (q + 1) : r * (q + 1) + (xcd - r) * q) + off; }
    const int nig = WGM * nN, gid = wgid / nig, fm = gid * WGM, gsz = (nM - fm) < WGM ? (nM - fm) : WGM;
    pm = fm + ((wgid % nig) % gsz); pn = (wgid % nig) / gsz; return true;
}
struct DenseOrder {
    int nM, nN, G, c;
    __device__ __forceinline__ bool next(int i, Unit& u) const { u.e = 0; u.rl = 0; return tile_of((long)i * G + c, nM, nN, u.pm, u.pn); }
};
struct MoeOrder {
    int nM, nN, G, c; const PG8_LAS int* tstart;
    __device__ __forceinline__ bool next(int i, Unit& u) const {
        int rt, pnl; if (!tile_of((long)i * G + c, nM, nN, rt, pnl)) return false;
        int e = 0;
#pragma unroll 1
        for (int j = 1; j < 32; ++j) if (tstart[j] <= rt) e = j;
        u.pm = rt; u.e = e; u.pn = e * nN + pnl; u.rl = e * 32768 + (rt - tstart[e]) * 256; return true;
    }
};

__device__ __forceinline__ unsigned cvt_pk_bf16(float lo, float hi) { unsigned r; asm volatile("v_cvt_pk_bf16_f32 %0, %1, %2" : "=v"(r) : "v"(lo), "v"(hi)); return r; }
__device__ __forceinline__ float bf_lo(unsigned w) { return __uint_as_float(w << 16); }
__device__ __forceinline__ float bf_hi(unsigned w) { return __uint_as_float(w & 0xffff0000u); }
__device__ __forceinline__ float sigm(float x) { return 1.0f / (1.0f + __expf(-x)); }


struct EpiInProj {
    static constexpr bool PERM = true;
    bf16_t *fq, *fk, *fv, *gq, *gk, *gv, *gr, *ga, *gb; float qscale, gqscale;
    __device__ __forceinline__ void operator()(const f32x4 (&acc)[2][2][4][2], const Unit& u, int wr, int wc, int fr, int fq_) const {
        const int pn = u.pn; bf16_t* base; int ldc, ct; float sc = 1.f; bool sg = false;
        if (pn < 2) { base = fq; ldc = 512; ct = pn; sc = qscale; } else if (pn < 4) { base = fk; ldc = 512; ct = pn - 2; } else if (pn < 6) { base = fv; ldc = 512; ct = pn - 4; }
        else if (pn < 8) { base = gq; ldc = 512; ct = pn - 6; sc = gqscale; } else if (pn < 10) { base = gk; ldc = 512; ct = pn - 8; }
        else if (pn < 14) { base = gv; ldc = 1024; ct = pn - 10; } else if (pn < 18) { base = gr; ldc = 1024; ct = pn - 14; }
        else if (pn < 22) { base = ga; ldc = 1024; ct = pn - 18; sg = true; } else { base = gb; ldc = 1024; ct = pn - 22; sg = true; }
        const int row0 = u.pm * BM + wr * 64 + fr, col0 = ct * BM + wc * 32 + 8 * fq_;
#pragma unroll
        for (int ai = 0; ai < 2; ++ai)
#pragma unroll
            for (int m = 0; m < 4; ++m) { bf16_t* rowp = base + (size_t)(row0 + ai * HALF + m * 16) * ldc + col0;
#pragma unroll
                for (int bj = 0; bj < 2; ++bj) { f32x4 v0 = acc[ai][bj][m][0], v1 = acc[ai][bj][m][1];
                    if (sg) {
#pragma unroll
                        for (int i = 0; i < 4; ++i) { v0[i] = sigm(v0[i]); v1[i] = sigm(v1[i]); } }
                    else { v0 = v0 * sc; v1 = v1 * sc; }
                    u32x4 w; w.x = cvt_pk_bf16(v0[0], v0[1]); w.y = cvt_pk_bf16(v0[2], v0[3]); w.z = cvt_pk_bf16(v1[0], v1[1]); w.w = cvt_pk_bf16(v1[2], v1[3]);
                    *(u32x4*)(rowp + bj * HALF) = w; } }
    }
};
template <bool ADD> struct EpiGate {
    static constexpr bool PERM = true;
    bf16_t* O; const bf16_t* gate;
    __device__ __forceinline__ void operator()(const f32x4 (&acc)[2][2][4][2], const Unit& u, int wr, int wc, int fr, int fq_) const {
        const int row0 = u.pm * BM + wr * 64 + fr, col0 = u.pn * BM + wc * 32 + 8 * fq_;
#pragma unroll
        for (int ai = 0; ai < 2; ++ai)
#pragma unroll
            for (int m = 0; m < 4; ++m) { const size_t off = (size_t)(row0 + ai * HALF + m * 16) * 1024 + col0;
#pragma unroll
                for (int bj = 0; bj < 2; ++bj) { const f32x4 a0 = acc[ai][bj][m][0], a1 = acc[ai][bj][m][1];
                    const u32x4 g = *(const u32x4*)(gate + off + bj * HALF);
                    float r[8] = { a0[0] * bf_lo(g.x), a0[1] * bf_hi(g.x), a0[2] * bf_lo(g.y), a0[3] * bf_hi(g.y), a1[0] * bf_lo(g.z), a1[1] * bf_hi(g.z), a1[2] * bf_lo(g.w), a1[3] * bf_hi(g.w) };
                    if (ADD) { const u32x4 o = *(const u32x4*)(O + off + bj * HALF);
                        r[0] += bf_lo(o.x); r[1] += bf_hi(o.x); r[2] += bf_lo(o.y); r[3] += bf_hi(o.y); r[4] += bf_lo(o.z); r[5] += bf_hi(o.z); r[6] += bf_lo(o.w); r[7] += bf_hi(o.w); }
                    u32x4 w; w.x = cvt_pk_bf16(r[0], r[1]); w.y = cvt_pk_bf16(r[2], r[3]); w.z = cvt_pk_bf16(r[4], r[5]); w.w = cvt_pk_bf16(r[6], r[7]);
                    *(u32x4*)(O + off + bj * HALF) = w; } }
    }
};
struct EpiResid {
    static constexpr bool PERM = false;
    const PG8_GAS float* x; float* z; const float* g1; int g1_bstride; int rows_per_batch; float alpha;
    __device__ __forceinline__ void operator()(const f32x4 (&acc)[2][2][4][2], const Unit& u, int wr, int wc, int fr, int fq_) const {
        const int row0 = u.pm * BM + wr * 64 + fr, col0 = u.pn * BM + wc * 32 + 4 * fq_;
        const float* gp = g1 + (size_t)((u.pm * BM) / rows_per_batch) * g1_bstride + col0;
        f32x4 gv[2][2];
#pragma unroll
        for (int bj = 0; bj < 2; ++bj)
#pragma unroll
            for (int n = 0; n < 2; ++n) gv[bj][n] = *(const f32x4*)(gp + bj * HALF + n * 16) + 1.0f;
#pragma unroll
        for (int ai = 0; ai < 2; ++ai)
#pragma unroll
            for (int m = 0; m < 4; ++m) { const size_t off = (size_t)(row0 + ai * HALF + m * 16) * 1024 + col0;
#pragma unroll
                for (int bj = 0; bj < 2; ++bj)
#pragma unroll
                    for (int n = 0; n < 2; ++n) { const f32x4 xv = *(const PG8_GAS f32x4*)(x + off + bj * HALF + n * 16);
                        *(f32x4*)(z + off + bj * HALF + n * 16) = xv * alpha + gv[bj][n] * acc[ai][bj][m][n]; } }
    }
};
template <bool OUT8> struct EpiSwiglu {
    static constexpr bool PERM = true;
    bf16_t* act; const PG8_GAS float* b_up; int nNe;
    __device__ __forceinline__ void operator()(const f32x4 (&acc)[2][2][4][2], const Unit& u, int wr, int wc, int fr, int fq_) const {
        const int pnl = u.pn - u.e * nNe; const int row0 = u.pm * BM + wr * 64 + fr, cl = pnl * HALF + wc * 32 + 8 * fq_;
        const PG8_GAS float* bp = b_up + (size_t)u.e * 2048 + cl;
        const f32x4 bg0 = *(const PG8_GAS f32x4*)(bp), bg1 = *(const PG8_GAS f32x4*)(bp + 4), bl0 = *(const PG8_GAS f32x4*)(bp + 1024), bl1 = *(const PG8_GAS f32x4*)(bp + 1028);
#pragma unroll
        for (int ai = 0; ai < 2; ++ai)
#pragma unroll
            for (int m = 0; m < 4; ++m) {
                f32x4 g0 = acc[ai][0][m][0] + bg0, g1 = acc[ai][0][m][1] + bg1, l0 = acc[ai][1][m][0] + bl0, l1 = acc[ai][1][m][1] + bl1; float r[8];
#pragma unroll
                for (int i = 0; i < 4; ++i) { float g = fminf(g0[i], 7.0f), l = fminf(fmaxf(l0[i], -7.0f), 7.0f); r[i] = g * sigm(1.702f * g) * (l + 1.0f);
                    g = fminf(g1[i], 7.0f); l = fminf(fmaxf(l1[i], -7.0f), 7.0f); r[4 + i] = g * sigm(1.702f * g) * (l + 1.0f); }
                if constexpr (OUT8) { int w0 = 0, w1 = 0; w0 = __builtin_amdgcn_cvt_pk_fp8_f32(r[0], r[1], w0, false); w0 = __builtin_amdgcn_cvt_pk_fp8_f32(r[2], r[3], w0, true);
                    w1 = __builtin_amdgcn_cvt_pk_fp8_f32(r[4], r[5], w1, false); w1 = __builtin_amdgcn_cvt_pk_fp8_f32(r[6], r[7], w1, true);
                    typedef int v2i_t __attribute__((ext_vector_type(2)));
                    *(v2i_t*)((unsigned char*)act + (size_t)(row0 + ai * HALF + m * 16) * 1024 + cl) = (v2i_t){w0, w1}; }
                else { u32x4 w; w.x = cvt_pk_bf16(r[0], r[1]); w.y = cvt_pk_bf16(r[2], r[3]); w.z = cvt_pk_bf16(r[4], r[5]); w.w = cvt_pk_bf16(r[6], r[7]);
                    *(u32x4*)(act + (size_t)(row0 + ai * HALF + m * 16) * 1024 + cl) = w; } }
    }
};
struct EpiDown {
    static constexpr bool PERM = true;
    bf16_t* O; const PG8_GAS float* b_down; int nNe;
    __device__ __forceinline__ void operator()(const f32x4 (&acc)[2][2][4][2], const Unit& u, int wr, int wc, int fr, int fq_) const {
        const int pnl = u.pn - u.e * nNe; const int row0 = u.pm * BM + wr * 64 + fr, col0 = pnl * BM + wc * 32 + 8 * fq_;
        const PG8_GAS float* bp = b_down + (size_t)u.e * 1024 + col0;
        f32x4 bv[2][2];
#pragma unroll
        for (int bj = 0; bj < 2; ++bj)
#pragma unroll
            for (int n = 0; n < 2; ++n) bv[bj][n] = *(const PG8_GAS f32x4*)(bp + bj * HALF + 4 * n);
#pragma unroll
        for (int ai = 0; ai < 2; ++ai)
#pragma unroll
            for (int m = 0; m < 4; ++m) { bf16_t* rowp = O + (size_t)(row0 + ai * HALF + m * 16) * 1024 + col0;
#pragma unroll
                for (int bj = 0; bj < 2; ++bj) { const f32x4 v0 = acc[ai][bj][m][0] + bv[bj][0], v1 = acc[ai][bj][m][1] + bv[bj][1];
                    u32x4 w; w.x = cvt_pk_bf16(v0[0], v0[1]); w.y = cvt_pk_bf16(v0[2], v0[3]); w.z = cvt_pk_bf16(v1[0], v1[1]); w.w = cvt_pk_bf16(v1[2], v1[3]);
                    *(u32x4*)(rowp + bj * HALF) = w; } }
    }
};

template <class Epi, class Sched, bool GATHER, bool ALIGN_EPI, bool FP8 = false>
__device__ __forceinline__ void gemm_phase(PG8_LAS unsigned char* lds, const Gemm g, const Sched& S, const Epi& E) {
    int tid_l = threadIdx.x; asm volatile("" : "+v"(tid_l));
    const int tid = tid_l, wid = __builtin_amdgcn_readfirstlane(tid >> 6), lane = tid & 63, wr = wid >> 2, wc = wid & 3, fr = lane & 15, fq = lane >> 4;
    const int K = g.K, nt = K / BK;
    unsigned voffB[2], vA0[2], vA1[2], nA0[2], nA1[2];
#pragma unroll
    for (int i = 0; i < 2; ++i) { int R, C; stage_rc(tid * 16 + i * 8192, R, C); const int Rb = Epi::PERM ? ((R & ~31) + perm32(R & 31)) : R;
        voffB[i] = (unsigned)(Rb * K + C) * 2u; vA0[i] = vA1[i] = nA0[i] = nA1[i] = (unsigned)(R * K + C) * 2u; }
    const size_t kstep = (size_t)(BK * 2);
    const size_t hstep = (size_t)HALF * K * 2;
    const size_t tstep = 2 * hstep;
    const size_t hsA = GATHER ? 0 : hstep;
    const unsigned ldsw = (unsigned)wid * 1024u;
    const int aoff = lds_byte(wr * 64 + fr, fq * 8), boff = lds_byte(wc * 32 + fr, fq * 8);
#define PG8_SA(b, h) (((b) * 2 + (h)) * HTB)
#define PG8_SB(b, h) ((4 + (b) * 2 + (h)) * HTB)
#define PG8_STAGE(bufoff, gbase, voff) do { _Pragma("unroll") for (int _i = 0; _i < 2; ++_i) \
        __builtin_amdgcn_global_load_lds((const unsigned*)((const char*)(gbase) + (voff)[_i]), (PG8_LAS unsigned*)(lds + (bufoff) + ldsw + _i * 8192), 16, 0, 0); } while (0)
#define PG8_LD8(dst8, addr) do { const u32x4 lo_ = *(const PG8_LAS u32x4*)(addr), hi_ = *(const PG8_LAS u32x4*)((addr) + 1024); \
        dst8 = (v8i_t){(int)lo_[0], (int)lo_[1], (int)lo_[2], (int)lo_[3], (int)hi_[0], (int)hi_[1], (int)hi_[2], (int)hi_[3]}; } while (0)
#define PG8_LDA(dst, b, h) do { if constexpr (FP8) { _Pragma("unroll") for (int m = 0; m < 4; ++m) PG8_LD8(dst##8[m], lds + PG8_SA(b, h) + aoff + m * 2048); } \
        else { _Pragma("unroll") for (int m = 0; m < 4; ++m) _Pragma("unroll") for (int k = 0; k < 2; ++k) dst[m][k] = *(const PG8_LAS bf16x8*)(lds + PG8_SA(b, h) + aoff + m * 2048 + k * 1024); } } while (0)
#define PG8_LDB(dst, b, h) do { if constexpr (FP8) { _Pragma("unroll") for (int n = 0; n < 2; ++n) PG8_LD8(dst##8[n], lds + PG8_SB(b, h) + boff + n * 2048); } \
        else { _Pragma("unroll") for (int n = 0; n < 2; ++n) _Pragma("unroll") for (int k = 0; k < 2; ++k) dst[n][k] = *(const PG8_LAS bf16x8*)(lds + PG8_SB(b, h) + boff + n * 2048 + k * 1024); } } while (0)
#define PG8_MMA(ai, bj, At, Bt) do { __builtin_amdgcn_s_setprio(1); \
        if constexpr (FP8) { _Pragma("unroll") for (int m = 0; m < 4; ++m) { _Pragma("unroll") for (int n = 0; n < 2; ++n) \
              \
            asm volatile("v_mfma_scale_f32_16x16x128_f8f6f4 %0, %1, %2, %0, %3, %4 op_sel_hi:[0,0,0]" : "+v"(acc[ai][bj][m][n]) : "v"(Bt##8[n]), "v"(At##8[m]), "v"(sclB_v), "v"(sclA_v)); } } \
        else { _Pragma("unroll") for (int m = 0; m < 4; ++m) _Pragma("unroll") for (int n = 0; n < 2; ++n) _Pragma("unroll") for (int k = 0; k < 2; ++k) \
            acc[ai][bj][m][n] = __builtin_amdgcn_mfma_f32_16x16x32_bf16(Bt[n][k], At[m][k], acc[ai][bj][m][n], 0, 0, 0); } \
        __builtin_amdgcn_s_setprio(0); } while (0)
#define PG8_WAIT_V(n) asm volatile("s_waitcnt vmcnt(" #n ")" ::: "memory")
#define PG8_WAIT_L(n) asm volatile("s_waitcnt lgkmcnt(" #n ")" ::: "memory")
#define PG8_BAR __builtin_amdgcn_s_barrier()
#define PG8_SCHED __builtin_amdgcn_sched_barrier(0)
#define PG8_GOFFS(u, o0, o1) do { if constexpr (GATHER) { _Pragma("unroll") for (int _i = 0; _i < 2; ++_i) { int R_, C_; stage_rc(tid * 16 + _i * 8192, R_, C_); \
        const int t0_ = g.rows[(u).rl + R_], t1_ = g.rows[(u).rl + HALF + R_]; \
        o0[_i] = (unsigned)(t0_ * K + C_) * 2u; o1[_i] = (unsigned)(t1_ * K + C_) * 2u; } } } while (0)
    Unit cur, nxt; int ui = 0;
    if (!S.next(0, cur)) return;
    f32x4 acc[2][2][4][2];
#pragma unroll
    for (int a = 0; a < 2; ++a)
#pragma unroll
        for (int b = 0; b < 2; ++b)
#pragma unroll
            for (int m = 0; m < 4; ++m)
#pragma unroll
                for (int n = 0; n < 2; ++n) acc[a][b][m][n] = (f32x4){0.f, 0.f, 0.f, 0.f};
    bf16x8 At[4][2], B0[2][2], B1[2][2]; v8i_t At8[4], B08[2], B18[2]; const int sclA_v = g.sclA, sclB_v = g.sclB; (void)sclA_v; (void)sclB_v;
    const char* cA = (const char*)g.A + (GATHER ? (size_t)0 : (size_t)cur.pm * tstep); const char* cB = (const char*)g.Bt + (size_t)cur.pn * tstep;
    PG8_GOFFS(cur, vA0, vA1);
    PG8_STAGE(PG8_SB(0, 0), cB, voffB); PG8_STAGE(PG8_SB(0, 1), cB + hstep, voffB); PG8_STAGE(PG8_SA(0, 0), cA, vA0); PG8_STAGE(PG8_SA(0, 1), cA + hsA, vA1);
    if (wr == 1) PG8_BAR;
    PG8_WAIT_V(2); PG8_BAR;
    PG8_STAGE(PG8_SB(1, 0), cB + kstep, voffB); PG8_STAGE(PG8_SA(1, 0), cA + kstep, vA0); PG8_STAGE(PG8_SB(1, 1), cB + hstep + kstep, voffB);
    PG8_WAIT_V(6); PG8_BAR;
    for (;;) {
        const bool has_next = S.next(ui + 1, nxt);
        const char* nA = has_next ? (const char*)g.A + (GATHER ? (size_t)0 : (size_t)nxt.pm * tstep) : cA; const char* nB = has_next ? (const char*)g.Bt + (size_t)nxt.pn * tstep : cB;
        if constexpr (GATHER) { if (has_next) { PG8_GOFFS(nxt, nA0, nA1); } else {
#pragma unroll
            for (int i = 0; i < 2; ++i) { nA0[i] = vA0[i]; nA1[i] = vA1[i]; } } }
        for (int t = 0; t < nt; t += 2) {
            const bool last = (t == nt - 2);
            const char* a1 = cA + (size_t)(t + 1) * kstep;
            const char* a2 = last ? nA : cA + (size_t)(t + 2) * kstep; const char* b2 = last ? nB : cB + (size_t)(t + 2) * kstep;
            const char* a3 = a2 + kstep; const char* b3 = b2 + kstep;
            unsigned s0[2], s1[2];
#pragma unroll
            for (int i = 0; i < 2; ++i) { s0[i] = (GATHER && last) ? nA0[i] : vA0[i]; s1[i] = (GATHER && last) ? nA1[i] : vA1[i]; }
            PG8_LDB(B0, 0, 0); PG8_LDB(B1, 0, 1); PG8_SCHED; PG8_LDA(At, 0, 0); PG8_STAGE(PG8_SA(1, 1), a1 + hsA, vA1);
            PG8_WAIT_V(8); PG8_WAIT_L(0); PG8_BAR; PG8_MMA(0, 0, At, B0); PG8_MMA(0, 1, At, B1); PG8_BAR; PG8_SCHED;
            PG8_LDA(At, 0, 1); PG8_STAGE(PG8_SB(0, 0), b2, voffB); PG8_STAGE(PG8_SB(0, 1), b2 + hstep, voffB); PG8_STAGE(PG8_SA(0, 0), a2, s0);
            PG8_WAIT_V(8); PG8_WAIT_L(0); PG8_BAR; PG8_MMA(1, 0, At, B0); PG8_MMA(1, 1, At, B1); PG8_BAR; PG8_SCHED;
            PG8_LDB(B0, 1, 0); PG8_LDB(B1, 1, 1); PG8_SCHED; PG8_LDA(At, 1, 0); PG8_STAGE(PG8_SA(0, 1), a2 + hsA, s1);
            PG8_WAIT_V(8); PG8_WAIT_L(0); PG8_BAR; PG8_MMA(0, 0, At, B0); PG8_MMA(0, 1, At, B1); PG8_BAR; PG8_SCHED;
            PG8_LDA(At, 1, 1); PG8_STAGE(PG8_SB(1, 0), b3, voffB); PG8_STAGE(PG8_SB(1, 1), b3 + hstep, voffB); PG8_STAGE(PG8_SA(1, 0), a3, s0);
            PG8_WAIT_V(8); PG8_WAIT_L(0); PG8_BAR; PG8_MMA(1, 0, At, B0); PG8_MMA(1, 1, At, B1); PG8_BAR; PG8_SCHED;
        }
        if constexpr (ALIGN_EPI) { if (wr == 0) PG8_BAR; }
        if constexpr (FP8) {
#pragma unroll
            for (int a = 0; a < 2; ++a)
#pragma unroll
                for (int b = 0; b < 2; ++b) asm volatile("s_nop 15\n\ts_nop 7" : "+v"(acc[a][b][0][0]), "+v"(acc[a][b][0][1]), "+v"(acc[a][b][1][0]), "+v"(acc[a][b][1][1]), "+v"(acc[a][b][2][0]), "+v"(acc[a][b][2][1]), "+v"(acc[a][b][3][0]), "+v"(acc[a][b][3][1])); }
        E(acc, cur, wr, wc, fr, fq);
        if (!has_next) break;
#pragma unroll
        for (int a = 0; a < 2; ++a)
#pragma unroll
            for (int b = 0; b < 2; ++b)
#pragma unroll
                for (int m = 0; m < 4; ++m)
#pragma unroll
                    for (int n = 0; n < 2; ++n) acc[a][b][m][n] = (f32x4){0.f, 0.f, 0.f, 0.f};
        cur = nxt; cA = nA; cB = nB; ++ui;
        if constexpr (GATHER) {
#pragma unroll
            for (int i = 0; i < 2; ++i) { vA0[i] = nA0[i]; vA1[i] = nA1[i]; } }
        if constexpr (ALIGN_EPI) { if (wr == 1) PG8_BAR; }
    }
    PG8_WAIT_V(0);
    if constexpr (!ALIGN_EPI) { if (wr == 0) PG8_BAR; }
    PG8_BAR;
#undef PG8_SA
#undef PG8_SB
#undef PG8_STAGE
#undef PG8_LDA
#undef PG8_LDB
#undef PG8_MMA
#undef PG8_LD8
#undef PG8_WAIT_V
#undef PG8_WAIT_L
#undef PG8_BAR
#undef PG8_SCHED
#undef PG8_GOFFS
}
}
#include <hip/hip_bf16.h>
#include <cmath>
namespace attn_body {
using bf16=__hip_bfloat16;
using bf16x8=__attribute__((ext_vector_type(8)))short;
using s16x4=__attribute__((ext_vector_type(4)))short;
using f32x16=__attribute__((ext_vector_type(16)))float;
using u32x4=__attribute__((ext_vector_type(4)))unsigned;
constexpr int BATCH=4,NHEAD=8,SEQ=8192,D=64,DM=NHEAD*D;
constexpr int NW=8,QBLK=32,QB=QBLK*NW,KVBLK=64,NQB=SEQ/QB;
constexpr int ATTN_PITCH=DM, ATTN_UNIT_ROWS=QB;
__device__ __forceinline__ int crow(int r,int hi){return (r&3)+8*(r>>2)+4*hi;}
#define SBAR() __builtin_amdgcn_sched_barrier(0)
__device__ __forceinline__ void cmask(f32x16&p0,f32x16&p1,int jb,int qrel,int hi){
  const float NEG=-INFINITY; int kb=64*jb+4*hi;
  #pragma unroll
  for(int r=0;r<16;++r){int kv=kb+(r&3)+8*(r>>2); if(kv>qrel)p0[r]=NEG; if(kv+32>qrel)p1[r]=NEG;}
}

constexpr int NSLOT=3, SLOTB=8192;
constexpr int LDS_K=0, LDS_V=NSLOT*SLOTB, LDS_WS=2*NSLOT*SLOTB, LDS_OST=LDS_WS+NW*64*4, LDS_CUM=LDS_OST+NW*4096, LDS_BYTES=LDS_CUM+SEQ*4;
constexpr float C2=0.125f*1.4426950408889634f;
__device__ __forceinline__ void glds16(const void*gsrc,unsigned lds_dst){unsigned keep;
  asm volatile("s_mov_b32 %0, m0\n\ts_mov_b32 m0, %2\n\ts_nop 0\n\tglobal_load_lds_dwordx4 %1, off\n\ts_mov_b32 m0, %0":"=&s"(keep):"v"(gsrc),"s"(lds_dst):"memory");}
__device__ __forceinline__ float max3f(float a,float b,float c){float r;asm("v_max3_f32 %0, %1, %2, %3":"=v"(r):"v"(a),"v"(b),"v"(c));return r;}
__device__ __forceinline__ float max2f(float a,float b){float r;asm("v_max_f32_e32 %0, %1, %2":"=v"(r):"v"(a),"v"(b));return r;}
__device__ __forceinline__ float fadd_s(float a,float b){float r;asm("v_add_f32_e32 %0, %1, %2":"=v"(r):"v"(a),"v"(b));return r;}
__device__ __forceinline__ float fsub_s(float a,float b){float r;asm("v_sub_f32_e32 %0, %1, %2":"=v"(r):"v"(a),"v"(b));return r;}
typedef float f32x2_t __attribute__((ext_vector_type(2))); typedef __bf16 bf16x2_t __attribute__((ext_vector_type(2)));
__device__ __forceinline__ unsigned cvtpk_s(float lo,float hi){f32x2_t v={lo,hi};bf16x2_t b=__builtin_convertvector(v,bf16x2_t);return __builtin_bit_cast(unsigned,b);}
#define WAIT_BAR(N) asm volatile("s_waitcnt vmcnt(" #N ") lgkmcnt(0)\n\ts_barrier":::"memory")

typedef __attribute__((address_space(3))) const float* lds_fptr;
typedef float f32x4a __attribute__((ext_vector_type(4)));
__device__ __forceinline__ void ckinit(f32x16&c0,f32x16&c1,lds_fptr ck,float nm,int hi){
  #pragma unroll
  for(int g=0;g<4;++g){
    const f32x4a a=*(const __attribute__((address_space(3))) f32x4a*)(ck+8*g+4*hi);
    const f32x4a b=*(const __attribute__((address_space(3))) f32x4a*)(ck+32+8*g+4*hi);
    c0[4*g+0]=nm-a[0];c0[4*g+1]=nm-a[1];c0[4*g+2]=nm-a[2];c0[4*g+3]=nm-a[3];
    c1[4*g+0]=nm-b[0];c1[4*g+1]=nm-b[1];c1[4*g+2]=nm-b[2];c1[4*g+3]=nm-b[3];}
}
__device__ __forceinline__ void qkt(f32x16&p0,f32x16&p1,const char*Kslot,const bf16x8*qr,lds_fptr ck,float nm,int r32,int hi){
  const char*kb=Kslot+hi*1024+r32*16;
  ckinit(p0,p1,ck,nm,hi);
  #pragma unroll
  for(int d0=0;d0<4;++d0){
    const bf16x8 b0=*reinterpret_cast<const bf16x8*>(kb+d0*2048);
    const bf16x8 b1=*reinterpret_cast<const bf16x8*>(kb+d0*2048+512);
    p0=__builtin_amdgcn_mfma_f32_32x32x16_bf16(b0,qr[d0],p0,0,0,0);p1=__builtin_amdgcn_mfma_f32_32x32x16_bf16(b1,qr[d0],p1,0,0,0);}
}
typedef __attribute__((address_space(3))) const char* lds_cptr;
typedef short v4i16_t __attribute__((ext_vector_type(4)));
__device__ __forceinline__ void kload8(bf16x8*kf,lds_cptr kp){
  kf[0]=*(const __attribute__((address_space(3))) bf16x8*)(kp);      kf[1]=*(const __attribute__((address_space(3))) bf16x8*)(kp+512);
  kf[2]=*(const __attribute__((address_space(3))) bf16x8*)(kp+2048); kf[3]=*(const __attribute__((address_space(3))) bf16x8*)(kp+2560);
  kf[4]=*(const __attribute__((address_space(3))) bf16x8*)(kp+4096); kf[5]=*(const __attribute__((address_space(3))) bf16x8*)(kp+4608);
  kf[6]=*(const __attribute__((address_space(3))) bf16x8*)(kp+6144); kf[7]=*(const __attribute__((address_space(3))) bf16x8*)(kp+6656);
}
__device__ __forceinline__ void kload2(bf16x8*kf,lds_cptr kp,int j){ kf[2*j]=*(const __attribute__((address_space(3))) bf16x8*)(kp+j*2048); kf[2*j+1]=*(const __attribute__((address_space(3))) bf16x8*)(kp+j*2048+512); }
__device__ __forceinline__ s16x4 vtr(lds_cptr p){ return __builtin_bit_cast(s16x4,__builtin_amdgcn_ds_read_tr16_b64_v4i16((__attribute__((address_space(3))) v4i16_t*)p)); }
__device__ __forceinline__ float rowmax(const f32x16&p0,const f32x16&p1){
  float a=max3f(p0[0],p0[1],p1[0]),b=max3f(p0[2],p0[3],p1[1]);a=max3f(a,p1[2],p1[3]);
  #pragma unroll
  for(int r=4;r<16;r+=4){a=max3f(a,p0[r],p0[r+1]);b=max3f(b,p0[r+2],p0[r+3]);a=max3f(a,p1[r],p1[r+1]);b=max3f(b,p1[r+2],p1[r+3]);}
  const float m=max2f(a,b);
  auto rr=__builtin_amdgcn_permlane32_swap(__float_as_uint(m),__float_as_uint(m),false,false);
  return max2f(__uint_as_float(rr[0]),__uint_as_float(rr[1]));
}
__device__ __forceinline__ void pv(f32x16*o,int vb,bf16x8 pa0,bf16x8 pa1,bf16x8 pa2,bf16x8 pa3){
  #pragma unroll
  for(int d0=0;d0<2;++d0){s16x4 lo[4],hi[4];
    #pragma unroll
    for(int ks=0;ks<4;++ks){
      asm volatile("ds_read_b64_tr_b16 %0,%1 offset:%c2":"=&v"(lo[ks]):"v"(vb),"i"(d0*4096+ks*1024):"memory");
      asm volatile("ds_read_b64_tr_b16 %0,%1 offset:%c2":"=&v"(hi[ks]):"v"(vb),"i"(d0*4096+ks*1024+512):"memory");}
    asm volatile("s_waitcnt lgkmcnt(0)":::"memory");SBAR();
    #define PK(k) (bf16x8){lo[k][0],lo[k][1],lo[k][2],lo[k][3],hi[k][0],hi[k][1],hi[k][2],hi[k][3]}
    o[d0]=__builtin_amdgcn_mfma_f32_32x32x16_bf16(pa0,PK(0),o[d0],0,0,0);
    o[d0]=__builtin_amdgcn_mfma_f32_32x32x16_bf16(pa1,PK(1),o[d0],0,0,0);
    o[d0]=__builtin_amdgcn_mfma_f32_32x32x16_bf16(pa2,PK(2),o[d0],0,0,0);
    o[d0]=__builtin_amdgcn_mfma_f32_32x32x16_bf16(pa3,PK(3),o[d0],0,0,0);
    #undef PK
  }
}

#ifndef ATTN_STORE16
#define ATTN_STORE16(p,v) (*(u32x4*)(p)=(v))
#endif
template<int THRL> __device__ __forceinline__ void attn_unit(int b,int h,int qb,const bf16*Q,const bf16*__restrict__ K,const bf16*__restrict__ V,bf16*O,const float*__restrict__ cum,const unsigned*__restrict__ qkm,char*shm){
  int tid_l=threadIdx.x; asm volatile("":"+v"(tid_l));
  const int tid=tid_l,lane=tid&63,r32=lane&31,hi=lane>>5; const int wid=__builtin_amdgcn_readfirstlane(tid>>6);
  const long rowbase=(long)b*SEQ; const int q0=qb*QB;
  const bf16*Qw=Q+(rowbase+q0+wid*QBLK)*DM+h*D;
  const bf16*Kh=K+rowbase*DM+h*D,*Vh=V+rowbase*DM+h*D;
  const unsigned lds0=(unsigned)(uintptr_t)shm;
  float*wsf=(float*)(shm+LDS_WS)+wid*64;
  const bf16*ksrc=Kh+(long)lane*DM+wid*8;
  const bf16*vsrc=Vh+(long)(16*(wid&3)+(lane>>2))*DM+(wid>>2)*32+(lane&3)*8;
  const unsigned kdst=lds0+LDS_K+wid*1024, vdst=lds0+LDS_V+wid*1024;
  #define DMA_K(t,slot) glds16(ksrc+(long)TILE(t)*KVBLK*DM,(unsigned)__builtin_amdgcn_readfirstlane(kdst+(slot)))
  #define DMA_V(t,slot) glds16(vsrc+(long)TILE(t)*KVBLK*DM,(unsigned)__builtin_amdgcn_readfirstlane(vdst+(slot)))
  const int vb0=(int)(lds0+LDS_V)+((lane>>4)&1)*32+(lane&3)*8+(4*hi+((lane&15)>>2))*64;
  const char*Kbase=shm+LDS_K; bf16x8 kf[8];
  const lds_cptr shm3=(lds_cptr)shm; const lds_cptr kp0=shm3+LDS_K+hi*1024+r32*16; const lds_cptr vp0=shm3+LDS_V+((lane>>4)&1)*32+(lane&3)*8+(4*hi+((lane&15)>>2))*64;
  const int NT=(q0+QB)/KVBLK;
  const lds_fptr cumS=(lds_fptr)(shm3+LDS_CUM);
  const float* cgp=cum+(long)(b*NHEAD+h)*SEQ;
  int tmin;
  { const float qk=sqrtf(__uint_as_float(qkm[b*NHEAD+h])*__uint_as_float(qkm[32+b*NHEAD+h]));
    const float thr=cgp[q0]+2.0f*qk+40.0f;
    const bool c0=(lane<NT-4)&&(cgp[64*lane+63]>=thr), c1=(lane+64<NT-4)&&(cgp[64*(lane+64)+63]>=thr);
    tmin=(__popcll(__ballot(c0))+__popcll(__ballot(c1)))&~1; }
  const int NTp=NT-tmin;
  #define TILE(j) (((j)<4)?(NT-4+(j)):(NT-1-(j)))
  { const f32x4a* cg4=(const f32x4a*)cgp; __attribute__((address_space(3))) f32x4a* cs4=(__attribute__((address_space(3))) f32x4a*)(shm3+LDS_CUM);
    for(int i=16*tmin+tid;i<(q0+QB)/4;i+=NW*64)cs4[i]=cg4[i]; }
  DMA_K(0,0);DMA_V(0,0);DMA_K(1,SLOTB);
  bf16x8 qr[4];
  #pragma unroll
  for(int d0=0;d0<4;++d0)qr[d0]=*reinterpret_cast<const bf16x8*>(&Qw[(long)r32*DM+d0*16+hi*8]);
  float mhat=0.f,l_reg=0.f;f32x16 o[2];o[0]=f32x16{};o[1]=f32x16{};float cq=0.f,nm=0.f;
  const int qrel=wid*QBLK+r32;
  #define CMASK(P0,P1,t) do{ if((t)<4)cmask(P0,P1,(t),qrel,hi);}while(0)
  bool resc=false;
  #define START(P0,P1) do{ const float rm=rowmax(P0,P1); resc=false; \
    { const float dl=rm; mhat=fadd_s(mhat,dl); \
      _Pragma("unroll") for(int r=0;r<16;++r){P0[r]=fsub_s(P0[r],dl);P1[r]=fsub_s(P1[r],dl);} \
      nm=cq-mhat; } \
    _Pragma("unroll") for(int r=0;r<16;++r)P0[r]=__builtin_amdgcn_exp2f(P0[r]); }while(0)
  #define RESC() do{ if(resc){ asm volatile("s_waitcnt lgkmcnt(0)":::"memory"); \
      _Pragma("unroll") for(int d_=0;d_<2;++d_) _Pragma("unroll") for(int r=0;r<16;++r)o[d_][r]*=wsf[crow(r,hi)]; } }while(0)
  f32x16 pA0,pA1,pB0,pB1;
  int sl_prev=0,sl_cur=0,sl_next=SLOTB;
  #define ROT() do{sl_prev=sl_cur;sl_cur=sl_next;sl_next=(sl_next==(NSLOT-1)*SLOTB)?0:sl_next+SLOTB;}while(0)
  DMA_K(2,2*SLOTB);
  WAIT_BAR(3);
  cq=cumS[q0+qrel]; nm=cq;
  qkt(pA0,pA1,Kbase,qr,cumS+64*TILE(0),nm,r32,hi);asm volatile("s_nop 15\n\ts_nop 7":"+v"(pA0),"+v"(pA1));CMASK(pA0,pA1,0);
  START(pA0,pA1);
  _Pragma("unroll") for(int r=0;r<16;++r)pA1[r]=__builtin_amdgcn_exp2f(pA1[r]);
  WAIT_BAR(0);
  DMA_K(3,0);DMA_V(1,SLOTB);
  ROT();
  kload8(kf,kp0+sl_cur);
  WAIT_BAR(2);
  s16x4 vlo[8],vhi[8]; u32x4 pw0,pw1,pw2,pw3;
  #define PKW(P,B) cvtpk_s(P[B],P[B+1])
  #define PAF(k) __builtin_bit_cast(bf16x8,pw##k)
  #define VFR(i) (bf16x8){vlo[i][0],vlo[i][1],vlo[i][2],vlo[i][3],vhi[i][0],vhi[i][1],vhi[i][2],vhi[i][3]}
  #define PIN(x) asm volatile("":"+v"(x))
  #define MX3(a,b,c) __builtin_fmaxf(__builtin_fmaxf((a),(b)),(c))
  #define GAPA(MF,A0,A1,A2,A3,W0,W1,PW) do{ MF; sacc+=A0; sacc+=A1; sacc+=A2; sacc+=A3; PIN(sacc); W0; W1; PIN(PW); SBAR(); }while(0)
  #define EX(v) __builtin_amdgcn_exp2f(v)
  #define GAPB(MF,X,B) do{ MF; X[B]=EX(X[B]); X[B+1]=EX(X[B+1]); X[B+2]=EX(X[B+2]); X[B+3]=EX(X[B+3]); PIN(X); SBAR(); }while(0)
  #define VRD(i) do{ vlo[i]=vtr(vp_+(((i)>>2)*4096+((i)&3)*1024)); vhi[i]=vtr(vp_+(((i)>>2)*4096+((i)&3)*1024+512)); }while(0)
  #define KRD(G,j) do{ if(G){ kload2(kf,kp0+sl_next,j); SBAR(); } }while(0)
  #define STEP(C0,C1,P0,P1,t,GK,GV,GL) do{ SBAR(); \
    ckinit(C0,C1,cumS+64*TILE(t),nm,hi); SBAR(); \
    const lds_cptr vp_=vp0+sl_prev; \
    VRD(0); SBAR(); float sacc=(P0[0]+P0[1]); \
    GAPA(C0=__builtin_amdgcn_mfma_f32_32x32x16_bf16(kf[0],qr[0],C0,0,0,0), P0[2],P0[3],P0[4],P0[5],     pw0[0]=PKW(P0,0), pw0[1]=PKW(P0,2), pw0); \
    VRD(4); SBAR(); GAPA(C1=__builtin_amdgcn_mfma_f32_32x32x16_bf16(kf[1],qr[0],C1,0,0,0), P0[6],P0[7],P0[8],P0[9],     pw0[2]=PKW(P0,4), pw0[3]=PKW(P0,6), pw0); \
    VRD(1); SBAR(); GAPA(C0=__builtin_amdgcn_mfma_f32_32x32x16_bf16(kf[2],qr[1],C0,0,0,0),   P0[10],P0[11],P0[12],P0[13], pw1[0]=PKW(P0,8), pw1[1]=PKW(P0,10), pw1); \
    VRD(5); SBAR(); GAPA(C1=__builtin_amdgcn_mfma_f32_32x32x16_bf16(kf[3],qr[1],C1,0,0,0),   P0[14],P0[15],P1[0],P1[1],   pw1[2]=PKW(P0,12),pw1[3]=PKW(P0,14), pw1); \
    VRD(2); SBAR(); GAPA(C0=__builtin_amdgcn_mfma_f32_32x32x16_bf16(kf[4],qr[2],C0,0,0,0),   P1[2],P1[3],P1[4],P1[5],     pw2[0]=PKW(P1,0), pw2[1]=PKW(P1,2), pw2); \
    VRD(6); SBAR(); GAPA(C1=__builtin_amdgcn_mfma_f32_32x32x16_bf16(kf[5],qr[2],C1,0,0,0),   P1[6],P1[7],P1[8],P1[9],     pw2[2]=PKW(P1,4), pw2[3]=PKW(P1,6), pw2); \
    VRD(3); SBAR(); GAPA(C0=__builtin_amdgcn_mfma_f32_32x32x16_bf16(kf[6],qr[3],C0,0,0,0),   P1[10],P1[11],P1[12],P1[13], pw3[0]=PKW(P1,8), pw3[1]=PKW(P1,10), pw3); \
    VRD(7); SBAR(); GAPA(C1=__builtin_amdgcn_mfma_f32_32x32x16_bf16(kf[7],qr[3],C1,0,0,0),   P1[14],P1[15],0.f,0.f,       pw3[2]=PKW(P1,12),pw3[3]=PKW(P1,14), pw3); \
    l_reg+=sacc; \
    if(GK){DMA_K((t)+3,sl_cur);} if(GV){DMA_V((t)+1,sl_next);} \
    CMASK(C0,C1,t); \
    { float a=MX3(C0[0],C0[1],C1[0]),b=MX3(C0[2],C0[3],C1[1]); a=MX3(a,C1[2],C1[3]); \
      _Pragma("unroll") for(int r=4;r<16;r+=4){a=MX3(a,C0[r],C0[r+1]);b=MX3(b,C0[r+2],C0[r+3]);a=MX3(a,C1[r],C1[r+1]);b=MX3(b,C1[r+2],C1[r+3]);} \
      float rm=__builtin_fmaxf(a,b); { auto rr=__builtin_amdgcn_permlane32_swap(__float_as_uint(rm),__float_as_uint(rm),false,false); rm=__builtin_fmaxf(__uint_as_float(rr[0]),__uint_as_float(rr[1])); } \
      resc=false; \
      if(__builtin_expect(__any(rm>(float)THRL),0)){ const float dl=__builtin_fmaxf(rm,0.f); mhat+=dl; \
        _Pragma("unroll") for(int r=0;r<16;++r){C0[r]-=dl;C1[r]-=dl;} \
        nm=cq-mhat; \
        const float f=__builtin_amdgcn_exp2f(-dl); l_reg*=f; if(hi==0)wsf[r32]=f; resc=true; } } \
    SBAR(); \
    GAPB(o[0]=__builtin_amdgcn_mfma_f32_32x32x16_bf16(PAF(0),VFR(0),o[0],0,0,0), C0,0); \
    GAPB(o[1]=__builtin_amdgcn_mfma_f32_32x32x16_bf16(PAF(0),VFR(4),o[1],0,0,0), C0,4); \
    KRD(GL,0); GAPB(o[0]=__builtin_amdgcn_mfma_f32_32x32x16_bf16(PAF(1),VFR(1),o[0],0,0,0), C0,8); \
    KRD(GL,1); GAPB(o[1]=__builtin_amdgcn_mfma_f32_32x32x16_bf16(PAF(1),VFR(5),o[1],0,0,0), C0,12); \
    KRD(GL,2); GAPB(o[0]=__builtin_amdgcn_mfma_f32_32x32x16_bf16(PAF(2),VFR(2),o[0],0,0,0), C1,0); \
    KRD(GL,3); GAPB(o[1]=__builtin_amdgcn_mfma_f32_32x32x16_bf16(PAF(2),VFR(6),o[1],0,0,0), C1,4); \
    GAPB(o[0]=__builtin_amdgcn_mfma_f32_32x32x16_bf16(PAF(3),VFR(3),o[0],0,0,0), C1,8); \
    GAPB(o[1]=__builtin_amdgcn_mfma_f32_32x32x16_bf16(PAF(3),VFR(7),o[1],0,0,0), C1,12); \
    }while(0)
  int t=1;
  for(;t+5<NTp;t+=2){
    STEP(pB0,pB1,pA0,pA1,t,true,true,true);     WAIT_BAR(2); RESC(); ROT();
    STEP(pA0,pA1,pB0,pB1,t+1,true,true,true);   WAIT_BAR(2); RESC(); ROT();
  }
  #define ENDW(tt) do{ if((tt)+3<NTp){WAIT_BAR(2);} else if((tt)+2<NTp){WAIT_BAR(1);} else {WAIT_BAR(0);} }while(0)
  for(;t+1<NTp;t+=2){
    STEP(pB0,pB1,pA0,pA1,t,(t+3<NTp),(t+1<NTp),(t+1<NTp));       ENDW(t);   RESC(); ROT();
    STEP(pA0,pA1,pB0,pB1,t+1,(t+4<NTp),(t+2<NTp),(t+2<NTp));     ENDW(t+1); RESC(); ROT();
  }
  STEP(pB0,pB1,pA0,pA1,NTp-1,false,false,false); RESC();
  { float sacc=pB0[0]+pB0[1]; _Pragma("unroll") for(int r=2;r<16;++r)sacc+=pB0[r]; _Pragma("unroll") for(int r=0;r<16;++r)sacc+=pB1[r]; l_reg+=sacc;
    pw0=(u32x4){PKW(pB0,0),PKW(pB0,2),PKW(pB0,4),PKW(pB0,6)};pw1=(u32x4){PKW(pB0,8),PKW(pB0,10),PKW(pB0,12),PKW(pB0,14)};pw2=(u32x4){PKW(pB1,0),PKW(pB1,2),PKW(pB1,4),PKW(pB1,6)};pw3=(u32x4){PKW(pB1,8),PKW(pB1,10),PKW(pB1,12),PKW(pB1,14)};
    SBAR(); pv(o,vb0+sl_cur,PAF(0),PAF(1),PAF(2),PAF(3)); }
  #undef PKW
  #undef PAF
  #undef VFR
  #undef PIN
  #undef MX3
  #undef GAPA
  #undef GAPB
  #undef EX
  #undef VRD
  #undef KRD
  #undef STEP
  #undef ENDW
  {auto rr=__builtin_amdgcn_permlane32_swap(__float_as_uint(l_reg),__float_as_uint(l_reg),false,false);l_reg=__uint_as_float(rr[0])+__uint_as_float(rr[1]);}
  if(hi==0)wsf[32+r32]=l_reg;asm volatile("s_waitcnt lgkmcnt(0)":::"memory");
  float rli[16];
  #pragma unroll
  for(int r=0;r<16;++r)rli[r]=__builtin_amdgcn_rcpf(wsf[32+crow(r,hi)]);
  bf16*Ow=O+(rowbase+q0+wid*QBLK)*DM+h*D;
  { bf16*stg=(bf16*)(shm+LDS_OST)+wid*2048;
    #pragma unroll
    for(int r=0;r<16;++r){const int orow=crow(r,hi);
      #pragma unroll
      for(int d0=0;d0<2;++d0)stg[orow*64+d0*32+r32]=__float2bfloat16(o[d0][r]*rli[r]);}
    asm volatile("s_waitcnt lgkmcnt(0)":::"memory");
    #pragma unroll
    for(int i=0;i<4;++i){const int row=i*8+(lane>>3),ch=lane&7; const u32x4 v=*(const u32x4*)(stg+row*64+ch*8); ATTN_STORE16(Ow+(long)row*DM+ch*8,v);} }
  asm volatile("s_waitcnt lgkmcnt(0)\n\ts_barrier":::"memory");
  #undef DMA_K
  #undef TILE
  #undef DMA_V
  #undef CMASK
  #undef START
  #undef RESC
  #undef ROT
}
constexpr int ATTN_LDS_BYTES=LDS_BYTES;
struct AttnTensors { const bf16* Q; const bf16* K; const bf16* V; bf16* O; const float* cum; const unsigned* qkm; };
struct AttnUnit { int bh; int qb; };
struct StaticOrder {
  int vcu;
  __device__ __forceinline__ explicit StaticOrder(int grid,int block):vcu((block%8)*(grid/8)+block/8){}
  __device__ __forceinline__ bool next(int i,AttnUnit&u)const{ if(i>=4)return false; const int s=vcu&7; u.bh=vcu>>3; u.qb=(i==0)?s:(i==1)?15-s:(i==2)?16+s:31-s; return true; }
  __device__ __forceinline__ void a_ready(const AttnUnit&)const{}
  __device__ __forceinline__ void done(const AttnUnit&)const{}
};
template<class Sched,int THRL=8> __device__ __forceinline__ void attn_phase(char*lds,const AttnTensors&T,const Sched&S){
  AttnUnit u;
  for(int i=0;S.next(i,u);++i){ S.a_ready(u); attn_unit<THRL>(u.bh/NHEAD,u.bh%NHEAD,u.qb,T.Q,T.K,T.V,T.O,T.cum,T.qkm,lds); S.done(u); }
}
#undef SBAR
#undef WAIT_BAR
}

constexpr int NWAVES = 8, NTHR = 512;
constexpr int NB = 4, SEQ = 8192, DM = 1024, T = NB * SEQ;
constexpr int NEXP = 32, TOPK = 4, ECAP = 32768;
constexpr int NSLOT_ROWS = T * TOPK + NEXP * 256;
constexpr int INW = 6680, NPROJ = 6656;
constexpr float LN_EPS = 1e-5f, ALPHA = 1.18920711500272f, LOG2E = 1.4426950408889634f;
constexpr size_t MiB = 1u << 20;
constexpr size_t WS_CTL = 0;
constexpr size_t WS_MODP = 13 * MiB, WS_MODF = 1 * MiB;
constexpr int MOD_KS = 16;
constexpr size_t WS_WGT = 2 * MiB + 768 * 1024;
constexpr size_t WS_WSM = 2 * MiB, WS_WRT = WS_WSM + 256 * 1024;
constexpr size_t WS_FFL = 3 * MiB, WS_GLR = 4 * MiB, WS_CUM = 6 * MiB, WS_DLAST = 7 * MiB;
constexpr size_t WS_TSLOT = 8 * MiB, WS_TGATE = WS_TSLOT + 512 * 1024, WS_RTOK = 9 * MiB;
constexpr size_t WS_WIN = 16 * MiB, WS_WA = 29 * MiB, WS_WB = 30 * MiB, WS_WO = 32 * MiB, WS_WUP = 34 * MiB, WS_WDN = 162 * MiB;
constexpr size_t WS_U = 226 * MiB;
constexpr size_t WS_FQ = 290 * MiB, WS_FK = 322 * MiB, WS_FV = 354 * MiB, WS_GQ = 386 * MiB, WS_GK = 418 * MiB, WS_GV = 450 * MiB, WS_GR = 514 * MiB, WS_GA = 578 * MiB, WS_GB = 642 * MiB;
constexpr size_t WS_US = 706 * MiB;
constexpr size_t WS_U2 = 834 * MiB;
constexpr size_t WS_ACT = 290 * MiB, WS_MOE = 562 * MiB;
constexpr size_t WS_END = 898 * MiB;
static_assert(WS_ACT + (size_t)NSLOT_ROWS * 1024 * 2 <= WS_MOE && WS_MOE + (size_t)NSLOT_ROWS * 1024 * 2 <= WS_U2, "overlay map");

constexpr int LDS_BYTES = 160 * 1024;
constexpr int MISC_OFF = 131072;
constexpr int BARLDS_OFF = LDS_BYTES - 64;
constexpr int CW_BAR = 4096;
constexpr size_t CTL_ZERO_BYTES = 65536;

#define LAS __attribute__((address_space(3)))
typedef unsigned short bf16;
typedef unsigned v4u __attribute__((ext_vector_type(4)));
typedef unsigned v2u __attribute__((ext_vector_type(2)));
typedef float f32x4 __attribute__((ext_vector_type(4)));
typedef float f32x16 __attribute__((ext_vector_type(16)));
typedef short bf16x8 __attribute__((ext_vector_type(8)));
typedef short s16x4 __attribute__((ext_vector_type(4)));
#define LDS_WAIT() asm volatile("s_waitcnt lgkmcnt(0)" ::: "memory")
__device__ __forceinline__ unsigned f2bf(float f) { unsigned u = __builtin_bit_cast(unsigned, f); return (u + 0x7fffu + ((u >> 16) & 1u)) >> 16; }
__device__ __forceinline__ unsigned pk2(float lo, float hi) { return f2bf(lo) | (f2bf(hi) << 16); }
__device__ __forceinline__ float bfl(unsigned w) { return __uint_as_float(w << 16); }
__device__ __forceinline__ float bfh(unsigned w) { return __uint_as_float(w & 0xffff0000u); }
__device__ __forceinline__ float bf1(bf16 h) { return __uint_as_float((unsigned)h << 16); }
template <int CTRL, int RM, bool BC> __device__ __forceinline__ float dpp_mov(float old, float v) { return __builtin_bit_cast(float, __builtin_amdgcn_update_dpp(__builtin_bit_cast(int, old), __builtin_bit_cast(int, v), CTRL, RM, 0xf, BC)); }
__device__ __forceinline__ float wave_sum(float v) {
    v += dpp_mov<0xB1, 0xf, true>(0.f, v); v += dpp_mov<0x4E, 0xf, true>(0.f, v); v += dpp_mov<0x141, 0xf, true>(0.f, v); v += dpp_mov<0x140, 0xf, true>(0.f, v);
    v += dpp_mov<0x142, 0xa, false>(0.f, v); v += dpp_mov<0x143, 0xc, false>(0.f, v);
    return __builtin_bit_cast(float, __builtin_amdgcn_readlane(__builtin_bit_cast(int, v), 63));
}
__device__ __forceinline__ float wave_max(float v) {
    v = fmaxf(v, dpp_mov<0xB1, 0xf, true>(v, v)); v = fmaxf(v, dpp_mov<0x4E, 0xf, true>(v, v)); v = fmaxf(v, dpp_mov<0x141, 0xf, true>(v, v)); v = fmaxf(v, dpp_mov<0x140, 0xf, true>(v, v));
    v = fmaxf(v, dpp_mov<0x142, 0xa, false>(v, v)); v = fmaxf(v, dpp_mov<0x143, 0xc, false>(v, v));
    return __builtin_bit_cast(float, __builtin_amdgcn_readlane(__builtin_bit_cast(int, v), 63));
}
__device__ __forceinline__ float logsigmoidf(float x) { return fminf(x, 0.f) - __logf(1.0f + __expf(-fabsf(x))); }
__device__ __forceinline__ float sigmoidf_(float x) { return 1.0f / (1.0f + __expf(-x)); }
__device__ __forceinline__ float reduce32(const float (&v)[32], int lane) {
    float a[16], b[8], c[4], d[2], e;
#pragma unroll
    for (int i = 0; i < 16; ++i) { const auto r = __builtin_amdgcn_permlane32_swap(__float_as_uint(v[i]), __float_as_uint(v[16 + i]), false, false); a[i] = __uint_as_float(r[0]) + __uint_as_float(r[1]); }
#pragma unroll
    for (int i = 0; i < 8; ++i) { const auto r = __builtin_amdgcn_permlane16_swap(__float_as_uint(a[i]), __float_as_uint(a[8 + i]), false, false); b[i] = __uint_as_float(r[0]) + __uint_as_float(r[1]); }
    { const bool up = lane & 8;
#pragma unroll
      for (int i = 0; i < 4; ++i) { const float sx = b[i] + dpp_mov<0x128, 0xf, true>(0.f, b[i]), sy = b[4 + i] + dpp_mov<0x128, 0xf, true>(0.f, b[4 + i]); c[i] = up ? sy : sx; } }
    { const bool up = lane & 4;
#pragma unroll
      for (int i = 0; i < 2; ++i) { const float sx = c[i] + __builtin_bit_cast(float, __builtin_amdgcn_ds_swizzle(__builtin_bit_cast(int, c[i]), 0x101F)), sy = c[2 + i] + __builtin_bit_cast(float, __builtin_amdgcn_ds_swizzle(__builtin_bit_cast(int, c[2 + i]), 0x101F)); d[i] = up ? sy : sx; } }
    { const bool up = lane & 2; const float sx = d[0] + dpp_mov<0x4E, 0xf, true>(0.f, d[0]), sy = d[1] + dpp_mov<0x4E, 0xf, true>(0.f, d[1]); e = up ? sy : sx; }
    e += dpp_mov<0xB1, 0xf, true>(0.f, e);
    return e;
}

__device__ __forceinline__ bf16x8 frag_row(const LAS bf16* img, int stride, int row0, int k0, int lane) {
    return *(const LAS bf16x8*)(img + (row0 + (lane & 31)) * stride + k0 + 8 * (lane >> 5));
}
__device__ __forceinline__ bf16x8 frag_tr(const LAS bf16* img, int stride, int k0, int n0, int lane) {
    const int g = lane >> 4, q = (lane >> 2) & 3, p = lane & 3, h = g >> 1;
    const LAS bf16* a = img + (k0 + 8 * h + q) * stride + n0 + 16 * (g & 1) + 4 * p;
    const s16x4 lo = __builtin_bit_cast(s16x4, __builtin_amdgcn_ds_read_tr16_b64_v4i16((LAS s16x4*)a));
    const s16x4 hi = __builtin_bit_cast(s16x4, __builtin_amdgcn_ds_read_tr16_b64_v4i16((LAS s16x4*)(a + 4 * stride)));
    return (bf16x8){lo[0], lo[1], lo[2], lo[3], hi[0], hi[1], hi[2], hi[3]};
}
__device__ __forceinline__ int crow16(int r, int h) { return (r & 3) + 8 * (r >> 2) + 4 * h; }

typedef __attribute__((address_space(1))) unsigned gu32;
#define XB_TMO      128
#define XB_XCNT(j)  (256  + 64 * (j))
#define XB_XSUB(j)  (1280 + 64 * (j))
#define XB_XGEN(j)  (2304 + 64 * (j))
#define XB_TOP      3328
#define XB_TOPGEN   3392
#define XCD_BAR_WORDS 3456
#define XB_SPIN_CAP (1u << 18)

__device__ __forceinline__ unsigned xb_ld(unsigned* p)              { return __hip_atomic_load(p, __ATOMIC_RELAXED, __HIP_MEMORY_SCOPE_AGENT); }
__device__ __forceinline__ unsigned xb_add(unsigned* p, unsigned v) { return __hip_atomic_fetch_add(p, v, __ATOMIC_RELAXED, __HIP_MEMORY_SCOPE_AGENT); }
__device__ __forceinline__ unsigned xb_xcc_id() { return (unsigned)__builtin_amdgcn_s_getreg((3 << 11) | 20) & 0xFu; }
#define XB_SPIN(cond, bar) do { unsigned _sp = 0; while (cond) { __builtin_amdgcn_s_sleep(1); \
    if ((++_sp & 255u) == 0u) { if (xb_ld(&(bar)[XB_TMO])) break; if (_sp > XB_SPIN_CAP) { atomicAdd(&(bar)[XB_TMO], 1u); break; } } } } while (0)

struct XcdBarrier {
    unsigned* bar; unsigned x;
    volatile LAS unsigned* st;
};

__device__ __forceinline__ XcdBarrier xcd_barrier_post(unsigned* bar, volatile LAS unsigned* st) {
    XcdBarrier b; b.bar = bar; b.x = xb_xcc_id(); b.st = st;
    if (threadIdx.x == 0) (void)xb_add(&bar[XB_XCNT(b.x)], 1u);
    return b;
}
__device__ __forceinline__ void xcd_barrier_complete(unsigned* bar, unsigned x, unsigned& nloc, unsigned& nx) {
    const unsigned G = gridDim.x * gridDim.y * gridDim.z;
    unsigned sum, cnt, mine, sp = 0u;
    for (;;) {
        sum = 0u; cnt = 0u; mine = 0u;
#pragma unroll
        for (unsigned j = 0; j < 16; ++j) { const unsigned c = xb_ld(&bar[XB_XCNT(j)]); sum += c; cnt += (c > 0u) ? 1u : 0u; mine = (j == x) ? c : mine; }
        if (sum == G) break;
        __builtin_amdgcn_s_sleep(1);
        if ((++sp & 255u) == 0u) { if (xb_ld(&bar[XB_TMO])) break; if (sp > XB_SPIN_CAP) { atomicAdd(&bar[XB_TMO], 1u); break; } }
    }
    nloc = mine > 0u ? mine : 1u; nx = cnt > 0u ? cnt : 1u;
}

__device__ __forceinline__ void xcd_barrier(const XcdBarrier& b) {
    asm volatile("s_waitcnt vmcnt(0)" ::: "memory");
    __syncthreads();
    if (threadIdx.x == 0) {
        unsigned* bar = b.bar;
        __builtin_amdgcn_s_waitcnt(0);
        unsigned nloc = b.st[0], nx = b.st[1];
        if (nloc == 0u) { xcd_barrier_complete(bar, b.x, nloc, nx); b.st[0] = nloc; b.st[1] = nx; }
        const unsigned old = xb_add(&bar[XB_XSUB(b.x)], 1u);
        const unsigned gen = old / nloc;
        if (old + 1u == (gen + 1u) * nloc) {
            __builtin_amdgcn_fence(__ATOMIC_RELEASE, "agent");
            asm volatile("s_waitcnt vmcnt(0)" ::: "memory");
            const unsigned og = xb_add(&bar[XB_TOP], 1u);
            const unsigned tg = og / nx;
            if (og + 1u == (tg + 1u) * nx) xb_add(&bar[XB_TOPGEN], 1u);
            else XB_SPIN(xb_ld(&bar[XB_TOPGEN]) == tg, bar);
            __builtin_amdgcn_fence(__ATOMIC_ACQUIRE, "agent");
            xb_add(&bar[XB_XGEN(b.x)], 1u);
            asm volatile("s_waitcnt vmcnt(0)" ::: "memory");
        } else {
            XB_SPIN(xb_ld(&bar[XB_XGEN(b.x)]) == gen, bar);
            __builtin_amdgcn_fence(__ATOMIC_ACQUIRE, "agent");
            asm volatile("s_waitcnt vmcnt(0)" ::: "memory");
        }
    }
    __syncthreads();
}

__device__ __forceinline__ int tid_() { int t = threadIdx.x; asm volatile("" : "+v"(t)); return t; }
struct Frame {
    LAS unsigned char* lds;
    int wave, G, blk;
    float* out; unsigned char* ws;
};
#define WSP(type, off) ((type*)(F.ws + (off)))
constexpr size_t WS_PTRS = 2048;
#define GAS __attribute__((address_space(1)))
typedef const GAS float* gfptr_t;
typedef const GAS f32x4* gf4ptr_t;
#define PT(k) (((const gfptr_t*)(F.ws + WS_PTRS))[k])
struct Args { const float* in[22]; float* out; unsigned char* ws; int ph_lo, ph_hi; };

struct WItem { const float* src; bf16* dst; int ldw, Kd; float scl; };
__device__ __forceinline__ bool p0_item(const Args& A, unsigned char* ws, int it, WItem& w) {
    constexpr int I_IN = 16 * (NPROJ / 64), I_A = 8 * 16, I_B = 16 * 16, I_O = 16 * 16, I_UP = 16 * 32, I_DN = 16 * 16;
    constexpr int NITEMS = I_IN + I_A + I_B + I_O + NEXP * (I_UP + I_DN);
    if (it >= NITEMS) return false;
    int r = it;
    if (r < I_IN) { const int nblk = NPROJ / 64, kb = r / nblk, nb = r % nblk, n0 = 64 * nb; const int sc0 = n0 + (n0 < 1536 ? 0 : (n0 < 4608 ? 8 : 24));
        w.src = A.in[4] + (size_t)(64 * kb) * INW + sc0; w.ldw = INW; w.dst = (bf16*)(ws + WS_WIN) + (size_t)n0 * 1024 + 64 * kb; w.Kd = 1024; w.scl = 0.f; return true; } r -= I_IN;
    if (r < I_A) { const int kb = r / 16, nb = r % 16; w.src = A.in[9] + (size_t)(64 * kb) * 1024 + 64 * nb; w.ldw = 1024; w.dst = (bf16*)(ws + WS_WA) + (size_t)(64 * nb) * 512 + 64 * kb; w.Kd = 512; w.scl = 0.f; return true; } r -= I_A;
    if (r < I_B) { const int kb = r / 16, nb = r % 16; w.src = A.in[10] + (size_t)(64 * kb) * 1024 + 64 * nb; w.ldw = 1024; w.dst = (bf16*)(ws + WS_WB) + (size_t)(64 * nb) * 1024 + 64 * kb; w.Kd = 1024; w.scl = 0.f; return true; } r -= I_B;
    if (r < I_O) { const int kb = r / 16, nb = r % 16; w.src = A.in[11] + (size_t)(64 * kb) * 1024 + 64 * nb; w.ldw = 1024; w.dst = (bf16*)(ws + WS_WO) + (size_t)(64 * nb) * 1024 + 64 * kb; w.Kd = 1024; w.scl = 0.f; return true; } r -= I_O;
    const int e = r / (I_UP + I_DN); r -= e * (I_UP + I_DN);
    if (r < I_UP) { const int kb = r / 32, nb = r % 32, n0 = 64 * nb, tile = n0 >> 8, wv = n0 & 255; const int sc0 = wv < 128 ? 128 * tile + wv : 1024 + 128 * tile + (wv - 128);
        w.src = A.in[16] + (size_t)e * 1024 * 2048 + (size_t)(64 * kb) * 2048 + sc0; w.ldw = 2048; w.dst = (bf16*)(ws + WS_WUP + (size_t)e * 2048 * 1024 + (size_t)n0 * 1024 + 64 * kb); w.Kd = 1024; w.scl = 32.f; return true; } r -= I_UP;
    { const int kb = r / 16, nb = r % 16; w.src = A.in[18] + (size_t)e * 1024 * 1024 + (size_t)(64 * kb) * 1024 + 64 * nb; w.ldw = 1024; w.dst = (bf16*)(ws + WS_WDN + (size_t)e * 1024 * 1024 + (size_t)(64 * nb) * 1024 + 64 * kb); w.Kd = 1024; w.scl = 64.f; return true; }
}
__device__ __forceinline__ void phase0(Frame& F, const Args& A) {
    const int tid = tid_(), lane = tid & 63;
    const int gtid = F.blk * NTHR + tid, NT_ALL = F.G * NTHR;
    if (F.blk == 0 && tid < 22) ((const float**)(F.ws + WS_PTRS))[tid] = A.in[tid];
    { v4u* p = WSP(v4u, WS_RTOK); for (int i = gtid; i < NEXP * ECAP / 4; i += NT_ALL) p[i] = (v4u){0u, 0u, 0u, 0u}; }
    for (int i = gtid; i < 24 * 1024; i += NT_ALL) { const int o = i >> 10, k = i & 1023; const int col = o < 8 ? 1536 + o : 4616 + (o - 8); WSP(float, WS_WSM)[i] = A.in[4][(size_t)k * INW + col]; }
    for (int i = gtid; i < 32 * 1024; i += NT_ALL) { const int e = i >> 10, k = i & 1023; WSP(float, WS_WRT)[i] = A.in[14][k * 32 + e]; }
    for (int i = gtid; i < 512 * 16; i += NT_ALL) { const int c = i >> 4, r = i & 15; const float w = A.in[6][r * 512 + c]; const unsigned hi = f2bf(w); const float rem = w - __uint_as_float(hi << 16);
        WSP(bf16, WS_WGT)[i] = (bf16)hi; WSP(bf16, WS_WGT)[512 * 16 + i] = (bf16)f2bf(rem); }
    {
        LAS float* sc = (LAS float*)(F.lds + 140 * 1024);
        for (int i = tid; i < 4096; i += NTHR) { const float v = A.in[1][i]; sc[i] = v * sigmoidf_(v); }
        __syncthreads();
        const int task = F.blk * 384 + tid;
        if (tid < 384 && task < MOD_KS * 6144) {
            const int ks = task / 6144, j = task % 6144; float a0 = 0.f, a1 = 0.f, a2 = 0.f, a3 = 0.f;
            const float* wp = A.in[2] + (size_t)(ks * 64) * 6144 + j; const LAS float* sv = sc + ks * 64;
#pragma unroll 16
            for (int k = 0; k < 64; ++k) { const float w = wp[(size_t)k * 6144]; a0 += sv[k] * w; a1 += sv[1024 + k] * w; a2 += sv[2048 + k] * w; a3 += sv[3072 + k] * w; }
            const float bb = ks == 0 ? A.in[3][j] : 0.f; float* mp = WSP(float, WS_MODP) + (size_t)ks * 4 * 6144 + j;
            mp[0] = a0 + bb; mp[6144] = a1 + bb; mp[2 * 6144] = a2 + bb; mp[3 * 6144] = a3 + bb;
        }
    }
    LAS float* scr = (LAS float*)(F.lds + F.wave * 16640);
    const int gw = F.blk * NWAVES + F.wave, NGW = F.G * NWAVES;
    WItem cur, nxt; f32x4 ld[16], ln[16];
    bool has = p0_item(A, F.ws, gw, cur);
    if (has) {
#pragma unroll
        for (int i = 0; i < 16; ++i) ld[i] = *(const f32x4*)(cur.src + (size_t)((lane >> 4) + 4 * i) * cur.ldw + 4 * (lane & 15)); }
    for (int it = gw; has; it += NGW) {
        const bool hn = p0_item(A, F.ws, it + NGW, nxt);
        if (hn) {
#pragma unroll
            for (int i = 0; i < 16; ++i) ln[i] = *(const f32x4*)(nxt.src + (size_t)((lane >> 4) + 4 * i) * nxt.ldw + 4 * (lane & 15)); }
#pragma unroll
        for (int i = 0; i < 16; ++i) { LAS float* d = scr + ((lane >> 4) + 4 * i) * 65 + 4 * (lane & 15); d[0] = ld[i].x; d[1] = ld[i].y; d[2] = ld[i].z; d[3] = ld[i].w; }
        LDS_WAIT(); asm volatile("" ::: "memory");
        if (cur.scl == 0.f) { const int c = lane & 7;
#pragma unroll
            for (int j = 0; j < 8; ++j) { const int n = (lane >> 3) + 8 * j; const LAS float* sp = scr + (8 * c) * 65 + n;
                v4u o; o.x = pk2(sp[0 * 65], sp[1 * 65]); o.y = pk2(sp[2 * 65], sp[3 * 65]); o.z = pk2(sp[4 * 65], sp[5 * 65]); o.w = pk2(sp[6 * 65], sp[7 * 65]);
                *(v4u*)(cur.dst + (size_t)n * cur.Kd + 8 * c) = o; } }
        else { const int c = lane & 3; const float sc = cur.scl;
#pragma unroll
            for (int j = 0; j < 4; ++j) { const int n = (lane >> 2) + 16 * j; const LAS float* sp = scr + (16 * c) * 65 + n; int o[4];
#pragma unroll
                for (int q = 0; q < 4; ++q) { int w = 0; w = __builtin_amdgcn_cvt_pk_fp8_f32(sp[(4 * q) * 65] * sc, sp[(4 * q + 1) * 65] * sc, w, false); w = __builtin_amdgcn_cvt_pk_fp8_f32(sp[(4 * q + 2) * 65] * sc, sp[(4 * q + 3) * 65] * sc, w, true); o[q] = w; }
                *(v4u*)((unsigned char*)cur.dst + (size_t)n * cur.Kd + 16 * c) = (v4u){(unsigned)o[0], (unsigned)o[1], (unsigned)o[2], (unsigned)o[3]}; } }
        LDS_WAIT(); asm volatile("" ::: "memory");
        has = hn; cur = nxt;
#pragma unroll
        for (int i = 0; i < 16; ++i) ld[i] = ln[i];
    }
}

template <int R> __device__ __forceinline__ void ln_center(f32x4 (&v)[R][4], float (&rstd)[R]) {
    float s[R];
#pragma unroll
    for (int r = 0; r < R; ++r) { s[r] = 0.f;
#pragma unroll
        for (int j = 0; j < 4; ++j) s[r] += (v[r][j].x + v[r][j].y) + (v[r][j].z + v[r][j].w); }
#pragma unroll
    for (int r = 0; r < R; ++r) { const float mean = wave_sum(s[r]) * (1.f / DM); s[r] = 0.f;
#pragma unroll
        for (int j = 0; j < 4; ++j) { v[r][j] = v[r][j] - mean; s[r] += (v[r][j].x * v[r][j].x + v[r][j].y * v[r][j].y) + (v[r][j].z * v[r][j].z + v[r][j].w * v[r][j].w); } }
#pragma unroll
    for (int r = 0; r < R; ++r) rstd[r] = 1.f / sqrtf(wave_sum(s[r]) * (1.f / DM) + LN_EPS);
}
template <int NO> __device__ __forceinline__ void row_dots2(const f32x4 (&v)[2][4], const LAS float* w, int lane, float (&p0)[32], float (&p1)[32]) {
#pragma unroll
    for (int o = 0; o < NO; ++o) { float a0 = 0.f, a1 = 0.f;
#pragma unroll
        for (int j = 0; j < 4; ++j) { const f32x4 ww = *(const LAS f32x4*)(w + o * 1024 + 256 * j + 4 * lane);
            a0 += (v[0][j].x * ww.x + v[0][j].y * ww.y) + (v[0][j].z * ww.z + v[0][j].w * ww.w); a1 += (v[1][j].x * ww.x + v[1][j].y * ww.y) + (v[1][j].z * ww.z + v[1][j].w * ww.w); }
        p0[o] = a0; p1[o] = a1; if ((o & 3) == 3) asm volatile("" ::: "memory"); }
#pragma unroll
    for (int o = NO; o < 32; ++o) { p0[o] = 0.f; p1[o] = 0.f; }
}
__device__ __forceinline__ void phase1(Frame& F, const Args& A) {
    const int tid = tid_(), lane = tid & 63;
    LAS float* wsm = (LAS float*)F.lds;
    LAS float* mods = (LAS float*)(F.lds + 98304);
    const int b = F.blk / (F.G / NB);
    for (int i = tid; i < 24 * 1024 / 4; i += NTHR) ((LAS f32x4*)wsm)[i] = WSP(f32x4, WS_WSM)[i];
    for (int i = tid; i < 2048; i += NTHR) { const float* mp = WSP(float, WS_MODP) + (size_t)b * 6144 + i; float a = 0.f;
#pragma unroll
        for (int k = 0; k < MOD_KS; ++k) a += mp[(size_t)k * 4 * 6144];
        mods[i] = a; }
    { const int gtid = F.blk * NTHR + tid; if (gtid < 4 * 6144) { const float* mp = WSP(float, WS_MODP) + gtid; float a = 0.f;
#pragma unroll
        for (int k = 0; k < MOD_KS; ++k) a += mp[(size_t)k * 4 * 6144];
        WSP(float, WS_MODF)[gtid] = a; } }
    __syncthreads();
    const int rows_per_blk = T / F.G, rows_per_wave = rows_per_blk / NWAVES;
    const int row0 = F.blk * rows_per_blk + F.wave * rows_per_wave;
    const int oi = lane >> 1; const float fb = oi < 8 ? A.in[5][oi] : 0.f;
    f32x4 va[2][4], vb[2][4];
#define P1_LOAD(V, rw) do { _Pragma("unroll") for (int r = 0; r < 2; ++r) _Pragma("unroll") for (int j = 0; j < 4; ++j) V[r][j] = ((const f32x4*)(A.in[0] + (size_t)((rw) + r) * DM) + lane)[64 * j]; } while (0)
#define P1_PAIR(v, rw, NEXT) do { \
        float rstd[2]; ln_center<2>(v, rstd); \
        _Pragma("unroll") for (int r = 0; r < 2; ++r) { unsigned long long* o8 = (unsigned long long*)(WSP(bf16, WS_U) + (size_t)((rw) + r) * DM) + lane; \
            _Pragma("unroll") for (int j = 0; j < 4; ++j) { const f32x4 sh = *(const LAS f32x4*)(mods + 256 * j + 4 * lane), scv = *(const LAS f32x4*)(mods + 1024 + 256 * j + 4 * lane); \
                v[r][j] = v[r][j] * rstd[r] * (scv + 1.0f) + sh; \
                o8[64 * j] = (unsigned long long)pk2(v[r][j].x, v[r][j].y) | ((unsigned long long)pk2(v[r][j].z, v[r][j].w) << 32); } } \
        float p0[32], p1[32]; row_dots2<24>(v, wsm, lane, p0, p1); \
        const float t0 = reduce32(p0, lane), t1 = reduce32(p1, lane); \
        if ((lane & 1) == 0) { \
            if (oi < 8) { WSP(float, WS_FFL)[(size_t)(rw) * 8 + oi] = logsigmoidf(t0 + fb) * LOG2E; WSP(float, WS_FFL)[(size_t)((rw) + 1) * 8 + oi] = logsigmoidf(t1 + fb) * LOG2E; } \
            else if (oi < 24) { WSP(float, WS_GLR)[(size_t)(rw) * 16 + (oi - 8)] = t0; WSP(float, WS_GLR)[(size_t)((rw) + 1) * 16 + (oi - 8)] = t1; } } \
        NEXT; } while (0)
    P1_LOAD(va, row0); P1_LOAD(vb, row0 + 2);
    for (int rr = 0; rr < rows_per_wave; rr += 4) {
        const int row = row0 + rr;
        P1_PAIR(va, row, if (rr + 4 < rows_per_wave) P1_LOAD(va, row + 4));
        P1_PAIR(vb, row + 2, if (rr + 6 < rows_per_wave) P1_LOAD(vb, row + 6));
    }
#undef P1_LOAD
#undef P1_PAIR
}

constexpr int GC = 64, GDK = 128, GDV = 256, GNCH = SEQ / GC, GITEMS = NB * 4 * GNCH;
constexpr int KST = 136, VST = 264, PST = 72;
__device__ __forceinline__ void fox_cumsum_item(Frame& F, int bh) {
    const int tid = tid_(), lane = tid & 63; (void)lane;
    const int b = bh >> 3, h = bh & 7; LAS float* wt = (LAS float*)(F.lds + MISC_OFF);
    const float* src = WSP(float, WS_FFL) + (size_t)b * SEQ * 8 + h; float v[16]; float run = 0.f;
#pragma unroll
    for (int i = 0; i < 16; ++i) { run += src[(size_t)(tid * 16 + i) * 8]; v[i] = run; }
    float incl = run;
#pragma unroll
    for (int o = 1; o < 64; o <<= 1) { const float n = __shfl_up(incl, o); if (lane >= o) incl += n; }
    if (lane == 63) wt[F.wave] = incl;
    __syncthreads();
    float base = incl - run;
    for (int w = 0; w < F.wave; ++w) base += wt[w];
    float* dst = WSP(float, WS_CUM) + (size_t)bh * SEQ + tid * 16;
#pragma unroll
    for (int i = 0; i < 16; i += 4) *(f32x4*)(dst + i) = (f32x4){v[i] + base, v[i + 1] + base, v[i + 2] + base, v[i + 3] + base};
    __syncthreads();
}
constexpr int GST = 24;
__device__ __forceinline__ float gla_decay_mfma(int lane, int wave, const LAS bf16* GH, const LAS bf16* GL, bf16x8 bwh, bf16x8 bwl, float bg, LAS float* totS, float (&bv)[16]) {
    const int tb = wave & 1, cb = wave >> 1, hh = lane >> 5, cc = 32 * cb + (lane & 31);
    const bf16x8 ah = frag_row(GH, GST, 32 * tb, 0, lane), al = frag_row(GL, GST, 32 * tb, 0, lane);
    f32x16 z = (f32x16){};
    z = __builtin_amdgcn_mfma_f32_32x32x16_bf16(ah, bwh, z, 0, 0, 0); z = __builtin_amdgcn_mfma_f32_32x32x16_bf16(al, bwh, z, 0, 0, 0); z = __builtin_amdgcn_mfma_f32_32x32x16_bf16(ah, bwl, z, 0, 0, 0);
    float G0[4], G1[4];
#pragma unroll
    for (int g = 0; g < 4; ++g) { float run = 0.f;
#pragma unroll
        for (int j = 0; j < 4; ++j) { run += logsigmoidf(z[4 * g + j] + bg) * (1.0f / 16.0f); bv[4 * g + j] = run; }
        const auto r = __builtin_amdgcn_permlane32_swap(__float_as_uint(run), __float_as_uint(run), false, false); G0[g] = __uint_as_float(r[0]); G1[g] = __uint_as_float(r[1]); }
    float run = 0.f;
#pragma unroll
    for (int g = 0; g < 4; ++g) { const float off = run + (hh ? G0[g] : 0.f);
#pragma unroll
        for (int j = 0; j < 4; ++j) bv[4 * g + j] += off;
        run += G0[g] + G1[g]; }
    if (hh == 0) totS[tb * GDK + cc] = run;
    __syncthreads();
    const float t0 = totS[cc], t1 = totS[GDK + cc];
    if (tb) {
#pragma unroll
        for (int r = 0; r < 16; ++r) bv[r] += t0; }
    return t0 + t1;
}
__device__ __forceinline__ void gla_state_phase(Frame& F) {
    const int tid = tid_(), lane = tid & 63;
    LAS bf16* KS = (LAS bf16*)F.lds;
    LAS bf16* VS = (LAS bf16*)(F.lds + 17408);
    LAS bf16* GH = (LAS bf16*)(F.lds + 51200);
    LAS bf16* GL = (LAS bf16*)(F.lds + 51200 + 3072);
    LAS float* totS = (LAS float*)(F.lds + 57344);
    LAS bf16* US = (LAS bf16*)(F.lds + 58368);
    v4u pv[4], pk[2]; f32x4 pg = (f32x4){0.f, 0.f, 0.f, 0.f}; bf16x8 bwhn, bwln, bwh, bwl; float bgn, bg;
    const gfptr_t bgate = PT(7); const int ccw = 32 * (F.wave >> 1) + (lane & 31);
#define GLA_A_PREFETCH(it_) do { const int h_ = (it_) & 3, n_ = ((it_) >> 2) & (GNCH - 1), b_ = (it_) >> 9; const size_t r0_ = (size_t)b_ * SEQ + (size_t)n_ * GC; \
        bwhn = *(const bf16x8*)(WSP(bf16, WS_WGT) + (size_t)(h_ * GDK + ccw) * 16 + 8 * (lane >> 5)); bwln = *(const bf16x8*)(WSP(bf16, WS_WGT) + 512 * 16 + (size_t)(h_ * GDK + ccw) * 16 + 8 * (lane >> 5)); bgn = bgate[h_ * GDK + ccw]; \
        _Pragma("unroll") for (int i = 0; i < 4; ++i) { const int pc = tid + i * NTHR, t = pc >> 5, ch = pc & 31; pv[i] = *(const v4u*)(WSP(bf16, WS_GV) + (r0_ + t) * 1024 + h_ * GDV + ch * 8); } \
        _Pragma("unroll") for (int i = 0; i < 2; ++i) { const int pc = tid + i * NTHR, t = pc >> 4, ch = pc & 15; pk[i] = *(const v4u*)(WSP(bf16, WS_GK) + (r0_ + t) * 512 + h_ * GDK + ch * 8); } \
        if (tid < 256) pg = ((const f32x4*)(WSP(float, WS_GLR) + r0_ * 16))[tid]; } while (0)
    int it = F.blk;
    if (it < GITEMS) GLA_A_PREFETCH(it);
    for (; it < GITEMS; it += F.G) {
#pragma unroll
        for (int i = 0; i < 4; ++i) { const int pc = tid + i * NTHR, t = pc >> 5, ch = pc & 31; *(LAS v4u*)(VS + t * VST + ch * 8) = pv[i]; }
#pragma unroll
        for (int i = 0; i < 2; ++i) { const int pc = tid + i * NTHR, t = pc >> 4, ch = pc & 15; *(LAS v4u*)(KS + t * KST + ch * 8) = pk[i]; }
        if (tid < 256) { const int t = tid >> 2, q = tid & 3; const unsigned h0 = f2bf(pg.x), h1 = f2bf(pg.y), h2 = f2bf(pg.z), h3 = f2bf(pg.w);
            *(LAS v2u*)(GH + t * GST + 4 * q) = (v2u){h0 | (h1 << 16), h2 | (h3 << 16)};
            *(LAS v2u*)(GL + t * GST + 4 * q) = (v2u){pk2(pg.x - __uint_as_float(h0 << 16), pg.y - __uint_as_float(h1 << 16)), pk2(pg.z - __uint_as_float(h2 << 16), pg.w - __uint_as_float(h3 << 16))}; }
        bwh = bwhn; bwl = bwln; bg = bgn;
        __syncthreads();
        if (it + F.G < GITEMS) GLA_A_PREFETCH(it + F.G);
        float p[16]; const float blast = gla_decay_mfma(lane, F.wave, GH, GL, bwh, bwl, bg, totS, p);
        { const int tb = F.wave & 1, hq = lane >> 5;
#pragma unroll
          for (int r = 0; r < 16; ++r) { const int t = 32 * tb + crow16(r, hq); KS[t * KST + ccw] = (bf16)f2bf(bf1(KS[t * KST + ccw]) * __expf(blast - p[r])); }
          if (tb == 0 && hq == 0) WSP(float, WS_DLAST)[(size_t)it * GDK + ccw] = __expf(blast); }
        __syncthreads();
        f32x16 acc[4];
#pragma unroll
        for (int cb = 0; cb < 4; ++cb) acc[cb] = (f32x16){};
#pragma unroll
        for (int ks = 0; ks < 4; ++ks) { const bf16x8 a = frag_tr(VS, VST, 16 * ks, 32 * F.wave, lane);
#pragma unroll
            for (int cb = 0; cb < 4; ++cb) { const bf16x8 bb = frag_tr(KS, KST, 16 * ks, 32 * cb, lane); acc[cb] = __builtin_amdgcn_mfma_f32_32x32x16_bf16(a, bb, acc[cb], 0, 0, 0); } }
        const int hh = lane >> 5;
#pragma unroll
        for (int cb = 0; cb < 4; ++cb) { const int cc = 32 * cb + (lane & 31);
#pragma unroll
            for (int g = 0; g < 4; ++g) { v2u w; w.x = pk2(acc[cb][4 * g], acc[cb][4 * g + 1]); w.y = pk2(acc[cb][4 * g + 2], acc[cb][4 * g + 3]);
                *(LAS v2u*)(US + cc * VST + 32 * F.wave + 8 * g + 4 * hh) = w; } }
        __syncthreads();
        bf16* us = WSP(bf16, WS_US) + (size_t)it * GDK * GDV;
#pragma unroll
        for (int i = 0; i < 8; ++i) { const int pc = tid + i * NTHR, cc = pc >> 5, ch = pc & 31; *(v4u*)(us + (size_t)cc * GDV + ch * 8) = *(const LAS v4u*)(US + cc * VST + ch * 8); }
    }
#undef GLA_A_PREFETCH
    __syncthreads();
}
constexpr int CW_QKM = 64;
__device__ __forceinline__ void fox_norm_item(Frame& F, int item) {
    const int tid = tid_(), lane = tid & 63; (void)lane;
    const int bh = item >> 4, sl = item & 15, b = bh >> 3, h = bh & 7; const size_t row = (size_t)b * SEQ + sl * 512 + tid;
    const v4u* qp = (const v4u*)(WSP(bf16, WS_FQ) + row * 512 + h * 64); const v4u* kp = (const v4u*)(WSP(bf16, WS_FK) + row * 512 + h * 64);
    float q2 = 0.f, k2 = 0.f;
#pragma unroll
    for (int i = 0; i < 8; ++i) { const v4u a = qp[i], c = kp[i];
        q2 += (bfl(a.x) * bfl(a.x) + bfh(a.x) * bfh(a.x)) + (bfl(a.y) * bfl(a.y) + bfh(a.y) * bfh(a.y)) + (bfl(a.z) * bfl(a.z) + bfh(a.z) * bfh(a.z)) + (bfl(a.w) * bfl(a.w) + bfh(a.w) * bfh(a.w));
        k2 += (bfl(c.x) * bfl(c.x) + bfh(c.x) * bfh(c.x)) + (bfl(c.y) * bfl(c.y) + bfh(c.y) * bfh(c.y)) + (bfl(c.z) * bfl(c.z) + bfh(c.z) * bfh(c.z)) + (bfl(c.w) * bfl(c.w) + bfh(c.w) * bfh(c.w)); }
    q2 = wave_max(q2) * 1.0001f; k2 = wave_max(k2) * 1.0001f;
    if (lane == 0) { atomicMax(WSP(unsigned, WS_CTL) + CW_QKM + bh, __float_as_uint(q2)); atomicMax(WSP(unsigned, WS_CTL) + CW_QKM + 32 + bh, __float_as_uint(k2)); }
}
__device__ __forceinline__ void phase3(Frame& F) {
    if (F.blk < 32) fox_cumsum_item(F, F.blk);
    for (int it = F.blk; it < 512; it += F.G) fox_norm_item(F, it);
    gla_state_phase(F);
}

__device__ __forceinline__ void gla_scan(Frame& F) {
    const int tid = tid_(), lane = tid & 63; (void)lane;
    const int NTOT = 16 * GDK * GDV / 4;
    for (int gt = F.blk * NTHR + tid; gt < NTOT; gt += F.G * NTHR) {
        const int bh = gt / (GDK * GDV / 4), e4 = gt % (GDK * GDV / 4), c = e4 >> 6; const size_t it0 = (size_t)(bh >> 2) * GNCH * 4 + (bh & 3);
        bf16* p = WSP(bf16, WS_US) + it0 * GDK * GDV + (size_t)e4 * 4; const float* dl = WSP(float, WS_DLAST) + it0 * GDK + c;
        float s0 = 0.f, s1 = 0.f, s2 = 0.f, s3 = 0.f;
        for (int n0 = 0; n0 < GNCH; n0 += 8) { v2u u[8]; float d[8];
#pragma unroll
            for (int j = 0; j < 8; ++j) { u[j] = *(const v2u*)(p + (size_t)(n0 + j) * 4 * GDK * GDV); d[j] = dl[(size_t)(n0 + j) * 4 * GDK]; }
#pragma unroll
            for (int j = 0; j < 8; ++j) { v2u o; o.x = pk2(s0, s1); o.y = pk2(s2, s3); *(v2u*)(p + (size_t)(n0 + j) * 4 * GDK * GDV) = o;
                s0 = d[j] * s0 + bfl(u[j].x); s1 = d[j] * s1 + bfh(u[j].x); s2 = d[j] * s2 + bfl(u[j].y); s3 = d[j] * s3 + bfh(u[j].y); } }
    }
}

__device__ __forceinline__ void gla_out_phase(Frame& F) {
    const int tid = tid_(), lane = tid & 63;
    LAS bf16* QhS = (LAS bf16*)F.lds;
    LAS bf16* KcS = (LAS bf16*)(F.lds + 17408);
    LAS bf16* PS = (LAS bf16*)(F.lds + 34816);
    LAS bf16* VS = (LAS bf16*)(F.lds + 44032);
    LAS bf16* SS = (LAS bf16*)(F.lds + 77824);
    LAS bf16* GH = (LAS bf16*)(F.lds + 145408);
    LAS bf16* GL = (LAS bf16*)(F.lds + 145408 + 3072);
    LAS float* totS = (LAS float*)(F.lds + 145408 + 6144);
    LAS float* oS = (LAS float*)(F.lds + 44032);
    v4u ps[8], pv[4], pq[2], pk[2]; f32x4 pg = (f32x4){0.f, 0.f, 0.f, 0.f}; bf16x8 bwhn, bwln, bwh, bwl; float bgn, bg; v2u ggn[8], gg[8]; f32x4 gnn, gn;
    const gfptr_t bgate = PT(7), gnorm = PT(8); const int ccw = 32 * (F.wave >> 1) + (lane & 31);
#define GLA_C_PREFETCH(it_) do { const int h_ = (it_) & 3, n_ = ((it_) >> 2) & (GNCH - 1), b_ = (it_) >> 9; const size_t r0_ = (size_t)b_ * SEQ + (size_t)n_ * GC; \
        bwhn = *(const bf16x8*)(WSP(bf16, WS_WGT) + (size_t)(h_ * GDK + ccw) * 16 + 8 * (lane >> 5)); bwln = *(const bf16x8*)(WSP(bf16, WS_WGT) + 512 * 16 + (size_t)(h_ * GDK + ccw) * 16 + 8 * (lane >> 5)); bgn = bgate[h_ * GDK + ccw]; \
        gnn = *(gf4ptr_t)(gnorm + h_ * GDV + 4 * lane); \
        _Pragma("unroll") for (int i = 0; i < 8; ++i) ggn[i] = *(const v2u*)(WSP(bf16, WS_GR) + (r0_ + 8 * F.wave + i) * 1024 + h_ * GDV + 4 * lane); \
        const bf16* sp_ = WSP(bf16, WS_US) + (size_t)(it_) * GDK * GDV; \
        _Pragma("unroll") for (int i = 0; i < 8; ++i) { const int pc = tid + i * NTHR, cc = pc >> 5, ch = pc & 31; ps[i] = *(const v4u*)(sp_ + (size_t)cc * GDV + ch * 8); } \
        _Pragma("unroll") for (int i = 0; i < 4; ++i) { const int pc = tid + i * NTHR, t = pc >> 5, ch = pc & 31; pv[i] = *(const v4u*)(WSP(bf16, WS_GV) + (r0_ + t) * 1024 + h_ * GDV + ch * 8); } \
        _Pragma("unroll") for (int i = 0; i < 2; ++i) { const int pc = tid + i * NTHR, t = pc >> 4, ch = pc & 15; const size_t go = (r0_ + t) * 512 + h_ * GDK + ch * 8; \
            pq[i] = *(const v4u*)(WSP(bf16, WS_GQ) + go); pk[i] = *(const v4u*)(WSP(bf16, WS_GK) + go); } \
        if (tid < 256) pg = ((const f32x4*)(WSP(float, WS_GLR) + r0_ * 16))[tid]; } while (0)
    int it = F.blk;
    if (it < GITEMS) GLA_C_PREFETCH(it);
    for (; it < GITEMS; it += F.G) {
        const int h = it & 3, n = (it >> 2) & (GNCH - 1), b = it >> 9; const size_t r0 = (size_t)b * SEQ + (size_t)n * GC;
#pragma unroll
        for (int i = 0; i < 8; ++i) { const int pc = tid + i * NTHR, cc = pc >> 5, ch = pc & 31; *(LAS v4u*)(SS + cc * VST + ch * 8) = ps[i]; }
#pragma unroll
        for (int i = 0; i < 4; ++i) { const int pc = tid + i * NTHR, t = pc >> 5, ch = pc & 31; *(LAS v4u*)(VS + t * VST + ch * 8) = pv[i]; }
#pragma unroll
        for (int i = 0; i < 2; ++i) { const int pc = tid + i * NTHR, t = pc >> 4, ch = pc & 15; *(LAS v4u*)(QhS + t * KST + ch * 8) = pq[i]; *(LAS v4u*)(KcS + t * KST + ch * 8) = pk[i]; }
        if (tid < 256) { const int t = tid >> 2, q = tid & 3; const unsigned h0 = f2bf(pg.x), h1 = f2bf(pg.y), h2 = f2bf(pg.z), h3 = f2bf(pg.w);
            *(LAS v2u*)(GH + t * GST + 4 * q) = (v2u){h0 | (h1 << 16), h2 | (h3 << 16)};
            *(LAS v2u*)(GL + t * GST + 4 * q) = (v2u){pk2(pg.x - __uint_as_float(h0 << 16), pg.y - __uint_as_float(h1 << 16)), pk2(pg.z - __uint_as_float(h2 << 16), pg.w - __uint_as_float(h3 << 16))}; }
        bwh = bwhn; bwl = bwln; bg = bgn;
#pragma unroll
        for (int i = 0; i < 8; ++i) gg[i] = ggn[i];
        gn = gnn;
        __syncthreads();
        if (it + F.G < GITEMS) GLA_C_PREFETCH(it + F.G);
        float p[16]; (void)gla_decay_mfma(lane, F.wave, GH, GL, bwh, bwl, bg, totS, p);
        { const int tb = F.wave & 1, hq = lane >> 5;
#pragma unroll
          for (int r = 0; r < 16; ++r) { const int t = 32 * tb + crow16(r, hq); const float e = __expf(p[r]);
              QhS[t * KST + ccw] = (bf16)f2bf(bf1(QhS[t * KST + ccw]) * e); KcS[t * KST + ccw] = (bf16)f2bf(bf1(KcS[t * KST + ccw]) * __builtin_amdgcn_rcpf(e)); } }
        __syncthreads();
        if (F.wave < 4) { const int tb = F.wave >> 1, sb = F.wave & 1; f32x16 pa = (f32x16){};
#pragma unroll
            for (int ks = 0; ks < 8; ++ks) pa = __builtin_amdgcn_mfma_f32_32x32x16_bf16(frag_row(KcS, KST, 32 * sb, 16 * ks, lane), frag_row(QhS, KST, 32 * tb, 16 * ks, lane), pa, 0, 0, 0);
            const int t = 32 * tb + (lane & 31), hh = lane >> 5;
#pragma unroll
            for (int g = 0; g < 4; ++g) { const int s0 = 32 * sb + 8 * g + 4 * hh; v2u w;
                w.x = pk2(s0 <= t ? pa[4 * g] : 0.f, s0 + 1 <= t ? pa[4 * g + 1] : 0.f); w.y = pk2(s0 + 2 <= t ? pa[4 * g + 2] : 0.f, s0 + 3 <= t ? pa[4 * g + 3] : 0.f);
                *(LAS v2u*)(PS + t * PST + s0) = w; } }
        __syncthreads();
        f32x16 acc[2]; acc[0] = (f32x16){}; acc[1] = (f32x16){};
#pragma unroll
        for (int ks = 0; ks < 8; ++ks) { const bf16x8 aa = frag_tr(SS, VST, 16 * ks, 32 * F.wave, lane);
#pragma unroll
            for (int tb = 0; tb < 2; ++tb) acc[tb] = __builtin_amdgcn_mfma_f32_32x32x16_bf16(aa, frag_row(QhS, KST, 32 * tb, 16 * ks, lane), acc[tb], 0, 0, 0); }
#pragma unroll
        for (int ks = 0; ks < 4; ++ks) { const bf16x8 aa = frag_tr(VS, VST, 16 * ks, 32 * F.wave, lane);
#pragma unroll
            for (int tb = 0; tb < 2; ++tb) acc[tb] = __builtin_amdgcn_mfma_f32_32x32x16_bf16(aa, frag_row(PS, PST, 32 * tb, 16 * ks, lane), acc[tb], 0, 0, 0); }
        __syncthreads();
        { const int hh = lane >> 5;
#pragma unroll
          for (int tb = 0; tb < 2; ++tb)
#pragma unroll
              for (int g = 0; g < 4; ++g) *(LAS f32x4*)(oS + (32 * tb + (lane & 31)) * 260 + 32 * F.wave + 8 * g + 4 * hh) = (f32x4){acc[tb][4 * g], acc[tb][4 * g + 1], acc[tb][4 * g + 2], acc[tb][4 * g + 3]}; }
        __syncthreads();
        {
#pragma unroll
          for (int i = 0; i < 8; ++i) { const int t = 8 * F.wave + i; const f32x4 o = *(const LAS f32x4*)(oS + t * 260 + 4 * lane);
              const float ss = wave_sum((o.x * o.x + o.y * o.y) + (o.z * o.z + o.w * o.w)); const float rs = 1.f / sqrtf(ss * (1.f / GDV) + LN_EPS);
              const float g0 = bfl(gg[i].x), g1 = bfh(gg[i].x), g2 = bfl(gg[i].y), g3 = bfh(gg[i].y);
              v2u w; w.x = pk2(o.x * rs * gn.x * (g0 * sigmoidf_(g0)), o.y * rs * gn.y * (g1 * sigmoidf_(g1))); w.y = pk2(o.z * rs * gn.z * (g2 * sigmoidf_(g2)), o.w * rs * gn.w * (g3 * sigmoidf_(g3)));
              *(v2u*)(WSP(bf16, WS_GV) + (r0 + t) * 1024 + h * GDV + 4 * lane) = w; } }
        __syncthreads();
    }
#undef GLA_C_PREFETCH
}

__device__ __forceinline__ void phase9(Frame& F) {
    const int tid = tid_(), lane = tid & 63;
    LAS float* wr = (LAS float*)F.lds;
    LAS int* lcnt = (LAS int*)(F.lds + MISC_OFF);
    LAS int* rec_e = lcnt + 64; LAS int* rec_i = rec_e + 512; LAS float* rec_g = (LAS float*)(rec_i + 512);
    LAS float* cst = (LAS float*)(F.lds + MISC_OFF + 8192);
    const int rows_per_blk = T / F.G, rows_per_wave = rows_per_blk / NWAVES;
    const int b = F.blk / (F.G / NB);
    for (int i = tid; i < 32 * 1024 / 4; i += NTHR) ((LAS f32x4*)wr)[i] = WSP(f32x4, WS_WRT)[i];
    { const float* modf = WSP(float, WS_MODF) + (size_t)b * 6144; const gfptr_t ln1g = PT(12), ln1b = PT(13);
      for (int i = tid; i < 1024; i += NTHR) { cst[i] = ln1g[i]; cst[1024 + i] = ln1b[i]; cst[2048 + i] = modf[3072 + i]; cst[3072 + i] = modf[4096 + i]; } }
    if (tid < 64) lcnt[tid] = 0;
    const int ei = lane >> 1; const float rb = PT(15)[ei];
    __syncthreads();
    const int rl0 = F.wave * rows_per_wave, rowb = F.blk * rows_per_blk + rl0;
    f32x4 va[2][4], vb[2][4];
#define P9_LOAD(V, rw) do { _Pragma("unroll") for (int r = 0; r < 2; ++r) _Pragma("unroll") for (int j = 0; j < 4; ++j) V[r][j] = ((const f32x4*)(F.out + (size_t)((rw) + r) * DM) + lane)[64 * j]; } while (0)
#define P9_PAIR(v, rw, rlp, NEXT) do { \
        float rstd[2]; ln_center<2>(v, rstd); \
        _Pragma("unroll") for (int r = 0; r < 2; ++r) { f32x4* zr = (f32x4*)(F.out + (size_t)((rw) + r) * DM) + lane; \
            _Pragma("unroll") for (int j = 0; j < 4; ++j) { const f32x4 g = *(const LAS f32x4*)(cst + 256 * j + 4 * lane), bb = *(const LAS f32x4*)(cst + 1024 + 256 * j + 4 * lane); v[r][j] = v[r][j] * rstd[r] * g + bb; zr[64 * j] = v[r][j]; } } \
        ln_center<2>(v, rstd); \
        _Pragma("unroll") for (int r = 0; r < 2; ++r) { int* o4 = (int*)(F.ws + WS_U2 + (size_t)((rw) + r) * DM) + lane;        \
            _Pragma("unroll") for (int j = 0; j < 4; ++j) { const f32x4 sh = *(const LAS f32x4*)(cst + 2048 + 256 * j + 4 * lane), scv = *(const LAS f32x4*)(cst + 3072 + 256 * j + 4 * lane); \
                v[r][j] = v[r][j] * rstd[r] * (scv + 1.0f) + sh; \
                int w = 0; w = __builtin_amdgcn_cvt_pk_fp8_f32(v[r][j].x, v[r][j].y, w, false); w = __builtin_amdgcn_cvt_pk_fp8_f32(v[r][j].z, v[r][j].w, w, true); o4[64 * j] = w; } } \
        float p0[32], p1[32]; row_dots2<32>(v, wr, lane, p0, p1); \
        float lgs[2]; lgs[0] = reduce32(p0, lane) + rb; lgs[1] = reduce32(p1, lane) + rb;     \
        _Pragma("unroll") for (int r = 0; r < 2; ++r) { float lg = lgs[r]; int ek[4]; float vk[4]; \
            _Pragma("unroll") for (int k = 0; k < 4; ++k) { const float m = wave_max(lg); const unsigned long long bal = __ballot(lg == m); const int src = __ffsll((long long)bal) - 1; \
                ek[k] = src >> 1; vk[k] = m; if (ei == ek[k]) lg = -INFINITY; } \
            const float w1 = __expf(vk[1] - vk[0]), w2 = __expf(vk[2] - vk[0]), w3 = __expf(vk[3] - vk[0]); const float inv = 1.f / (1.f + w1 + w2 + w3); \
            if (lane < 4) { const int e = lane == 0 ? ek[0] : lane == 1 ? ek[1] : lane == 2 ? ek[2] : ek[3]; const float gk = (lane == 0 ? 1.f : lane == 1 ? w1 : lane == 2 ? w2 : w3) * inv; \
                const int li = atomicAdd((int*)(lcnt + e), 1); const int rl = (rlp) + r; \
                rec_e[rl * 4 + lane] = e; rec_i[rl * 4 + lane] = li; rec_g[rl * 4 + lane] = gk; } } \
        NEXT; } while (0)
    P9_LOAD(va, rowb); P9_LOAD(vb, rowb + 2);
    for (int rr = 0; rr < rows_per_wave; rr += 4) {
        const int row = rowb + rr;
        P9_PAIR(va, row, rl0 + rr, if (rr + 4 < rows_per_wave) P9_LOAD(va, row + 4));
        P9_PAIR(vb, row + 2, rl0 + rr + 2, if (rr + 6 < rows_per_wave) P9_LOAD(vb, row + 6));
    }
#undef P9_LOAD
#undef P9_PAIR
    __syncthreads();
    if (tid < 32) lcnt[32 + tid] = (int)atomicAdd(WSP(unsigned, WS_CTL) + tid, (unsigned)lcnt[tid]);
    __syncthreads();
    for (int r = tid; r < rows_per_blk * 4; r += NTHR) { const int e = rec_e[r], idx = lcnt[32 + e] + rec_i[r], tok = F.blk * rows_per_blk + (r >> 2);
        WSP(int, WS_RTOK)[e * ECAP + idx] = tok; WSP(int, WS_TSLOT)[(size_t)tok * 4 + (r & 3)] = e * ECAP + idx; WSP(float, WS_TGATE)[(size_t)tok * 4 + (r & 3)] = rec_g[r]; }
    __syncthreads();
}
__device__ __forceinline__ void moe_tables(Frame& F, LAS int* tstart) {
    const int tid = tid_(), lane = tid & 63; (void)lane;
    if (tid == 0) { int run = 0; for (int e = 0; e < NEXP; ++e) { tstart[e] = run; run += (int)((WSP(unsigned, WS_CTL)[e] + 255u) >> 8); } tstart[NEXP] = run; }
    __syncthreads();
}
__device__ __forceinline__ void phase12(Frame& F) {
    const int tid = tid_(), lane = tid & 63;
    LAS int* tstart = (LAS int*)(F.lds + MISC_OFF);
    moe_tables(F, tstart);
    const int rows_per_blk = T / F.G, rows_per_wave = rows_per_blk / NWAVES; const int b = F.blk / (F.G / NB);
    LAS float* cst = (LAS float*)F.lds;
    { const float* modf = WSP(float, WS_MODF) + (size_t)b * 6144; const gfptr_t ln2g = PT(20), ln2b = PT(21);
      for (int i = tid; i < 1024; i += NTHR) { cst[i] = modf[5120 + i]; cst[1024 + i] = ln2g[i]; cst[2048 + i] = ln2b[i]; } }
    __syncthreads();
    const int row0 = F.blk * rows_per_blk + F.wave * rows_per_wave;
    v4u slA, slB; f32x4 gsA, gsB, gkA, gkB; v2u moA[4][4], moB[4][4]; f32x4 xvA[4], xvB[4];
#define P12_SLOTS(S, G, rw) do { G = *(const f32x4*)(WSP(float, WS_TGATE) + (size_t)(rw) * 4); S = *(const v4u*)(WSP(int, WS_TSLOT) + (size_t)(rw) * 4); } while (0)
#define P12_DATA(MO, XV, GK, S, G, rw) do { _Pragma("unroll") for (int k = 0; k < 4; ++k) { const int sl_ = (int)S[k]; const int e = sl_ >> 15, idx = sl_ & (ECAP - 1); const size_t srow = (size_t)tstart[e] * 256 + idx; \
            const v2u* mp = (const v2u*)(WSP(bf16, WS_MOE) + srow * DM) + lane; _Pragma("unroll") for (int j = 0; j < 4; ++j) MO[k][j] = mp[64 * j]; } GK = G; \
        const f32x4* xr_ = (const f32x4*)(F.out + (size_t)(rw) * DM) + lane; _Pragma("unroll") for (int j = 0; j < 4; ++j) XV[j] = xr_[64 * j]; } while (0)
#define P12_FINISH(MO, XV, GK, rw) do { f32x4 v[4]; float s = 0.f; \
        _Pragma("unroll") for (int j = 0; j < 4; ++j) { f32x4 y = (f32x4){0.f, 0.f, 0.f, 0.f}; \
            _Pragma("unroll") for (int k = 0; k < 4; ++k) { const v2u w = MO[k][j]; const float g = GK[k]; y.x += g * bfl(w.x); y.y += g * bfh(w.x); y.z += g * bfl(w.y); y.w += g * bfh(w.y); } \
            const f32x4 g2 = *(const LAS f32x4*)(cst + 256 * j + 4 * lane); v[j] = XV[j] * ALPHA + (g2 + 1.0f) * y; s += (v[j].x + v[j].y) + (v[j].z + v[j].w); } \
        const float mean = wave_sum(s) * (1.f / DM); float s2 = 0.f; \
        _Pragma("unroll") for (int j = 0; j < 4; ++j) { v[j] = v[j] - mean; s2 += (v[j].x * v[j].x + v[j].y * v[j].y) + (v[j].z * v[j].z + v[j].w * v[j].w); } \
        const float rstd = 1.f / sqrtf(wave_sum(s2) * (1.f / DM) + LN_EPS); f32x4* xo = (f32x4*)(F.out + (size_t)(rw) * DM) + lane; \
        _Pragma("unroll") for (int j = 0; j < 4; ++j) { const f32x4 g = *(const LAS f32x4*)(cst + 1024 + 256 * j + 4 * lane), bb = *(const LAS f32x4*)(cst + 2048 + 256 * j + 4 * lane); xo[64 * j] = v[j] * rstd * g + bb; } } while (0)
    P12_SLOTS(slA, gsA, row0); P12_SLOTS(slB, gsB, row0 + 1);
    P12_DATA(moA, xvA, gkA, slA, gsA, row0); P12_DATA(moB, xvB, gkB, slB, gsB, row0 + 1);
    P12_SLOTS(slA, gsA, row0 + 2); P12_SLOTS(slB, gsB, row0 + 3);
    for (int rr = 0; rr < rows_per_wave; rr += 2) {
        const int row = row0 + rr;
        P12_FINISH(moA, xvA, gkA, row);
        if (rr + 2 < rows_per_wave) { P12_DATA(moA, xvA, gkA, slA, gsA, row + 2); if (rr + 4 < rows_per_wave) P12_SLOTS(slA, gsA, row + 4); }
        P12_FINISH(moB, xvB, gkB, row + 1);
        if (rr + 3 < rows_per_wave) { P12_DATA(moB, xvB, gkB, slB, gsB, row + 3); if (rr + 5 < rows_per_wave) P12_SLOTS(slB, gsB, row + 5); }
    }
#undef P12_SLOTS
#undef P12_DATA
#undef P12_FINISH
}

constexpr int NPHASE = 13;
__global__ void __launch_bounds__(NTHR, 2) fwd_kernel(Args args) {
    extern __shared__ __attribute__((aligned(16))) unsigned char lds[];
    Frame F;
    F.lds = (LAS unsigned char*)lds; F.wave = __builtin_amdgcn_readfirstlane((int)threadIdx.x >> 6); F.G = gridDim.x; F.blk = blockIdx.x;
    F.out = args.out; F.ws = args.ws;
    const int lo = args.ph_lo, hi = args.ph_hi;
#ifndef PROBE_PH
#define PROBE_PH (-1)
#endif
    unsigned long long tp0 = 0, tp1 = 0;
#define STAMP0(k) do { if ((k) == PROBE_PH) tp0 = __builtin_amdgcn_s_memrealtime(); } while (0)
#define STAMP1(k) do { if ((k) == PROBE_PH) tp1 = __builtin_amdgcn_s_memrealtime(); } while (0)
#ifndef PH_MASK
#define PH_MASK 0xffff
#endif
#define IN(k) (((PH_MASK >> (k)) & 1) && lo <= (k) && (k) < hi)
#if MK_N_LAUNCHES == 1
    if (threadIdx.x < 2) ((LAS unsigned*)(F.lds + BARLDS_OFF))[threadIdx.x] = 0u;
    __syncthreads();
    const XcdBarrier bar = xcd_barrier_post(WSP(unsigned, WS_CTL) + CW_BAR, (volatile LAS unsigned*)(F.lds + BARLDS_OFF));
#define SEAM(k) do { if (IN(k) && IN((k) + 1)) { if ((k) == 0) cg::this_grid().sync(); else xcd_barrier(bar); } } while (0)
#else
#define SEAM(k) do { } while (0)
#endif
    typedef pg8::bf16_t pbf;
    STAMP0(0); if (IN(0)) { phase0(F, args); } SEAM(0); STAMP1(0);
    STAMP0(1); if (IN(1)) { phase1(F, args); } SEAM(1); STAMP1(1);
    STAMP0(2); if (IN(2)) {
        pg8::Gemm g{WSP(pbf, WS_U), WSP(pbf, WS_WIN), 1024, nullptr, 0, 0}; pg8::DenseOrder S{T / 256, NPROJ / 256, F.G, F.blk};
        pg8::EpiInProj E{WSP(pbf, WS_FQ), WSP(pbf, WS_FK), WSP(pbf, WS_FV), WSP(pbf, WS_GQ), WSP(pbf, WS_GK), WSP(pbf, WS_GV), WSP(pbf, WS_GR), WSP(pbf, WS_GA), WSP(pbf, WS_GB), 0.125f * LOG2E, 0.08838834764831845f};
        pg8::gemm_phase<pg8::EpiInProj, pg8::DenseOrder, false, true>(F.lds, g, S, E);
    } SEAM(2); STAMP1(2);
    STAMP0(3); if (IN(3)) { phase3(F); } SEAM(3); STAMP1(3);
    STAMP0(4); if (IN(4)) {
        gla_scan(F);
        __syncthreads();
        const attn_body::AttnTensors AT{(const attn_body::bf16*)WSP(pbf, WS_FQ), (const attn_body::bf16*)WSP(pbf, WS_FK), (const attn_body::bf16*)WSP(pbf, WS_FV), (attn_body::bf16*)WSP(pbf, WS_FQ), WSP(float, WS_CUM), WSP(unsigned, WS_CTL) + CW_QKM};
        const attn_body::StaticOrder S((int)F.G, (int)F.blk);
        attn_body::attn_phase<attn_body::StaticOrder>((char*)lds, AT, S);
    } SEAM(4); STAMP1(4);
    STAMP0(5); if (IN(5)) { gla_out_phase(F); } SEAM(5); STAMP1(5);
    STAMP0(6); if (IN(6)) {
        pg8::Gemm g{WSP(pbf, WS_FQ), WSP(pbf, WS_WA), 512, nullptr, 0, 0}; pg8::DenseOrder S{T / 256, 4, F.G, F.blk};
        pg8::EpiGate<false> E{WSP(pbf, WS_U), WSP(pbf, WS_GA)};
        pg8::gemm_phase<pg8::EpiGate<false>, pg8::DenseOrder, false, true>(F.lds, g, S, E);
    }
    if (IN(6) && IN(7)) { __syncthreads(); } STAMP1(6);
    STAMP0(7); if (IN(7)) {
        pg8::Gemm g{WSP(pbf, WS_GV), WSP(pbf, WS_WB), 1024, nullptr, 0, 0}; pg8::DenseOrder S{T / 256, 4, F.G, F.blk};
        pg8::EpiGate<true> E{WSP(pbf, WS_U), WSP(pbf, WS_GB)};
        pg8::gemm_phase<pg8::EpiGate<true>, pg8::DenseOrder, false, true>(F.lds, g, S, E);
    } SEAM(7); STAMP1(7);
    STAMP0(8); if (IN(8)) {
        pg8::Gemm g{WSP(pbf, WS_U), WSP(pbf, WS_WO), 1024, nullptr, 0, 0}; pg8::DenseOrder S{T / 256, 4, F.G, F.blk};
        pg8::EpiResid E{PT(0), F.out, WSP(float, WS_MODF) + 2048, 6144, SEQ, ALPHA};
        pg8::gemm_phase<pg8::EpiResid, pg8::DenseOrder, false, true>(F.lds, g, S, E);
    } SEAM(8); STAMP1(8);
    STAMP0(9); if (IN(9)) { phase9(F); } SEAM(9); STAMP1(9);
    STAMP0(10); if (IN(10)) {
        LAS int* tstart = (LAS int*)(F.lds + MISC_OFF); moe_tables(F, tstart);
        pg8::Gemm g{WSP(pbf, WS_U2), WSP(pbf, WS_WUP), 512, WSP(int, WS_RTOK), 0x7f7f7f7f, 0x7a7a7a7a}; pg8::MoeOrder S{tstart[NEXP], 8, F.G, F.blk, tstart};
        pg8::EpiSwiglu<true> E{WSP(pbf, WS_ACT), PT(17), 8};
        pg8::gemm_phase<pg8::EpiSwiglu<true>, pg8::MoeOrder, true, true, true>(F.lds, g, S, E);
    } SEAM(10); STAMP1(10);
    STAMP0(11); if (IN(11)) {
        LAS int* tstart = (LAS int*)(F.lds + MISC_OFF); moe_tables(F, tstart);
        pg8::Gemm g{WSP(pbf, WS_ACT), WSP(pbf, WS_WDN), 512, nullptr, 0x7f7f7f7f, 0x79797979}; pg8::MoeOrder S{tstart[NEXP], 4, F.G, F.blk, tstart};
        pg8::EpiDown E{WSP(pbf, WS_MOE), PT(19), 4};
        pg8::gemm_phase<pg8::EpiDown, pg8::MoeOrder, false, true, true>(F.lds, g, S, E);
    } SEAM(11); STAMP1(11);
    STAMP0(12); if (IN(12)) { phase12(F); } STAMP1(12);
    if (PROBE_PH >= 0 && F.blk == 0) { const unsigned long long te = __builtin_amdgcn_s_memrealtime(), dd = 9ull * (tp1 - tp0); while (__builtin_amdgcn_s_memrealtime() - te < dd) __builtin_amdgcn_s_sleep(32); }
#undef IN
#undef SEAM
}

extern "C" void kernel_launch(void* const* d_in, const int* in_sizes, int n_in, void* d_out, int out_size, void* d_ws, size_t ws_size, hipStream_t stream) {
    static int grid = 0;
    if (grid == 0) {
        if (n_in != 22 || in_sizes[0] != T * DM || out_size != T * DM || ws_size < WS_END) { fprintf(stderr, "kernel_launch: unexpected shapes (n_in %d, x %d, out %d, ws %zu < %zu); nothing launched\n", n_in, n_in > 0 ? in_sizes[0] : -1, out_size, ws_size, (size_t)WS_END); grid = -1; return; }
        int dev = 0, cus = 0, per_cu = 0;
        if (hipGetDevice(&dev) != hipSuccess || hipDeviceGetAttribute(&cus, hipDeviceAttributeMultiprocessorCount, dev) != hipSuccess) { grid = -1; return; }
        if (hipFuncSetAttribute((const void*)fwd_kernel, hipFuncAttributeMaxDynamicSharedMemorySize, LDS_BYTES) != hipSuccess) { fprintf(stderr, "kernel_launch: hipFuncSetAttribute failed\n"); grid = -1; return; }
        if (hipOccupancyMaxActiveBlocksPerMultiprocessor(&per_cu, (const void*)fwd_kernel, NTHR, LDS_BYTES) != hipSuccess || per_cu < 1) { fprintf(stderr, "kernel_launch: occupancy query says %d blocks per CU\n", per_cu); (void)hipGetLastError(); grid = -1; return; }
        grid = cus;
        if (grid != 256) { fprintf(stderr, "kernel_launch: built for a 256-CU device, found %d CUs; nothing launched\n", cus); grid = -1; return; }
    }
    if (grid < 0) return;
    if (hipMemsetAsync((char*)d_ws + WS_CTL, 0, CTL_ZERO_BYTES, stream) != hipSuccess) { fprintf(stderr, "kernel_launch: hipMemsetAsync failed\n"); return; }
    Args a{};
    for (int i = 0; i < 22; ++i) a.in[i] = (const float*)d_in[i];
    a.out = (float*)d_out; a.ws = (unsigned char*)d_ws;
#if MK_N_LAUNCHES == 1
    a.ph_lo = 0; a.ph_hi = NPHASE;
    void* kargs[] = {&a};
    hipError_t e = hipLaunchCooperativeKernel((const void*)fwd_kernel, dim3(grid), dim3(NTHR), kargs, LDS_BYTES, stream);
    if (e != hipSuccess) fprintf(stderr, "kernel_launch: cooperative launch failed: %s\n", hipGetErrorString(e));
#else
    for (int p = 0; p < NPHASE; ++p) {
        if (p == 7) continue;
        a.ph_lo = p; a.ph_hi = (p == 6) ? 8 : p + 1;
        hipLaunchKernelGGL(fwd_kernel, dim3(grid), dim3(NTHR), LDS_BYTES, stream, a);
    }
#endif
}
```
